# Optimizing an MI355X kernel written in HIP

```python
import jax, jax.numpy as jnp
from jax import lax
import numpy as np

D_MODEL = 4096
BATCH = 2
SEQ = 8192
DEPTH = 4

N_MIXERS = 3
EPS = 1e-6
HEAD_DIM = 128
D_FF = (11 * D_MODEL) // 8
GDN_HEADS = D_MODEL // HEAD_DIM
GDN_DK = HEAD_DIM
GDN_DV = HEAD_DIM
GDN_CONV = 4
GDN_CHUNK = 64
SC_CONV = 3
ATT_HEADS = D_MODEL // HEAD_DIM
ATT_DH = HEAD_DIM
MOBA_BLOCK = 256
MOBA_TOPK = 3
MOBA_QCHUNK = 16
ROPE_THETA = 10000.0

N_A = (DEPTH + 2) // 3
N_B = (DEPTH + 1) // 3
N_C = DEPTH // 3
GDN_QK = GDN_HEADS * GDN_DK
GDN_VW = GDN_HEADS * GDN_DV
GDN_CONV_W = 2 * GDN_QK + GDN_VW
GDN_PROJ = 2 * GDN_QK + 2 * GDN_VW + 2 * GDN_HEADS

kernel_name = "macaron_hybrid_gdn_shortconv_moba"


def rmsnorm(x, g):
    xf = x.astype(jnp.float32)
    y = xf * lax.rsqrt(jnp.mean(xf * xf, axis=-1, keepdims=True) + EPS)
    return (y * g.astype(jnp.float32)).astype(x.dtype)


def l2norm(x):
    return x * lax.rsqrt(jnp.sum(x * x, axis=-1, keepdims=True) + EPS)


def swiglu(h, w_in, w_out):
    gate, up = jnp.split(h @ w_in, 2, axis=-1)
    return (jax.nn.silu(gate) * up) @ w_out


def causal_dwconv(x, w):
    width = w.shape[0]
    s = x.shape[1]
    xp = jnp.pad(x, ((0, 0), (width - 1, 0), (0, 0)))
    return sum(xp[:, t:t + s] * w[t] for t in range(width))


def rope(x, positions):
    half = x.shape[-1] // 2
    inv_freq = ROPE_THETA ** (-jnp.arange(half, dtype=jnp.float32) / half)
    ang = positions.astype(jnp.float32)[..., None] * inv_freq
    cos = jnp.cos(ang)[:, :, None, :]
    sin = jnp.sin(ang)[:, :, None, :]
    xf = x.astype(jnp.float32)
    x1, x2 = xf[..., :half], xf[..., half:]
    return jnp.concatenate([x1 * cos - x2 * sin, x2 * cos + x1 * sin], axis=-1).astype(x.dtype)


def chunk_gated_delta_rule(q, k, v, g, beta):
    b, s, h, dk = q.shape
    dv = v.shape[-1]
    c = GDN_CHUNK
    n = s // c

    def to_chunks(t):
        return jnp.moveaxis(t.reshape((b, n, c) + t.shape[2:]), 3, 1)

    q, k, v, g, beta = map(to_chunks, (q, k, v, g, beta))
    gc = jnp.cumsum(g, axis=-1)
    incl = jnp.tril(jnp.ones((c, c), dtype=bool))
    strict = jnp.tril(jnp.ones((c, c), dtype=bool), -1)
    eye = jnp.eye(c, dtype=jnp.float32)
    diff = gc[..., :, None] - gc[..., None, :]
    gamma = jnp.where(incl, jnp.exp(jnp.where(incl, diff, 0.0)), 0.0)
    kb = k * beta[..., None]
    m = jnp.where(strict, jnp.einsum('bhncd,bhnjd->bhncj', kb, k) * gamma, 0.0) + eye
    t_inv = lax.linalg.triangular_solve(m, jnp.broadcast_to(eye, m.shape), left_side=True,
                                        lower=True, unit_diagonal=True)
    w = t_inv @ (kb * jnp.exp(gc)[..., None])
    u = t_inv @ (v * beta[..., None])
    qk = jnp.einsum('bhncd,bhnjd->bhncj', q, k) * gamma
    q_dec = q * jnp.exp(gc)[..., None]
    k_dec = k * jnp.exp(gc[..., -1:] - gc)[..., None]
    g_last = jnp.exp(gc[..., -1])

    def step(state, xs):
        w_c, u_c, qk_c, qd_c, kd_c, gl_c = xs
        v_new = u_c - w_c @ state
        o_c = qd_c @ state + qk_c @ v_new
        state = state * gl_c[..., None, None] + jnp.swapaxes(kd_c, -1, -2) @ v_new
        return state, o_c

    xs = tuple(jnp.moveaxis(t, 2, 0) for t in (w, u, qk, q_dec, k_dec, g_last))
    _, o = lax.scan(step, jnp.zeros((b, h, dk, dv), jnp.float32), xs)
    return o.transpose(1, 0, 3, 2, 4).reshape(b, s, h, dv)


def gated_deltanet(h, w_in, conv_w, a_log, dt_bias, o_norm, w_out):
    b, s, _ = h.shape
    H = GDN_HEADS
    proj = h @ w_in
    qkv = proj[..., :GDN_CONV_W]
    z = proj[..., GDN_CONV_W:GDN_CONV_W + GDN_VW]
    a = proj[..., GDN_CONV_W + GDN_VW:GDN_CONV_W + GDN_VW + H]
    bt = proj[..., GDN_CONV_W + GDN_VW + H:]
    qkv = jax.nn.silu(causal_dwconv(qkv, conv_w)).astype(jnp.float32)
    q = l2norm(qkv[..., :GDN_QK].reshape(b, s, H, GDN_DK)) * (GDN_DK ** -0.5)
    k = l2norm(qkv[..., GDN_QK:2 * GDN_QK].reshape(b, s, H, GDN_DK))
    v = qkv[..., 2 * GDN_QK:].reshape(b, s, H, GDN_DV)
    beta = jax.nn.sigmoid(bt.astype(jnp.float32))
    g = -jnp.exp(a_log.astype(jnp.float32)) * jax.nn.softplus(a.astype(jnp.float32) + dt_bias.astype(jnp.float32))
    o = chunk_gated_delta_rule(q, k, v, g, beta)
    o = rmsnorm(o, o_norm) * jax.nn.silu(z.reshape(b, s, H, GDN_DV).astype(jnp.float32))
    return o.reshape(b, s, GDN_VW).astype(h.dtype) @ w_out


def short_conv(h, w_in, conv_w, w_out):
    gb, gc, xv = jnp.split(h @ w_in, 3, axis=-1)
    return (gb * causal_dwconv(gc * xv, conv_w)) @ w_out


def moba_attention(h, positions, w_in, q_norm, k_norm, w_out):
    b, s, _ = h.shape
    H, dh, bs = ATT_HEADS, ATT_DH, MOBA_BLOCK
    q, k, v = (t.reshape(b, s, H, dh) for t in jnp.split(h @ w_in, 3, axis=-1))
    q = rope(rmsnorm(q, q_norm), positions)
    k = rope(rmsnorm(k, k_norm), positions)
    nb = -(-s // bs)
    sp = nb * bs
    padw = ((0, 0), (0, 0), (0, sp - s), (0, 0))
    qp, kp, vp = (jnp.pad(jnp.transpose(t, (0, 2, 1, 3)), padw) for t in (q, k, v))
    kb = kp.reshape(b, H, nb, bs, dh)
    vb = vp.reshape(b, H, nb, bs, dh)
    kmean = jnp.mean(kb.astype(jnp.float32), axis=3)
    topk = min(MOBA_TOPK, nb - 1)
    qc = MOBA_QCHUNK
    scale = dh ** -0.5
    bi = jnp.arange(b)[:, None, None, None]
    hi = jnp.arange(H)[None, :, None, None]

    def chunk(ci):
        start = ci * qc
        qblk = start // bs
        q_c = lax.dynamic_slice_in_dim(qp, start, qc, axis=2)
        qpos = start + jnp.arange(qc)
        k_own = lax.dynamic_index_in_dim(kb, qblk, axis=2, keepdims=False)
        v_own = lax.dynamic_index_in_dim(vb, qblk, axis=2, keepdims=False)
        kpos = qblk * bs + jnp.arange(bs)
        s_own = jnp.einsum('bhqd,bhkd->bhqk', q_c, k_own).astype(jnp.float32) * scale
        s_own = jnp.where(kpos[None, :] <= qpos[:, None], s_own, -jnp.inf)
        if topk > 0:
            gate = jnp.einsum('bhqd,bhnd->bhqn', q_c.astype(jnp.float32), kmean)
            gate = jnp.where(jnp.arange(nb) < qblk, gate, -jnp.inf)
            _, idx = lax.top_k(gate, topk)
            valid = jnp.arange(topk) < qblk
            k_sel = kb[bi, hi, idx]
            v_sel = vb[bi, hi, idx]
            s_sel = jnp.einsum('bhqd,bhqjkd->bhqjk', q_c, k_sel).astype(jnp.float32) * scale
            s_sel = jnp.where(valid[:, None], s_sel, -jnp.inf).reshape(b, H, qc, topk * bs)
            p = jax.nn.softmax(jnp.concatenate([s_sel, s_own], axis=-1), axis=-1)
            p_sel = p[..., :topk * bs].reshape(b, H, qc, topk, bs).astype(vb.dtype)
            p_own = p[..., topk * bs:].astype(vb.dtype)
            return (jnp.einsum('bhqjk,bhqjkd->bhqd', p_sel, v_sel)
                    + jnp.einsum('bhqk,bhkd->bhqd', p_own, v_own))
        p_own = jax.nn.softmax(s_own, axis=-1).astype(vb.dtype)
        return jnp.einsum('bhqk,bhkd->bhqd', p_own, v_own)

    o = lax.map(chunk, jnp.arange(sp // qc))
    o = o.transpose(1, 0, 3, 2, 4).reshape(b, sp, H * dh)[:, :s]
    return o @ w_out


def setup_inputs(seed: int = 0) -> dict:
    key = jax.random.key(seed)
    ks = iter(jax.random.split(key, 32))

    def nrm(shape, scale):
        return jax.random.normal(next(ks), shape, jnp.float32) * scale

    def gain(shape):
        return 1.0 + nrm(shape, 0.02)

    D, F = D_MODEL, D_FF
    x = nrm((BATCH, SEQ, D), 1.0)
    positions = jnp.broadcast_to(jnp.arange(SEQ, dtype=jnp.int32), (BATCH, SEQ))
    dt = jnp.exp(jax.random.uniform(next(ks), (N_A, GDN_HEADS), jnp.float32,
                                    np.log(1e-3), np.log(1e-1)))
    return {
        "x": x,
        "positions": positions,
        "norm_ffn1": gain((DEPTH, D)),
        "norm_mix": gain((DEPTH, D)),
        "norm_ffn2": gain((DEPTH, D)),
        "ffn1_w_in": nrm((DEPTH, D, 2 * F), D ** -0.5),
        "ffn1_w_out": nrm((DEPTH, F, D), F ** -0.5),
        "ffn2_w_in": nrm((DEPTH, D, 2 * F), D ** -0.5),
        "ffn2_w_out": nrm((DEPTH, F, D), F ** -0.5),
        "gdn_w_in": nrm((N_A, D, GDN_PROJ), D ** -0.5),
        "gdn_conv_w": nrm((N_A, GDN_CONV, GDN_CONV_W), GDN_CONV ** -0.5),
        "gdn_a_log": jnp.log(jax.random.uniform(next(ks), (N_A, GDN_HEADS), jnp.float32, 1.0, 16.0)),
        "gdn_dt_bias": dt + jnp.log(-jnp.expm1(-dt)),
        "gdn_out_norm": gain((N_A, GDN_DV)),
        "gdn_w_out": nrm((N_A, GDN_VW, D), GDN_VW ** -0.5),
        "sc_w_in": nrm((N_B, D, 3 * D), D ** -0.5),
        "sc_conv_w": nrm((N_B, SC_CONV, D), SC_CONV ** -0.5),
        "sc_w_out": nrm((N_B, D, D), D ** -0.5),
        "moba_w_in": nrm((N_C, D, 3 * D), D ** -0.5),
        "moba_q_norm": gain((N_C, ATT_DH)),
        "moba_k_norm": gain((N_C, ATT_DH)),
        "moba_w_out": nrm((N_C, D, D), D ** -0.5),
    }


def reference(x, positions, norm_ffn1, norm_mix, norm_ffn2, ffn1_w_in, ffn1_w_out,
              ffn2_w_in, ffn2_w_out, gdn_w_in, gdn_conv_w, gdn_a_log, gdn_dt_bias,
              gdn_out_norm, gdn_w_out, sc_w_in, sc_conv_w, sc_w_out, moba_w_in,
              moba_q_norm, moba_k_norm, moba_w_out):
    for i in range(DEPTH):
        kind, j = i % N_MIXERS, i // N_MIXERS
        x = x + 0.5 * swiglu(rmsnorm(x, norm_ffn1[i]), ffn1_w_in[i], ffn1_w_out[i])
        h = rmsnorm(x, norm_mix[i])
        if kind == 0:
            m = gated_deltanet(h, gdn_w_in[j], gdn_conv_w[j], gdn_a_log[j], gdn_dt_bias[j],
                               gdn_out_norm[j], gdn_w_out[j])
        elif kind == 1:
            m = short_conv(h, sc_w_in[j], sc_conv_w[j], sc_w_out[j])
        else:
            m = moba_attention(h, positions, moba_w_in[j], moba_q_norm[j], moba_k_norm[j],
                               moba_w_out[j])
        x = x + m
        x = x + 0.5 * swiglu(rmsnorm(x, norm_ffn2[i]), ffn2_w_in[i], ffn2_w_out[i])
    return x
```

```cpp
#include <hip/hip_runtime.h>
#include <cstdio>
#include <cstdint>
#define MK_LAS __attribute__((address_space(3)))
constexpr int MK_MISC_ABS = 155648 + 320;
__device__ __forceinline__ int mk_hwslot() { return (int)(__builtin_amdgcn_s_getreg((5 << 11) | 4) & 63u); }
__device__ __forceinline__ int mk_tid() {
    const unsigned w = ((const volatile MK_LAS unsigned*)(unsigned)MK_MISC_ABS)[32 + mk_hwslot()];
    int l_; asm volatile("v_mbcnt_lo_u32_b32 %0, -1, 0\n\tv_mbcnt_hi_u32_b32 %0, -1, %0" : "=v"(l_));
    return __builtin_amdgcn_readfirstlane((int)w) * 64 + l_;
}
namespace pg8 {
#define PG8_LAS __attribute__((address_space(3)))
typedef unsigned short bf16_t;
typedef short bf16x8 __attribute__((ext_vector_type(8)));
typedef float f32x4 __attribute__((ext_vector_type(4)));
typedef unsigned u32x4 __attribute__((ext_vector_type(4)));
typedef int i32x4 __attribute__((ext_vector_type(4)));
typedef int i32x8 __attribute__((ext_vector_type(8)));
__device__ __forceinline__ f32x4 mma_f8(bf16x8 a0, bf16x8 a1, bf16x8 b0, bf16x8 b1, f32x4 c) {
    const i32x8 A = __builtin_shufflevector(__builtin_bit_cast(i32x4, a0), __builtin_bit_cast(i32x4, a1), 0, 1, 2, 3, 4, 5, 6, 7);
    const i32x8 B = __builtin_shufflevector(__builtin_bit_cast(i32x4, b0), __builtin_bit_cast(i32x4, b1), 0, 1, 2, 3, 4, 5, 6, 7);
    return __builtin_amdgcn_mfma_scale_f32_16x16x128_f8f6f4(A, B, c, 0, 0, 0, 0, 0, 0);
}
constexpr int BM = 256, BK = 64, HALF = 128, HTB = HALF * BK * 2  , STAGE_BYTES = 8 * HTB, NXCD = 8, WGM = 8;

__host__ __device__ __forceinline__ int lds_byte(int r, int c) { const int st = (r >> 4) * 2 + (c >> 5), rr = r & 15, cc = c & 31, ob = rr * 64 + cc * 2; return st * 1024 + (ob ^ (((ob >> 9) & 1) << 5)); }
__host__ __device__ __forceinline__ void stage_rc(int b, int& R, int& C) { const int st = b / 1024, sb = b % 1024, swz = sb ^ (((sb >> 9) & 1) << 5); R = (st >> 1) * 16 + swz / 64; C = (st & 1) * 32 + (swz % 64) / 2; }
__host__ __device__ __forceinline__ int perm32(int rho) { const int n = rho >> 4, i = rho & 15; return 8 * (i >> 2) + 4 * n + (i & 3); }

struct Unit { int pm, pn; };
struct Gemm { const bf16_t* A; const bf16_t* Bt; int M, N, K; };

struct StaticOrder {
    int nM, nN, nwg, G, c;
    __host__ __device__ void init(int M, int N, int G_, int c_) { nM = M / BM; nN = N / BM; nwg = nM * nN; G = G_; c = c_; }
    __host__ __device__ bool next(int i, Unit& u) const {
        const long L = (long)i * G + c; if (L >= nwg) return false;
        int wgid = (int)L; { const int q = nwg / NXCD, r = nwg % NXCD, xcd = wgid % NXCD, off = wgid / NXCD; wgid = (xcd < r ? xcd * (q + 1) : r * (q + 1) + (xcd - r) * q) + off; }
        const int nig = WGM * nN, gid = wgid / nig, fm = gid * WGM, gsz = (nM - fm) < WGM ? (nM - fm) : WGM;
        u.pm = fm + ((wgid % nig) % gsz); u.pn = (wgid % nig) / gsz; return true;
    }
    __device__ __forceinline__ void a_ready(const Unit&) const {}
    __device__ __forceinline__ void done(const Unit&) const {}
};
typedef float f32x2v __attribute__((ext_vector_type(2)));
typedef __bf16 bf2v __attribute__((ext_vector_type(2)));
__device__ __forceinline__ unsigned pkbf(float lo, float hi) { f32x2v v = {lo, hi}; return __builtin_bit_cast(unsigned, __builtin_convertvector(v, bf2v)); }
__device__ __forceinline__ float silu_f(float x) { return x * __builtin_amdgcn_rcpf(1.0f + __builtin_amdgcn_exp2f(-1.4426950408889634f * x)); }
__device__ __forceinline__ u32x4 pack8f(f32x4 a, f32x4 b) { u32x4 w; w.x = pkbf(a[0], a[1]); w.y = pkbf(a[2], a[3]); w.z = pkbf(b[0], b[1]); w.w = pkbf(b[2], b[3]); return w; }
constexpr float RMS_EPS = 1e-6f;
constexpr float F8_HS = 8.0f, F8_WS = 1024.0f, F8_XS = 16.0f;
typedef unsigned u32x2 __attribute__((ext_vector_type(2)));
__device__ __forceinline__ float f8c(float v, float sc) { return __builtin_amdgcn_fmed3f(v * sc, -448.f, 448.f); }
__device__ __forceinline__ unsigned pk4f8(float a, float b, float c, float d, float sc) { int w = __builtin_amdgcn_cvt_pk_fp8_f32(f8c(a, sc), f8c(b, sc), 0, false); w = __builtin_amdgcn_cvt_pk_fp8_f32(f8c(c, sc), f8c(d, sc), w, true); return (unsigned)w; }
template <int MODE, bool O8 = false> struct EpiIn {
    static constexpr bool PERM = true, AFTER_DRAIN = false;
    const unsigned long long* rowss; bf16_t* O0; bf16_t* O1; float* OF; int ldc; float usc = 1.0f;
    __device__ __forceinline__ void operator()(const f32x4 (&acc)[2][2][4][2], const Unit& u, int wr, int wc, int fr, int fq) const {
        const int row0 = u.pm * BM + wr * 64 + fr; const int cw = wc * 32 + 8 * fq;
#pragma unroll
        for (int ai = 0; ai < 2; ++ai)
#pragma unroll
            for (int m = 0; m < 4; ++m) {
                const int row = row0 + ai * HALF + m * 16;
                const float rs = usc * (1.0f / sqrtf((float)rowss[row] * (1.0f / (4096.0f * 16777216.0f)) + RMS_EPS));
                if constexpr (MODE == 0) {
                    f32x4 g0 = acc[ai][0][m][0] * rs, g1 = acc[ai][0][m][1] * rs, u0 = acc[ai][1][m][0] * rs, u1 = acc[ai][1][m][1] * rs;
#pragma unroll
                    for (int j = 0; j < 4; ++j) { g0[j] = silu_f(g0[j]) * u0[j]; g1[j] = silu_f(g1[j]) * u1[j]; }
                    if constexpr (O8) { u32x2 w; w.x = pk4f8(g0[0], g0[1], g0[2], g0[3], F8_HS); w.y = pk4f8(g1[0], g1[1], g1[2], g1[3], F8_HS);
                        *(u32x2*)((unsigned char*)O0 + (size_t)row * ldc + u.pn * HALF + cw) = w; }
                    else *(u32x4*)(O0 + (size_t)row * ldc + u.pn * HALF + cw) = pack8f(g0, g1);
                } else if constexpr (MODE == 1) {
#pragma unroll
                    for (int bj = 0; bj < 2; ++bj) *(u32x4*)(O0 + (size_t)row * ldc + u.pn * BM + bj * HALF + cw) = pack8f(acc[ai][bj][m][0] * rs, acc[ai][bj][m][1] * rs);
                } else if constexpr (MODE == 2) {
                    if (u.pn < 32) { const f32x4 a0 = (acc[ai][0][m][0] * rs) * (acc[ai][1][m][0] * rs), a1 = (acc[ai][0][m][1] * rs) * (acc[ai][1][m][1] * rs);
                        *(u32x4*)(O0 + (size_t)row * 4096 + u.pn * HALF + cw) = pack8f(a0, a1); }
                    else {
#pragma unroll
                        for (int bj = 0; bj < 2; ++bj) *(u32x4*)(O1 + (size_t)row * 4096 + (u.pn - 32) * BM + bj * HALF + cw) = pack8f(acc[ai][bj][m][0] * rs, acc[ai][bj][m][1] * rs); }
                } else {
                    if (u.pn < 64) {
#pragma unroll
                        for (int bj = 0; bj < 2; ++bj) *(u32x4*)(O0 + (size_t)row * 16384 + u.pn * BM + bj * HALF + cw) = pack8f(acc[ai][bj][m][0] * rs, acc[ai][bj][m][1] * rs); }
                    else if (wc < 2) { *(f32x4*)(OF + (size_t)row * 64 + cw) = acc[ai][0][m][0] * rs; *(f32x4*)(OF + (size_t)row * 64 + cw + 4) = acc[ai][0][m][1] * rs; }
                }
            }
    }
};
template <bool FINAL, bool X8 = false> struct EpiRes {
    static constexpr bool PERM = true, AFTER_DRAIN = false;
    float* out; bf16_t* xb; unsigned long long* rowss_next; float scale; unsigned char* x8 = nullptr;
    __device__ __forceinline__ void operator()(const f32x4 (&acc)[2][2][4][2], const Unit& u, int wr, int wc, int fr, int fq) const {
        const int row0 = u.pm * BM + wr * 64 + fr, col0 = u.pn * BM + wc * 32 + 8 * fq;
#pragma unroll
        for (int ai = 0; ai < 2; ++ai) {
            u32x4 bs[4][2];
#pragma unroll
            for (int m = 0; m < 4; ++m)
#pragma unroll
                for (int bj = 0; bj < 2; ++bj) bs[m][bj] = *(const u32x4*)(xb + (size_t)(row0 + ai * HALF + m * 16) * 4096 + col0 + bj * HALF);
#pragma unroll
            for (int m = 0; m < 4; ++m) {
                const int row = row0 + ai * HALF + m * 16; const size_t off = (size_t)row * 4096 + col0; float ss = 0.f;
#pragma unroll
                for (int bj = 0; bj < 2; ++bj) {
                    const u32x4 b = bs[m][bj];
                    f32x4 o0, o1;
                    o0[0] = __builtin_bit_cast(float, b.x << 16) + acc[ai][bj][m][0][0] * scale; o0[1] = __builtin_bit_cast(float, b.x & 0xffff0000u) + acc[ai][bj][m][0][1] * scale;
                    o0[2] = __builtin_bit_cast(float, b.y << 16) + acc[ai][bj][m][0][2] * scale; o0[3] = __builtin_bit_cast(float, b.y & 0xffff0000u) + acc[ai][bj][m][0][3] * scale;
                    o1[0] = __builtin_bit_cast(float, b.z << 16) + acc[ai][bj][m][1][0] * scale; o1[1] = __builtin_bit_cast(float, b.z & 0xffff0000u) + acc[ai][bj][m][1][1] * scale;
                    o1[2] = __builtin_bit_cast(float, b.w << 16) + acc[ai][bj][m][1][2] * scale; o1[3] = __builtin_bit_cast(float, b.w & 0xffff0000u) + acc[ai][bj][m][1][3] * scale;
                    if constexpr (FINAL) { *(f32x4*)(out + off + bj * HALF) = o0; *(f32x4*)(out + off + bj * HALF + 4) = o1; }
                    else { const u32x4 w = pack8f(o0, o1); *(u32x4*)(xb + off + bj * HALF) = w;
                        const float r0 = __builtin_bit_cast(float, w.x << 16), r1 = __builtin_bit_cast(float, w.x & 0xffff0000u), r2 = __builtin_bit_cast(float, w.y << 16), r3 = __builtin_bit_cast(float, w.y & 0xffff0000u);
                        const float r4 = __builtin_bit_cast(float, w.z << 16), r5 = __builtin_bit_cast(float, w.z & 0xffff0000u), r6 = __builtin_bit_cast(float, w.w << 16), r7 = __builtin_bit_cast(float, w.w & 0xffff0000u);
                        ss += ((r0 * r0 + r1 * r1) + (r2 * r2 + r3 * r3)) + ((r4 * r4 + r5 * r5) + (r6 * r6 + r7 * r7));
                        if constexpr (X8) { u32x2 w8; w8.x = pk4f8(r0, r1, r2, r3, F8_XS); w8.y = pk4f8(r4, r5, r6, r7, F8_XS); *(u32x2*)(x8 + off + bj * HALF) = w8; } }
                }
                if constexpr (!FINAL) { ss += __shfl_xor(ss, 16); ss += __shfl_xor(ss, 32);
                    if (fq == 0) __hip_atomic_fetch_add(rowss_next + row, (unsigned long long)(ss * 16777216.0f + 0.5f), __ATOMIC_RELAXED, __HIP_MEMORY_SCOPE_AGENT); }
            }
            asm volatile("" ::: "memory");
        }
    }
};
template <class Epi, class Sched, bool ALIGN_EPI = false, bool SP2 = false, bool F8 = false>
__device__ __forceinline__ void gemm_phase(PG8_LAS unsigned char* lds, const Gemm g, const Sched& S, const Epi& E) {
    int tid_ = mk_tid(); asm volatile("" : "+v"(tid_));
    const int tid = tid_, wid = __builtin_amdgcn_readfirstlane(tid >> 6), lane = tid & 63, wr = wid >> 2, wc = wid & 3, fr = lane & 15, fq = lane >> 4;
    const int K = g.K, nt = K / BK;
    unsigned voffA[2], voffB[2];
#pragma unroll
    for (int i = 0; i < 2; ++i) { int R, C; stage_rc(tid * 16 + i * 8192, R, C); const int Rb = Epi::PERM ? ((R & ~31) + perm32(R & 31)) : R;
        voffA[i] = (unsigned)(R * K + C) * 2u; voffB[i] = (unsigned)(Rb * K + C) * 2u; }
    const size_t kstep = (size_t)(BK * 2);
    const size_t hstep = (size_t)HALF * K * 2;
    const size_t tstep = 2 * hstep;
    const unsigned ldsw = (unsigned)wid * 1024u;
    const int aoff = lds_byte(wr * 64 + fr, fq * 8), boff = lds_byte(wc * 32 + fr, fq * 8);
#define PG8_SA(b, h) (((b) * 2 + (h)) * HTB)
#define PG8_SB(b, h) ((4 + (b) * 2 + (h)) * HTB)
#define PG8_STAGE(bufoff, gbase, voff) do { const char* gb_ = (const char*)(gbase); if constexpr (F8) asm volatile("" : "+s"(gb_));     \
        _Pragma("unroll") for (int _i = 0; _i < 2; ++_i) \
        __builtin_amdgcn_global_load_lds((const unsigned*)(gb_ + (voff)[_i]), (PG8_LAS unsigned*)(lds + (bufoff) + ldsw + _i * 8192), 16, 0, 0); } while (0)
#define PG8_LDA(dst, b, h) do { _Pragma("unroll") for (int m = 0; m < 4; ++m) _Pragma("unroll") for (int k = 0; k < 2; ++k) dst[m][k] = *(const PG8_LAS bf16x8*)(lds + PG8_SA(b, h) + aoff + m * 2048 + k * 1024); } while (0)
#define PG8_LDB(dst, b, h) do { _Pragma("unroll") for (int n = 0; n < 2; ++n) _Pragma("unroll") for (int k = 0; k < 2; ++k) dst[n][k] = *(const PG8_LAS bf16x8*)(lds + PG8_SB(b, h) + boff + n * 2048 + k * 1024); } while (0)
#define PG8_MMA(ai, bj, At, Bt) do { __builtin_amdgcn_s_setprio(1); _Pragma("unroll") for (int m = 0; m < 4; ++m) _Pragma("unroll") for (int n = 0; n < 2; ++n) { \
        if constexpr (F8) acc[ai][bj][m][n] = mma_f8(Bt[n][0], Bt[n][1], At[m][0], At[m][1], acc[ai][bj][m][n]); \
        else { _Pragma("unroll") for (int k = 0; k < 2; ++k) acc[ai][bj][m][n] = __builtin_amdgcn_mfma_f32_16x16x32_bf16(Bt[n][k], At[m][k], acc[ai][bj][m][n], 0, 0, 0); } } __builtin_amdgcn_s_setprio(0); } while (0)
#define PG8_WAIT_V(n) asm volatile("s_waitcnt vmcnt(" #n ")" ::: "memory")
#define PG8_WAIT_L(n) asm volatile("s_waitcnt lgkmcnt(" #n ")" ::: "memory")
#define PG8_BAR __builtin_amdgcn_s_barrier()
#define PG8_SCHED __builtin_amdgcn_sched_barrier(0)
    Unit cur, nxt; int ui = 0;
    if (!S.next(0, cur)) return;
    f32x4 acc[2][2][4][2];
#pragma unroll
    for (int a = 0; a < 2; ++a)
#pragma unroll
        for (int b = 0; b < 2; ++b)
#pragma unroll
            for (int m = 0; m < 4; ++m)
#pragma unroll
                for (int n = 0; n < 2; ++n) acc[a][b][m][n] = (f32x4){0.f, 0.f, 0.f, 0.f};
    bf16x8 At[4][2], B0[2][2], B1[2][2];
    const char* cA = (const char*)g.A + (size_t)cur.pm * tstep; const char* cB = (const char*)g.Bt + (size_t)cur.pn * tstep;
    S.a_ready(cur);
    if constexpr (SP2) {
        PG8_STAGE(PG8_SB(0, 0), cB, voffB); PG8_STAGE(PG8_SB(0, 1), cB + hstep, voffB); PG8_STAGE(PG8_SA(0, 0), cA, voffA); PG8_STAGE(PG8_SA(0, 1), cA + hstep, voffA);
        if (wr == 1) PG8_BAR;
        PG8_WAIT_V(2); PG8_BAR;
        PG8_STAGE(PG8_SB(1, 0), cB + kstep, voffB); PG8_STAGE(PG8_SA(1, 0), cA + kstep, voffA); PG8_STAGE(PG8_SB(1, 1), cB + hstep + kstep, voffB);
        PG8_WAIT_V(6); PG8_BAR;
    } else {
        PG8_STAGE(PG8_SB(0, 0), cB, voffB); PG8_STAGE(PG8_SA(0, 0), cA, voffA); PG8_STAGE(PG8_SB(0, 1), cB + hstep, voffB); PG8_STAGE(PG8_SA(0, 1), cA + hstep, voffA);
        if (wr == 1) PG8_BAR;
        PG8_WAIT_V(4); PG8_BAR;
        PG8_STAGE(PG8_SB(1, 0), cB + kstep, voffB); PG8_STAGE(PG8_SA(1, 0), cA + kstep, voffA); PG8_STAGE(PG8_SB(1, 1), cB + hstep + kstep, voffB);
        PG8_WAIT_V(6); PG8_BAR;
    }
    for (;;) {
        const bool has_next = S.next(ui + 1, nxt);
        const char* nA = has_next ? (const char*)g.A + (size_t)nxt.pm * tstep : cA; const char* nB = has_next ? (const char*)g.Bt + (size_t)nxt.pn * tstep : cB;
        for (int t = 0; t < nt; t += 2) {
            const bool last = (t == nt - 2);
            const char* a1 = cA + (size_t)(t + 1) * kstep;
            const char* a2 = last ? nA : cA + (size_t)(t + 2) * kstep; const char* b2 = last ? nB : cB + (size_t)(t + 2) * kstep;
            const char* a3 = a2 + kstep; const char* b3 = b2 + kstep;
            if (last && has_next) S.a_ready(nxt);
            if constexpr (SP2) {
            PG8_LDB(B0, 0, 0); PG8_LDB(B1, 0, 1); PG8_SCHED; PG8_LDA(At, 0, 0); PG8_STAGE(PG8_SA(1, 1), a1 + hstep, voffA);
            PG8_WAIT_V(8); PG8_WAIT_L(0); PG8_BAR; PG8_MMA(0, 0, At, B0); PG8_MMA(0, 1, At, B1); PG8_BAR; PG8_SCHED;
            PG8_LDA(At, 0, 1); PG8_STAGE(PG8_SB(0, 0), b2, voffB); PG8_STAGE(PG8_SB(0, 1), b2 + hstep, voffB); PG8_STAGE(PG8_SA(0, 0), a2, voffA);
            PG8_WAIT_V(8); PG8_WAIT_L(0); PG8_BAR; PG8_MMA(1, 0, At, B0); PG8_MMA(1, 1, At, B1); PG8_BAR; PG8_SCHED;
            PG8_LDB(B0, 1, 0); PG8_LDB(B1, 1, 1); PG8_SCHED; PG8_LDA(At, 1, 0); PG8_STAGE(PG8_SA(0, 1), a2 + hstep, voffA);
            PG8_WAIT_V(8); PG8_WAIT_L(0); PG8_BAR; PG8_MMA(0, 0, At, B0); PG8_MMA(0, 1, At, B1); PG8_BAR; PG8_SCHED;
            PG8_LDA(At, 1, 1); PG8_STAGE(PG8_SB(1, 0), b3, voffB); PG8_STAGE(PG8_SB(1, 1), b3 + hstep, voffB); PG8_STAGE(PG8_SA(1, 0), a3, voffA);
            PG8_WAIT_V(8); PG8_WAIT_L(0); PG8_BAR; PG8_MMA(1, 0, At, B0); PG8_MMA(1, 1, At, B1); PG8_BAR; PG8_SCHED;
            } else {
            PG8_LDB(B0, 0, 0); PG8_SCHED; PG8_LDA(At, 0, 0); PG8_STAGE(PG8_SA(1, 1), a1 + hstep, voffA);
            PG8_WAIT_L(8); PG8_BAR; PG8_WAIT_L(0); PG8_MMA(0, 0, At, B0); PG8_BAR; PG8_SCHED;
            PG8_LDB(B1, 0, 1); PG8_STAGE(PG8_SB(0, 0), b2, voffB);
            PG8_BAR; PG8_WAIT_L(0); PG8_MMA(0, 1, At, B1); PG8_BAR;
            PG8_LDA(At, 0, 1); PG8_STAGE(PG8_SA(0, 0), a2, voffA);
            PG8_BAR; PG8_WAIT_L(0); PG8_MMA(1, 0, At, B0); PG8_BAR; PG8_SCHED;
            PG8_STAGE(PG8_SB(0, 1), b2 + hstep, voffB);
            PG8_WAIT_V(6); PG8_BAR; PG8_MMA(1, 1, At, B1); PG8_BAR;
            PG8_LDB(B0, 1, 0); PG8_SCHED; PG8_LDA(At, 1, 0); PG8_STAGE(PG8_SA(0, 1), a2 + hstep, voffA);
            PG8_WAIT_L(8); PG8_BAR; PG8_WAIT_L(0); PG8_MMA(0, 0, At, B0); PG8_BAR; PG8_SCHED;
            PG8_LDB(B1, 1, 1); PG8_STAGE(PG8_SB(1, 0), b3, voffB);
            PG8_BAR; PG8_WAIT_L(0); PG8_MMA(0, 1, At, B1); PG8_BAR;
            PG8_LDA(At, 1, 1); PG8_STAGE(PG8_SA(1, 0), a3, voffA);
            PG8_BAR; PG8_WAIT_L(0); PG8_MMA(1, 0, At, B0); PG8_BAR; PG8_SCHED;
            PG8_STAGE(PG8_SB(1, 1), b3 + hstep, voffB);
            PG8_WAIT_V(6); PG8_BAR; PG8_MMA(1, 1, At, B1); PG8_BAR;
            }
        }
        if constexpr (ALIGN_EPI) { if (wr == 0) PG8_BAR; }
        if constexpr (!Epi::AFTER_DRAIN) {
            if constexpr (F8) { int t2_; asm volatile("v_mbcnt_lo_u32_b32 %0, -1, 0\n\tv_mbcnt_hi_u32_b32 %0, -1, %0" : "=v"(t2_)); E(acc, cur, wr, wc, t2_ & 15, t2_ >> 4); }
            else E(acc, cur, wr, wc, fr, fq);
            S.done(cur); }
        if (!has_next) break;
#pragma unroll
        for (int a = 0; a < 2; ++a)
#pragma unroll
            for (int b = 0; b < 2; ++b)
#pragma unroll
                for (int m = 0; m < 4; ++m)
#pragma unroll
                    for (int n = 0; n < 2; ++n) acc[a][b][m][n] = (f32x4){0.f, 0.f, 0.f, 0.f};
        cur = nxt; cA = nA; cB = nB; ++ui;
        if constexpr (ALIGN_EPI) { if (wr == 1) PG8_BAR; }
    }
    PG8_WAIT_V(0);
    if constexpr (!ALIGN_EPI) { if (wr == 0) PG8_BAR; }
    PG8_BAR;
    if constexpr (Epi::AFTER_DRAIN) { E.fused(acc, cur, wr, wc, fr, fq, lds, wid, lane); S.done(cur); }
#undef PG8_SA
#undef PG8_SB
#undef PG8_STAGE
#undef PG8_LDA
#undef PG8_LDB
#undef PG8_MMA
#undef PG8_WAIT_V
#undef PG8_WAIT_L
#undef PG8_BAR
#undef PG8_SCHED
}
}
constexpr int NWAVES = 8;
constexpr int BATCH = 2, SEQ = 8192, D = 4096, FF = 5632, NH = 32, HD = 128, DEPTH = 4;
constexpr int M = BATCH * SEQ;
constexpr int GDN_N = 16448, GDN_NP = 16640;
constexpr size_t MiB = 1u << 20;
constexpr size_t WS_CTL = 0, CTL_ZERO_BYTES = 3 * MiB;
constexpr size_t WS_ROWSS = 1 * MiB;
constexpr size_t WS_ROPE = 4 * MiB;
constexpr size_t WS_WB0 = 16 * MiB, WS_WB1 = 160 * MiB;
constexpr size_t WS_XB = 304 * MiB;
constexpr size_t WS_SCR = 432 * MiB;
constexpr size_t WS_HID = WS_SCR;
constexpr size_t WS_SC_U = WS_SCR, WS_SC_GB = WS_SCR + 128 * MiB, WS_SC_A2 = WS_SCR + 256 * MiB;
constexpr size_t WS_MB_PROJ = WS_SCR;
constexpr size_t WS_MB_Q = WS_SCR + 384 * MiB, WS_MB_K = WS_SCR + 512 * MiB;
constexpr size_t WS_MB_O = WS_SCR + 640 * MiB;
constexpr size_t WS_MB_KMEAN = WS_SCR + 768 * MiB;
constexpr size_t WS_MB_SEL = WS_SCR + 770 * MiB;
constexpr size_t WS_MB_LIST = WS_SCR + 772 * MiB;
constexpr size_t WS_MB_CNT = WS_SCR + 836 * MiB;
constexpr size_t WS_MB_LSE = WS_SCR + 838 * MiB;
constexpr size_t WS_MB_OPART = WS_SCR + 848 * MiB;
constexpr size_t WS_GD_PROJ = WS_SCR;
constexpr size_t WS_GD_AB = WS_SCR + 512 * MiB;
constexpr size_t WS_GD_TAB = WS_SCR + 516 * MiB;
constexpr size_t WS_GD_QN = WS_SCR + 524 * MiB, WS_GD_KN = WS_GD_QN + 128 * MiB, WS_GD_KWT = WS_GD_KN + 128 * MiB, WS_GD_VUT = WS_GD_KWT + 128 * MiB,
                 WS_GD_KDT = WS_GD_VUT + 128 * MiB, WS_GD_QD = WS_GD_KDT + 128 * MiB, WS_GD_WF = WS_GD_QD + 128 * MiB, WS_GD_QKM = WS_GD_WF + 128 * MiB,
                 WS_GD_U = WS_GD_QKM + 64 * MiB, WS_GD_O = WS_GD_U + 256 * MiB, WS_GD_OG = WS_GD_O + 256 * MiB, WS_X8 = WS_GD_OG + 128 * MiB  , WS_END = WS_X8 + 64 * MiB;
static_assert(WS_END <= (size_t)3400 * MiB, "d_ws map must stay below the guaranteed workspace size");
constexpr int CW_TMO = 0, CW_CODE = 1, CW_QHEAD = 1024, CW_PROG = 2048  , CW_BAR = 4096;
constexpr int RING_OFF = 0, RING_BYTES = 155648;
constexpr int LDSCTL_OFF = RING_BYTES, MISC_OFF = LDSCTL_OFF + 320;
constexpr int LDS_BYTES = 163840;
static_assert(MISC_OFF + 4 * 96 <= LDS_BYTES && MISC_OFF == MK_MISC_ABS, "LDS map");

#define GAS __attribute__((address_space(1)))
#define LAS __attribute__((address_space(3)))
typedef unsigned short bf16;
typedef unsigned v4u __attribute__((ext_vector_type(4)));
typedef unsigned v2u __attribute__((ext_vector_type(2)));
typedef float f32x4 __attribute__((ext_vector_type(4)));
typedef float f32x16 __attribute__((ext_vector_type(16)));
typedef float f32x2v __attribute__((ext_vector_type(2)));
typedef short bf16x8 __attribute__((ext_vector_type(8)));
typedef GAS unsigned gu32;
typedef GAS unsigned long long gu64;
#define RLX_AGENT __ATOMIC_RELAXED, __HIP_MEMORY_SCOPE_AGENT
#define LDS_WAIT() asm volatile("s_waitcnt lgkmcnt(0)" ::: "memory")
#define VM_WAIT() asm volatile("s_waitcnt vmcnt(0)" ::: "memory")
using pg8::pkbf;
__device__ __forceinline__ float bf2f(unsigned short b) { return __builtin_bit_cast(float, (unsigned)b << 16); }
__device__ __forceinline__ float bflo(unsigned w) { return __builtin_bit_cast(float, w << 16); }
__device__ __forceinline__ float bfhi(unsigned w) { return __builtin_bit_cast(float, w & 0xffff0000u); }
#define DPP_ADD(x, ctrl) ((x) + __builtin_bit_cast(float, __builtin_amdgcn_update_dpp(0, __builtin_bit_cast(int, (x)), (ctrl), 0xf, 0xf, true)))
__device__ __forceinline__ float wave_sum_dpp(float v) {
    v = DPP_ADD(v, 0xB1);
    v = DPP_ADD(v, 0x4E);
    v = DPP_ADD(v, 0x141);
    v = DPP_ADD(v, 0x140);
    const int b = __builtin_bit_cast(int, v);
    return (__builtin_bit_cast(float, __builtin_amdgcn_readlane(b, 0)) + __builtin_bit_cast(float, __builtin_amdgcn_readlane(b, 16))) +
           (__builtin_bit_cast(float, __builtin_amdgcn_readlane(b, 32)) + __builtin_bit_cast(float, __builtin_amdgcn_readlane(b, 48)));
}
__device__ __forceinline__ float row16_sum_dpp(float v) {
    v = DPP_ADD(v, 0xB1); v = DPP_ADD(v, 0x4E); v = DPP_ADD(v, 0x141); v = DPP_ADD(v, 0x140); return v;
}
__device__ __forceinline__ float wave_sum(float v) {
#pragma unroll
    for (int o = 1; o < 64; o <<= 1) v += __shfl_xor(v, o);
    return v;
}
#define XB_TMO      128
#define XB_XCNT(j)  (256  + 64 * (j))
#define XB_XSUB(j)  (1280 + 64 * (j))
#define XB_XGEN(j)  (2304 + 64 * (j))
#define XB_TOP      3328
#define XB_TOPGEN   3392
#define XCD_BAR_WORDS 3456
#define XB_SPIN_CAP (1u << 27)

__device__ __forceinline__ unsigned xb_ld(unsigned* p)              { return __hip_atomic_load(p, __ATOMIC_RELAXED, __HIP_MEMORY_SCOPE_AGENT); }
__device__ __forceinline__ unsigned xb_add(unsigned* p, unsigned v) { return __hip_atomic_fetch_add(p, v, __ATOMIC_RELAXED, __HIP_MEMORY_SCOPE_AGENT); }
__device__ __forceinline__ unsigned xb_xcc_id() { return (unsigned)__builtin_amdgcn_s_getreg((3 << 11) | 20) & 0xFu; }
#define XB_SPIN(cond, bar) do { unsigned _sp = 0; while (cond) { __builtin_amdgcn_s_sleep(1); \
    if ((++_sp & 255u) == 0u) { if (xb_ld(&(bar)[XB_TMO])) break; if (_sp > XB_SPIN_CAP) { atomicAdd(&(bar)[XB_TMO], 1u); break; } } } } while (0)

struct XcdBarrier {
    unsigned* bar; unsigned x;
    volatile LAS unsigned* st;
};

__device__ __forceinline__ XcdBarrier xcd_barrier_post(unsigned* bar, volatile LAS unsigned* st) {
    XcdBarrier b; b.bar = bar; b.x = xb_xcc_id(); b.st = st;
    if (mk_tid() == 0) (void)xb_add(&bar[XB_XCNT(b.x)], 1u);
    return b;
}
__device__ __forceinline__ void xcd_barrier_complete(unsigned* bar, unsigned x, unsigned& nloc, unsigned& nx, unsigned G) {
    unsigned sum, cnt, mine, sp = 0u;
    for (;;) {
        sum = 0u; cnt = 0u; mine = 0u;
#pragma unroll
        for (unsigned j = 0; j < 16; ++j) { const unsigned c = xb_ld(&bar[XB_XCNT(j)]); sum += c; cnt += (c > 0u) ? 1u : 0u; mine = (j == x) ? c : mine; }
        if (sum == G) break;
        __builtin_amdgcn_s_sleep(1);
        if ((++sp & 255u) == 0u) { if (xb_ld(&bar[XB_TMO])) break; if (sp > XB_SPIN_CAP) { atomicAdd(&bar[XB_TMO], 1u); break; } }
    }
    nloc = mine > 0u ? mine : 1u; nx = cnt > 0u ? cnt : 1u;
}

__device__ __attribute__((noinline)) void xcd_barrier_fn(unsigned* bar_, unsigned x_, volatile LAS unsigned* st_) {
    XcdBarrier b; b.bar = bar_; b.x = x_; b.st = st_;
    asm volatile("s_waitcnt vmcnt(0)" ::: "memory");
    __syncthreads();
    if (mk_tid() == 0) {
        unsigned* bar = b.bar;
        __builtin_amdgcn_s_waitcnt(0);
        unsigned nloc = b.st[0], nx = b.st[1];
        if (nloc == 0u) { xcd_barrier_complete(bar, b.x, nloc, nx, b.st[9]); b.st[0] = nloc; b.st[1] = nx; }
        const unsigned old = xb_add(&bar[XB_XSUB(b.x)], 1u);
        const unsigned gen = old / nloc;
        if (old + 1u == (gen + 1u) * nloc) {
            __builtin_amdgcn_fence(__ATOMIC_RELEASE, "agent");
            asm volatile("s_waitcnt vmcnt(0)" ::: "memory");
            const unsigned og = xb_add(&bar[XB_TOP], 1u);
            const unsigned tg = og / nx;
            if (og + 1u == (tg + 1u) * nx) xb_add(&bar[XB_TOPGEN], 1u);
            else XB_SPIN(xb_ld(&bar[XB_TOPGEN]) == tg, bar);
            __builtin_amdgcn_fence(__ATOMIC_ACQUIRE, "agent");
            xb_add(&bar[XB_XGEN(b.x)], 1u);
            asm volatile("s_waitcnt vmcnt(0)" ::: "memory");
        } else {
            XB_SPIN(xb_ld(&bar[XB_XGEN(b.x)]) == gen, bar);
            __builtin_amdgcn_fence(__ATOMIC_ACQUIRE, "agent");
            asm volatile("s_waitcnt vmcnt(0)" ::: "memory");
        }
    }
    __syncthreads();
}

__device__ __forceinline__ void xcd_barrier(const XcdBarrier& b) { xcd_barrier_fn(b.bar, b.x, b.st); }
struct Frame {
    LAS unsigned char* lds;
    volatile LAS unsigned* MISC;
    gu32* ctl;
    int tid, lane, wave;
    int vcu, G, gw, NGW, bx;
    unsigned char* ws;
};
struct Args { const float* in[22]; float* out; unsigned char* ws; int ph_lo, ph_hi; };
#define AS4 __attribute__((address_space(4)))
typedef const char AS4* kargp;
template <class T> __device__ __forceinline__ T karg(kargp kp, int byteoff) { typedef T AS4 TA; return *(const TA*)(kp + byteoff); }
#define ARG_IN(kp, i) karg<const float*>(kp, 8 * (i))
#define ARG_OUT(kp) karg<float*>(kp, 176)
#define ARG_WS(kp) karg<unsigned char*>(kp, 184)
static_assert(sizeof(Args) == 200, "Args layout");

template <int MODE, int N> __device__ __forceinline__ int cvt_src_col(int nd) {
    if (MODE == 0) return nd < N ? nd : -1;
    const int t = nd >> 8, r = nd & 255;
    if (MODE == 1) return r < 128 ? 128 * t + r : FF + 128 * t + (r - 128);
    if (t < 32) return r < 128 ? D + 128 * t + r : 2 * D + 128 * t + (r - 128);
    return (t - 32) * 256 + r;
}
template <int K, int N, int ND, int MODE, bool Q8 = false, bool KP = false> __device__ __forceinline__ void cvt_weights(const Frame& F, const float* W, const float* gain, bf16* dst) {
    constexpr int nbn = ND / 64, nwitems = (K / 512) * nbn;
    static_assert(K % 512 == 0, "8 k blocks per workgroup item");
    for (int wit = F.vcu; wit < nwitems; wit += F.G) {
        const int kg = wit / nbn, nb = wit - kg * nbn, kb = kg * 8 + F.wave, k0 = kb * 64, nd = nb * 64 + F.lane;
        const int c = cvt_src_col<MODE, N>(nd);
        float v[64];
        const float* p = W + (size_t)(KP ? ((k0 & ~127) + ((k0 & 64) >> 2)) : k0) * N + (c >= 0 ? c : 0);
#pragma unroll
        for (int q = 0; q < 8; ++q) {
            const float* pq = p + (size_t)q * (KP ? 2 : 8) * N; asm volatile("" : "+v"(pq));
#pragma unroll
            for (int i = 0; i < 8; ++i) v[8 * q + i] = __builtin_nontemporal_load(pq + (size_t)(KP ? ((i & 3) * 32 + (i >> 2)) : i) * N); }
        if (MODE == 0 && ND != N) { if (c < 0) {
#pragma unroll
            for (int i = 0; i < 64; ++i) v[i] = 0.f; } }
        if (gain) { const int gvb = __builtin_bit_cast(int, gain[k0 + F.lane]);
#pragma unroll
            for (int i = 0; i < 64; ++i) v[i] *= __builtin_bit_cast(float, __builtin_amdgcn_readlane(gvb, i)); }
        if constexpr (Q8) {
            GAS v4u* o8 = (GAS v4u*)((unsigned char*)dst + (size_t)nd * K + k0);
#pragma unroll
            for (int q = 0; q < 4; ++q) { v4u w; w.x = pg8::pk4f8(v[16 * q], v[16 * q + 1], v[16 * q + 2], v[16 * q + 3], pg8::F8_WS); w.y = pg8::pk4f8(v[16 * q + 4], v[16 * q + 5], v[16 * q + 6], v[16 * q + 7], pg8::F8_WS);
                w.z = pg8::pk4f8(v[16 * q + 8], v[16 * q + 9], v[16 * q + 10], v[16 * q + 11], pg8::F8_WS); w.w = pg8::pk4f8(v[16 * q + 12], v[16 * q + 13], v[16 * q + 14], v[16 * q + 15], pg8::F8_WS); o8[q] = w; }
            continue; }
        GAS v4u* o = (GAS v4u*)(dst + (size_t)nd * K + k0);
#pragma unroll
        for (int q = 0; q < 8; ++q) { v4u w; w.x = pkbf(v[8 * q], v[8 * q + 1]); w.y = pkbf(v[8 * q + 2], v[8 * q + 3]); w.z = pkbf(v[8 * q + 4], v[8 * q + 5]); w.w = pkbf(v[8 * q + 6], v[8 * q + 7]); o[q] = w; }
    }
}
#define CVT_FFN_IN(kp, widx, gidx, L, dst, Q8)  cvt_weights<D, 2 * FF, 2 * FF, 1, Q8>(F, ARG_IN(kp, widx) + (size_t)(L) * D * 2 * FF, ARG_IN(kp, gidx) + (L) * D, dst)
#define CVT_FFN_OUT(kp, widx, L, dst, Q8)   cvt_weights<FF, D, D, 0, Q8>(F, ARG_IN(kp, widx) + (size_t)(L) * FF * D, nullptr, dst)
#define CVT_MIX_IN(kp, kind, L, jj, dst) do { const float* g_ = ARG_IN(kp, 3) + (L) * D; \
        if ((kind) == 0) cvt_weights<D, GDN_N, GDN_NP, 0>(F, ARG_IN(kp, 9) + (size_t)(jj) * D * GDN_N, g_, dst); \
        else if ((kind) == 1) cvt_weights<D, 3 * D, 3 * D, 2>(F, ARG_IN(kp, 15), g_, dst); \
        else cvt_weights<D, 3 * D, 3 * D, 0>(F, ARG_IN(kp, 18), g_, dst); } while (0)
#define CVT_MIX_OUT(kp, widx, jj, dst, KP)  cvt_weights<D, D, D, 0, false, KP>(F, ARG_IN(kp, widx) + (size_t)(jj) * D * D, nullptr, dst)
__device__ __forceinline__ void p0_rows(const Frame& F, const float* x, bf16* xb, unsigned long long* rowss) {
    for (int row = F.gw; row < M; row += F.NGW) {
        const GAS f32x4* xr = (const GAS f32x4*)(x + (size_t)row * D) + F.lane;
        GAS v2u* o8 = (GAS v2u*)(xb + (size_t)row * D) + F.lane;
        f32x4 v[16]; float s = 0.f;
#pragma unroll
        for (int j = 0; j < 16; ++j) { v[j] = __builtin_nontemporal_load(xr + 64 * j); s += (v[j].x * v[j].x + v[j].y * v[j].y) + (v[j].z * v[j].z + v[j].w * v[j].w); }
#pragma unroll
        for (int j = 0; j < 16; ++j) { v2u w; w.x = pkbf(v[j].x, v[j].y); w.y = pkbf(v[j].z, v[j].w); o8[64 * j] = w; }
        s = wave_sum(s);
        if (F.lane == 0) rowss[row] = (unsigned long long)(s * 16777216.0f + 0.5f);
    }
}
__device__ __forceinline__ void sc_conv(const Frame& F, const bf16* U, const bf16* GB, const float* cw, bf16* A2) {
    for (int unit = F.gw; unit < (M / 64) * 8; unit += F.NGW) {
        const int rc = unit >> 3, cs = unit & 7, r0 = rc * 64, c0 = cs * 512 + F.lane * 8;
        float w0[8], w1[8], w2[8];
#pragma unroll
        for (int j = 0; j < 8; ++j) { w0[j] = cw[c0 + j]; w1[j] = cw[D + c0 + j]; w2[j] = cw[2 * D + c0 + j]; }
        v4u p2 = {0u, 0u, 0u, 0u}, p1 = {0u, 0u, 0u, 0u};
        if ((r0 % SEQ) != 0) { p2 = *(const GAS v4u*)(U + (size_t)(r0 - 2) * D + c0); p1 = *(const GAS v4u*)(U + (size_t)(r0 - 1) * D + c0); }
#pragma unroll 4
        for (int r = 0; r < 64; ++r) {
            const size_t off = (size_t)(r0 + r) * D + c0;
            const v4u cu = __builtin_nontemporal_load((const GAS v4u*)(U + off)), g = __builtin_nontemporal_load((const GAS v4u*)(GB + off));
            v4u o;
#pragma unroll
            for (int q = 0; q < 4; ++q) {
                const float lo = bflo(g[q]) * (w0[2 * q] * bflo(p2[q]) + w1[2 * q] * bflo(p1[q]) + w2[2 * q] * bflo(cu[q]));
                const float hi = bfhi(g[q]) * (w0[2 * q + 1] * bfhi(p2[q]) + w1[2 * q + 1] * bfhi(p1[q]) + w2[2 * q + 1] * bfhi(cu[q]));
                o[q] = pkbf(lo, hi); }
            *(GAS v4u*)(A2 + off) = o;
            p2 = p1; p1 = cu;
        }
    }
}
constexpr int MB_BLK = 256, MB_NB = SEQ / MB_BLK, MB_TOPK = 3;
__device__ __forceinline__ void rope_table(const Frame& F, const int* pos, float* tab) {
    for (int i = F.gw * 64 + F.lane; i < M * 64; i += F.NGW * 64) {
        const int row = i >> 6, fi = i & 63;
        const double inv = exp2(-(double)fi * (13.287712379549449 / 64.0));
        const double ang = (double)pos[row] * inv; double s, c; sincos(ang, &s, &c);
        tab[i] = (float)c; tab[(size_t)M * 64 + i] = (float)s;
    }
}
__device__ __forceinline__ void moba_prep(const Frame& F, const bf16* PROJ, const float* qg, const float* kg, const float* rope, bf16* Qh, bf16* Kh, float* kmean) {
    LAS float* red = (LAS float*)(F.lds + RING_OFF);
    const int l5 = F.lane & 31, tp = F.lane >> 5;
    const float gq0 = qg[2 * l5], gq1 = qg[2 * l5 + 1], gq2 = qg[64 + 2 * l5], gq3 = qg[65 + 2 * l5];
    const float gk0 = kg[2 * l5], gk1 = kg[2 * l5 + 1], gk2 = kg[64 + 2 * l5], gk3 = kg[65 + 2 * l5];
    for (int unit = F.vcu; unit < BATCH * NH * MB_NB; unit += F.G) {
        const int blk = unit % MB_NB, h = (unit / MB_NB) % NH, b = unit / (MB_NB * NH);
        float ks0 = 0.f, ks1 = 0.f, ks2 = 0.f, ks3 = 0.f;
#pragma unroll 1
        for (int ib = 0; ib < 16; ib += 8) {
            unsigned lqa[8], lqb[8], lka[8], lkb[8]; float lc0[8], lc1[8], ls0[8], ls1[8];
#pragma unroll
            for (int t = 0; t < 8; ++t) {
                const int s = blk * MB_BLK + F.wave * 32 + (ib + t) * 2 + tp; const size_t row = (size_t)b * SEQ + s;
                const bf16* pq = PROJ + row * (3 * D) + h * HD; const bf16* pk = pq + D;
                lqa[t] = __builtin_nontemporal_load((const GAS unsigned*)(pq + 2 * l5)); lqb[t] = __builtin_nontemporal_load((const GAS unsigned*)(pq + 64 + 2 * l5));
                lka[t] = __builtin_nontemporal_load((const GAS unsigned*)(pk + 2 * l5)); lkb[t] = __builtin_nontemporal_load((const GAS unsigned*)(pk + 64 + 2 * l5));
                lc0[t] = rope[row * 64 + 2 * l5]; lc1[t] = rope[row * 64 + 2 * l5 + 1]; ls0[t] = rope[(size_t)M * 64 + row * 64 + 2 * l5]; ls1[t] = rope[(size_t)M * 64 + row * 64 + 2 * l5 + 1];
            }
#pragma unroll
            for (int t = 0; t < 8; ++t) {
                const int s = blk * MB_BLK + F.wave * 32 + (ib + t) * 2 + tp;
                const unsigned qa = lqa[t], qb = lqb[t], ka = lka[t], kb = lkb[t];
                const float c0 = lc0[t], c1 = lc1[t], s0 = ls0[t], s1 = ls1[t];
                float q0 = bflo(qa), q1 = bfhi(qa), q2 = bflo(qb), q3 = bfhi(qb), k0 = bflo(ka), k1 = bfhi(ka), k2 = bflo(kb), k3 = bfhi(kb);
                float sq = (q0 * q0 + q1 * q1) + (q2 * q2 + q3 * q3), sk = (k0 * k0 + k1 * k1) + (k2 * k2 + k3 * k3);
                sq = row16_sum_dpp(sq); sk = row16_sum_dpp(sk); sq += __shfl_xor(sq, 16); sk += __shfl_xor(sk, 16);
                const float rq = __builtin_amdgcn_rsqf(sq * (1.0f / 128.0f) + 1e-6f), rk = __builtin_amdgcn_rsqf(sk * (1.0f / 128.0f) + 1e-6f);
                q0 *= rq * gq0; q1 *= rq * gq1; q2 *= rq * gq2; q3 *= rq * gq3; k0 *= rk * gk0; k1 *= rk * gk1; k2 *= rk * gk2; k3 *= rk * gk3;
                const float qo0 = q0 * c0 - q2 * s0, qo1 = q1 * c1 - q3 * s1, qo2 = q2 * c0 + q0 * s0, qo3 = q3 * c1 + q1 * s1;
                const float ko0 = k0 * c0 - k2 * s0, ko1 = k1 * c1 - k3 * s1, ko2 = k2 * c0 + k0 * s0, ko3 = k3 * c1 + k1 * s1;
                const size_t ho = ((size_t)(b * NH + h) * SEQ + s) * HD;
                *(GAS unsigned*)(Qh + ho + 2 * l5) = pkbf(qo0, qo1); *(GAS unsigned*)(Qh + ho + 64 + 2 * l5) = pkbf(qo2, qo3);
                *(GAS unsigned*)(Kh + ho + 2 * l5) = pkbf(ko0, ko1); *(GAS unsigned*)(Kh + ho + 64 + 2 * l5) = pkbf(ko2, ko3);
                ks0 += ko0; ks1 += ko1; ks2 += ko2; ks3 += ko3;
            }
        }
        ks0 += __shfl_xor(ks0, 32); ks1 += __shfl_xor(ks1, 32); ks2 += __shfl_xor(ks2, 32); ks3 += __shfl_xor(ks3, 32);
        if (tp == 0) { red[F.wave * 128 + 2 * l5] = ks0; red[F.wave * 128 + 2 * l5 + 1] = ks1; red[F.wave * 128 + 64 + 2 * l5] = ks2; red[F.wave * 128 + 65 + 2 * l5] = ks3; }
        __syncthreads();
        if (F.tid < 128) { float a = 0.f;
#pragma unroll
            for (int w = 0; w < 8; ++w) a += red[w * 128 + F.tid];
            kmean[((size_t)(b * NH + h) * MB_NB + blk) * HD + F.tid] = a * (1.0f / 256.0f); }
        __syncthreads();
    }
}
__device__ __forceinline__ void moba_select(const Frame& F, const bf16* Qh, const float* kmean, unsigned* sel, float* LSE) {
    LAS float* km = (LAS float*)(F.lds + RING_OFF);
    for (int unit = F.vcu; unit < BATCH * NH * (SEQ / 512); unit += F.G) {
        const int part = unit % (SEQ / 512), bh = unit / (SEQ / 512);
        __syncthreads();
        for (int i = F.tid; i < MB_NB * HD; i += NWAVES * 64) km[i] = kmean[(size_t)bh * MB_NB * HD + i];
        __syncthreads();
        const int s = part * 512 + F.wave * 64 + F.lane, qblk = (part * 512 + F.wave * 64) / MB_BLK;
        const GAS v4u* qp = (const GAS v4u*)(Qh + ((size_t)bh * SEQ + s) * HD);
        v4u qv[16];
#pragma unroll
        for (int i = 0; i < 16; ++i) qv[i] = qp[i];
        float v0 = -INFINITY, v1 = -INFINITY, v2 = -INFINITY; int i0 = -1, i1 = -1, i2 = -1;
        for (int n = 0; n < qblk; ++n) {
            const LAS f32x4* kr = (const LAS f32x4*)(km + n * HD);
            float a0 = 0.f, a1 = 0.f;
#pragma unroll
            for (int i = 0; i < 16; ++i) { const f32x4 ka = kr[2 * i], kb = kr[2 * i + 1];
                a0 += bflo(qv[i].x) * ka.x + bfhi(qv[i].x) * ka.y; a1 += bflo(qv[i].y) * ka.z + bfhi(qv[i].y) * ka.w;
                a0 += bflo(qv[i].z) * kb.x + bfhi(qv[i].z) * kb.y; a1 += bflo(qv[i].w) * kb.z + bfhi(qv[i].w) * kb.w; }
            const float x = a0 + a1;
            if (x > v0) { v2 = v1; i2 = i1; v1 = v0; i1 = i0; v0 = x; i0 = n; }
            else if (x > v1) { v2 = v1; i2 = i1; v1 = x; i1 = n; }
            else if (x > v2) { v2 = x; i2 = n; }
        }
        unsigned mask = 0u;
        if (i0 >= 0) mask |= 1u << i0; if (i1 >= 0) mask |= 1u << i1; if (i2 >= 0) mask |= 1u << i2;
        sel[(size_t)bh * SEQ + s] = mask;
        { const float ninf = -INFINITY; float* lp = LSE + ((size_t)bh * SEQ + s) * 4; lp[0] = ninf; lp[1] = ninf; lp[2] = ninf; }
    }
}
__device__ __forceinline__ void moba_attn_naive(const Frame& F, const bf16* Qh, const bf16* Kh, const bf16* PROJ, const unsigned* sel, bf16* O) {
    const float scale = 0.08838834764831845f;
    for (int qi = F.gw; qi < BATCH * NH * SEQ; qi += F.NGW) {
        const int s = qi % SEQ, bh = qi / SEQ, b = bh / NH, h = bh % NH, qblk = s / MB_BLK;
        const GAS v4u* qp = (const GAS v4u*)(Qh + ((size_t)bh * SEQ + s) * HD);
        v4u qv[16];
#pragma unroll
        for (int i = 0; i < 16; ++i) qv[i] = qp[i];
        const unsigned mask = sel[(size_t)bh * SEQ + s] | (1u << qblk);
        float m = -1e30f, l = 0.f, o0 = 0.f, o1 = 0.f;
        for (int j = 0; j <= qblk; ++j) {
            if (!((mask >> j) & 1u)) continue;
            for (int t = 0; t < 4; ++t) {
                const int key0 = j * MB_BLK + t * 64; if (key0 > s) break;
                const int key = key0 + F.lane;
                const GAS v4u* kp = (const GAS v4u*)(Kh + ((size_t)bh * SEQ + key) * HD);
                float a0 = 0.f, a1 = 0.f;
#pragma unroll
                for (int i = 0; i < 16; ++i) { const v4u kv = kp[i];
                    a0 += bflo(qv[i].x) * bflo(kv.x) + bfhi(qv[i].x) * bfhi(kv.x); a1 += bflo(qv[i].y) * bflo(kv.y) + bfhi(qv[i].y) * bfhi(kv.y);
                    a0 += bflo(qv[i].z) * bflo(kv.z) + bfhi(qv[i].z) * bfhi(kv.z); a1 += bflo(qv[i].w) * bflo(kv.w) + bfhi(qv[i].w) * bfhi(kv.w); }
                float sc = (a0 + a1) * scale; if (key > s) sc = -INFINITY;
                float tm = sc;
#pragma unroll
                for (int o = 1; o < 64; o <<= 1) tm = fmaxf(tm, __shfl_xor(tm, o));
                const float mn = fmaxf(m, tm), alpha = __expf(m - mn), p = __expf(sc - mn);
                const float ps = wave_sum(p);
                l = l * alpha + ps; o0 *= alpha; o1 *= alpha; m = mn;
                const bf16* vp = PROJ + ((size_t)b * SEQ + key0) * (3 * D) + 2 * D + h * HD + 2 * F.lane;
#pragma unroll 8
                for (int kk = 0; kk < 64; ++kk) { const float pk = __shfl(p, kk); const unsigned vv = *(const GAS unsigned*)(vp + (size_t)kk * (3 * D)); o0 += pk * bflo(vv); o1 += pk * bfhi(vv); }
            }
        }
        const float il = 1.0f / l;
        *(GAS unsigned*)(O + ((size_t)b * SEQ + s) * D + h * HD + 2 * F.lane) = pkbf(o0 * il, o1 * il);
    }
}
#include <hip/hip_bf16.h>
namespace mattn {
constexpr int D = 128, LDV = 3 * 4096;
constexpr float THR = 8.f;
constexpr bool WSKIP = false;
constexpr float SCALE = 0.08838834764831845f;
constexpr int NW = 8, QBLK = 32, KVBLK = 64, QB = NW * QBLK;
constexpr int SHM_V = KVBLK * D * 2, SHM_K = KVBLK * D * 2;
constexpr int LDS_TAB = 2 * SHM_V + 2 * SHM_K + NW * 64 * 4;
constexpr int LDS_BYTES = LDS_TAB + NW * 32 * 4 + 64;
using bf16 = __hip_bfloat16;
typedef short bf16x8 __attribute__((ext_vector_type(8)));
typedef short s16x4 __attribute__((ext_vector_type(4)));
typedef float f32x16 __attribute__((ext_vector_type(16)));
typedef float f32x4 __attribute__((ext_vector_type(4)));
typedef unsigned u32x4 __attribute__((ext_vector_type(4)));
template <class A, class Bt> struct same_t { static constexpr bool v = false; };
template <class A> struct same_t<A, A> { static constexpr bool v = true; };

#define KSWZ(row, colB) ((row) * 256 + ((colB) ^ (((row) & 7) << 4)))
#define SBAR() __builtin_amdgcn_sched_barrier(0)
__device__ __forceinline__ int v_st(int k, int c) { const int kk = (k & ~0xC) | ((k & 4) << 1) | ((k & 8) >> 1); return ((kk >> 3) * 4 + (c >> 5)) * 512 + ((kk & 7) * 32 + (c & 31)) * 2; }
__device__ __forceinline__ int v_rd_base(int lane) { return ((lane & 3) << 3) | (((lane >> 2) & 3) << 6) | (((lane >> 4) & 1) << 5) | (((lane >> 5) & 1) << 8); }
constexpr int v_rd_off(int d0, int ks, int half) { return d0 * 512 + ks * 4096 + half * 2048; }
__device__ __forceinline__ int crow(int r, int hi) { return (r & 3) + 8 * (r >> 2) + 4 * hi; }
__device__ __forceinline__ unsigned cvtpk(float lo, float hi) {
    unsigned r; asm volatile("v_cvt_pk_bf16_f32 %0, %1, %2" : "=v"(r) : "v"(lo), "v"(hi)); return r;
}
__device__ __forceinline__ bf16x8 pack8(f32x4 a, f32x4 b) {
    u32x4 w = {cvtpk(a[0], a[1]), cvtpk(a[2], a[3]), cvtpk(b[0], b[1]), cvtpk(b[2], b[3])};
    return *reinterpret_cast<bf16x8*>(&w);
}
template <class T> __device__ __forceinline__ bf16x8 load8(const T* p) {
    if constexpr (same_t<T, float>::v) { return pack8(*(const f32x4*)p, *(const f32x4*)(p + 4)); }
    else { return *reinterpret_cast<const bf16x8*>(p); }
}
__device__ __forceinline__ void mask_tile(f32x16& p0, f32x16& p1, int dq, unsigned W) {
    const float NEG = -__builtin_inff();
#pragma unroll
    for (int r = 0; r < 16; ++r) {
        const int c = (r & 3) + 8 * (r >> 2);
        if ((unsigned)(dq - c) >= W) p0[r] = NEG;
        if ((unsigned)(dq - c - 32) >= W) p1[r] = NEG;
    }
}
__device__ __forceinline__ void partialSM(f32x16& p0, f32x16& p1, float& m_reg, float& mn, float& alpha) {
    float pmax = p0[0]; for (int r = 1; r < 16; ++r) pmax = fmaxf(pmax, p0[r]); for (int r = 0; r < 16; ++r) pmax = fmaxf(pmax, p1[r]);
    { auto rr = __builtin_amdgcn_permlane32_swap(__float_as_uint(pmax), __float_as_uint(pmax), false, false);
      pmax = fmaxf(__uint_as_float(rr[0]), __uint_as_float(rr[1])); }
    constexpr float C2 = 1.4426950408889634f * SCALE;
    if (__builtin_expect(__all((pmax - m_reg) * SCALE <= THR), 1)) { mn = m_reg; alpha = 1.f; }
    else { mn = fmaxf(m_reg, pmax); alpha = __builtin_amdgcn_exp2f((m_reg - mn) * C2); m_reg = mn; }
    const float mnL = -mn * C2;
    for (int r = 0; r < 16; ++r) p0[r] = fmaf(p0[r], C2, mnL); for (int r = 0; r < 16; ++r) p1[r] = fmaf(p1[r], C2, mnL);
    for (int r = 0; r < 16; ++r) p0[r] = __builtin_amdgcn_exp2f(p0[r]);
}
__device__ __forceinline__ void finishSM(f32x16& p0, f32x16& p1, float alpha, float& l_reg, bf16x8& pa0, bf16x8& pa1, bf16x8& pa2, bf16x8& pa3) {
    for (int r = 0; r < 16; ++r) p1[r] = __builtin_amdgcn_exp2f(p1[r]);
    float ps = 0; for (int r = 0; r < 16; ++r) ps += p0[r]; for (int r = 0; r < 16; ++r) ps += p1[r];
    { auto rr = __builtin_amdgcn_permlane32_swap(__float_as_uint(ps), __float_as_uint(ps), false, false);
      ps = __uint_as_float(rr[0]) + __uint_as_float(rr[1]); }
    l_reg = l_reg * alpha + ps;
#define PK4(P, B_, OUT) do { unsigned a0 = cvtpk(P[B_+0], P[B_+1]), a1 = cvtpk(P[B_+2], P[B_+3]);                          \
        unsigned b0 = cvtpk(P[B_+4], P[B_+5]), b1 = cvtpk(P[B_+6], P[B_+7]);                                             \
        auto r0 = __builtin_amdgcn_permlane32_swap(a0, b0, false, false); auto r1 = __builtin_amdgcn_permlane32_swap(a1, b1, false, false); \
        u32x4 w = {r0[0], r1[0], r0[1], r1[1]}; OUT = *reinterpret_cast<bf16x8*>(&w); } while (0)
    PK4(p0, 0, pa0); PK4(p0, 8, pa1); PK4(p1, 0, pa2); PK4(p1, 8, pa3);
#undef PK4
}
template <int KB, bool SK>
__device__ __forceinline__ void qkt(f32x16& p0, f32x16& p1, const char* K_lds, int r32, int hi, const bf16x8* qr, bool act) {
    if (SK && !act) { const float NEG = -__builtin_inff();
#pragma unroll
        for (int r = 0; r < 16; ++r) { p0[r] = NEG; p1[r] = NEG; } return; }
    p0 = f32x16{}; p1 = f32x16{};
    const char* kb[4];
#pragma unroll
    for (int dd = 0; dd < 4; ++dd) kb[dd] = K_lds + KB * SHM_K + KSWZ(r32, (dd * 16 + hi * 8) * 2);
#pragma unroll
    for (int d0 = 0; d0 < 8; ++d0) { const char* a = kb[d0 & 3] + (d0 >> 2) * 128;
        bf16x8 b0 = *reinterpret_cast<const bf16x8*>(a);
        bf16x8 b1 = *reinterpret_cast<const bf16x8*>(a + 32 * 256);
        p0 = __builtin_amdgcn_mfma_f32_32x32x16_bf16(b0, qr[d0], p0, 0, 0, 0);
        p1 = __builtin_amdgcn_mfma_f32_32x32x16_bf16(b1, qr[d0], p1, 0, 0, 0); }
}
template <int VB, bool SK>
__device__ __forceinline__ void pv_tile(f32x16* o, int vb0, bf16x8 pa0, bf16x8 pa1, bf16x8 pa2, bf16x8 pa3, bool act) {
    if (SK && !act) return;
#define TRRD(dst, off) asm volatile("ds_read_b64_tr_b16 %0, %1 offset:%2" : "=&v"(dst) : "v"(vb0), "i"(off) : "memory")
#define PV_D0(d0) do { s16x4 l0, l1, l2, l3, h0, h1, h2, h3; constexpr int b_ = VB * SHM_V + v_rd_off(d0, 0, 0);     \
        TRRD(l0, b_); TRRD(h0, b_ + 2048); TRRD(l1, b_ + 4096); TRRD(h1, b_ + 6144); TRRD(l2, b_ + 8192); TRRD(h2, b_ + 10240); TRRD(l3, b_ + 12288); TRRD(h3, b_ + 14336); \
        asm volatile("s_waitcnt lgkmcnt(0)" ::: "memory"); SBAR();                 \
        o[d0] = __builtin_amdgcn_mfma_f32_32x32x16_bf16(pa0, (bf16x8){l0[0], l0[1], l0[2], l0[3], h0[0], h0[1], h0[2], h0[3]}, o[d0], 0, 0, 0);   \
        o[d0] = __builtin_amdgcn_mfma_f32_32x32x16_bf16(pa1, (bf16x8){l1[0], l1[1], l1[2], l1[3], h1[0], h1[1], h1[2], h1[3]}, o[d0], 0, 0, 0);   \
        o[d0] = __builtin_amdgcn_mfma_f32_32x32x16_bf16(pa2, (bf16x8){l2[0], l2[1], l2[2], l2[3], h2[0], h2[1], h2[2], h2[3]}, o[d0], 0, 0, 0);   \
        o[d0] = __builtin_amdgcn_mfma_f32_32x32x16_bf16(pa3, (bf16x8){l3[0], l3[1], l3[2], l3[3], h3[0], h3[1], h3[2], h3[3]}, o[d0], 0, 0, 0); } while (0)
    PV_D0(0); PV_D0(1); PV_D0(2); PV_D0(3);
#undef PV_D0
#undef TRRD
}

template <class TIn, class TOut> struct BlockRef { const TIn* Q; const TIn* K; const TIn* V; TOut* O; float* LSE; const unsigned* ROWS; int NR, ROW0, P0; };
template <class R> __device__ __forceinline__ unsigned blk_entry(const R& b, int idx) { return b.ROWS ? (idx < b.NR ? b.ROWS[idx] : 0xffffffffu) : ((unsigned)(b.ROW0 + idx) | (3u << 16)); }
template <class TIn> struct Seam {
    bf16x8 qr[8];
    unsigned ecur;
    bf16x8 st_v0, st_v1, st_k0, st_k1; f32x4 sf0, sf1, sf2, sf3;
    f32x4 tq[16];
};
__device__ __forceinline__ int swa_jlo(int P0, int W) { const int lowk = P0 - W + 1; return lowk > 0 ? lowk / KVBLK : 0; }
#define ROW(p, k0, rr) ((p) + (size_t)((k0) + (rr)) * D + sc)
#define ROWV(p, k0, rr) ((p) + (size_t)((k0) + (rr)) * LDV + sc)
#define VMW() asm volatile("s_waitcnt vmcnt(0)" ::: "memory")
#define VMWN(n) asm volatile("s_waitcnt vmcnt(%0)" :: "i"(n) : "memory")
#define SLOAD_H(Kp, Vp, k0) do { S.st_v0 = load8<TIn>(ROWV(Vp, k0, sr)); S.st_v1 = load8<TIn>(ROWV(Vp, k0, 32 + sr));              \
                         S.st_k0 = load8<TIn>(ROW(Kp, k0, sr)); S.st_k1 = load8<TIn>(ROW(Kp, k0, 32 + sr)); } while (0)
#define SWRITE_HK(bf) do { *(bf16x8*)(K_lds + (bf) * SHM_K + kws) = S.st_k0; *(bf16x8*)(K_lds + (bf) * SHM_K + kws + 32 * 256) = S.st_k1; } while (0)
#define SWRITE_HV(bf) do { *(bf16x8*)(V_lds + (bf) * SHM_V + vst0) = S.st_v0; *(bf16x8*)(V_lds + (bf) * SHM_V + vst1) = S.st_v1; } while (0)
#define SWRITE_H(bf) do { SWRITE_HV(bf); SWRITE_HK(bf); } while (0)
#define SLOAD_F(p, k0) do { S.sf0 = *(const f32x4*)ROW(p, k0, sr); S.sf1 = *(const f32x4*)(ROW(p, k0, sr) + 4);                \
                            S.sf2 = *(const f32x4*)ROW(p, k0, 32 + sr); S.sf3 = *(const f32x4*)(ROW(p, k0, 32 + sr) + 4); } while (0)
#define SWRITE_KF(bf) do { *(bf16x8*)(K_lds + (bf) * SHM_K + kws) = pack8(S.sf0, S.sf1); *(bf16x8*)(K_lds + (bf) * SHM_K + kws + 32 * 256) = pack8(S.sf2, S.sf3); } while (0)
#define SWRITE_VF(bf) do { *(bf16x8*)(V_lds + (bf) * SHM_V + vst0) = pack8(S.sf0, S.sf1); *(bf16x8*)(V_lds + (bf) * SHM_V + vst1) = pack8(S.sf2, S.sf3); } while (0)
template <class TIn, class TOut>
__device__ __forceinline__ void causal_swa_prime(const BlockRef<TIn, TOut>& cur, int W, char* lds, Seam<TIn>& S) {
    constexpr bool F32 = same_t<TIn, float>::v;
    const int tid = mk_tid(), wid = __builtin_amdgcn_readfirstlane(tid >> 6), lane = tid & 63, r32 = lane & 31, hi = lane >> 5;
    const int sr = tid >> 4, sc = (tid & 15) * 8, kws = KSWZ(sr, sc * 2); char* K_lds = lds + 2 * SHM_V;
    const int kb0 = swa_jlo(cur.P0, W) * KVBLK;
    S.ecur = blk_entry(cur, wid * QBLK + r32);
    { const unsigned qrow = S.ecur == 0xffffffffu ? 0u : (S.ecur & 0xffffu);
      for (int d0 = 0; d0 < 8; ++d0) S.qr[d0] = load8<TIn>(cur.Q + (size_t)qrow * D + d0 * 16 + hi * 8); }
    if constexpr (F32) { SLOAD_F((const float*)cur.K, kb0); VMW(); SWRITE_KF(0); SBAR(); SLOAD_F((const float*)cur.V, kb0); }
    else { SLOAD_H(cur.K, cur.V, kb0); VMW(); SWRITE_HK(0); }
    __syncthreads();
}
template <class TIn, class TOut>
__device__ __forceinline__ void causal_swa_block(const BlockRef<TIn, TOut>& cur, const BlockRef<TIn, TOut>& nxt, int skv, int W, char* lds, Seam<TIn>& S) {
    constexpr bool F32 = same_t<TIn, float>::v;
    const int tid = mk_tid(), wid = __builtin_amdgcn_readfirstlane(tid >> 6), lane = tid & 63, r32 = lane & 31, hi = lane >> 5;
    const int j_lo = swa_jlo(cur.P0, W);
    int j_hi = (cur.P0 + QB - 1) / KVBLK + 1; if (j_hi > skv / KVBLK) j_hi = skv / KVBLK;
    const int NT = j_hi - j_lo;
    const int kbn = swa_jlo(nxt.P0, W) * KVBLK;
    const int qlo = cur.P0 + wid * QBLK, qm = qlo + r32 - 4 * hi;
    char* V_lds = lds; char* K_lds = lds + 2 * SHM_V;
    float* ws = (float*)(lds + 2 * SHM_V + 2 * SHM_K) + wid * 64; float* li_l = ws, * al_l = ws + 32;
    const unsigned enxt = blk_entry(nxt, wid * QBLK + r32);
    float m_reg = -1e30f, l_reg = 0; f32x16 o[4] = {};
    const int sr = tid >> 4, sc = (tid & 15) * 8, vst0 = v_st(sr, sc), vst1 = v_st(32 + sr, sc), kws = KSWZ(sr, sc * 2);
    const int vb0 = (int)(uintptr_t)V_lds + v_rd_base(lane);
    const TIn* Kh = cur.K; const TIn* Vh = cur.V;
#define RESC(a) do { if (__any((a) < 1.f)) { if (hi == 0) al_l[r32] = (a); asm volatile("s_waitcnt lgkmcnt(0)" ::: "memory");              \
                     for (int d_ = 0; d_ < 4; ++d_) for (int r = 0; r < 16; ++r) o[d_][r] *= al_l[crow(r, hi)]; } } while (0)
#define KBASE(t) ((j_lo + (t)) * KVBLK)
#define ACT(t) (KBASE(t) <= qlo + QBLK - 1 && KBASE(t) + KVBLK - 1 >= qlo - W + 1)
#define MASKT(P0_, P1_, t) do { const int kb_ = KBASE(t); if ((!SK || ACT(t)) && (kb_ + KVBLK - 1 > qlo || kb_ <= qlo + QBLK - 1 - W)) mask_tile(P0_, P1_, qm - kb_, (unsigned)W); } while (0)
    constexpr int NQL = F32 ? 16 : 8;
    constexpr bool SK = WSKIP && !F32;
#define SEAM_K0() do { VMWN(NQL); if constexpr (F32) { SWRITE_KF(0); SBAR(); SLOAD_F((const float*)nxt.V, kbn); } else { SWRITE_HK(0); } SBAR(); } while (0)
    f32x16 pA0, pA1, pB0, pB1; float mnA, mnB, alA, alB; bf16x8 pa0, pa1, pa2, pa3;
    if constexpr (F32) { VMW(); SWRITE_VF(0); SBAR(); } else { SWRITE_HV(0); SBAR(); }
    if (NT > 1) { if constexpr (F32) SLOAD_F((const float*)Kh, KBASE(1)); else SLOAD_H(Kh, Vh, KBASE(1)); }
    SBAR(); qkt<0, SK>(pA0, pA1, K_lds, r32, hi, S.qr, ACT(0));
    if constexpr (F32) { if (NT > 1) { VMW(); SWRITE_KF(1); SBAR(); SLOAD_F((const float*)Vh, KBASE(1)); } }
    MASKT(pA0, pA1, 0); partialSM(pA0, pA1, m_reg, mnA, alA);
    if (NT > 1) { VMW(); if constexpr (F32) { SWRITE_VF(1); SBAR(); if (NT > 2) SLOAD_F((const float*)Kh, KBASE(2)); } else SWRITE_H(1); }
    __syncthreads();
#define HALF_STEP(PX0, PX1, mnX, alX, PY0, PY1, alY, t, KB, VB, SB) do {                                                      \
        SBAR(); qkt<KB, SK>(PX0, PX1, K_lds, r32, hi, S.qr, ACT(t));                                             \
        finishSM(PY0, PY1, alY, l_reg, pa0, pa1, pa2, pa3); SBAR();                                                           \
        if ((t) + 1 < NT) { if constexpr (F32) { VMW(); SWRITE_KF(SB); SBAR(); SLOAD_F((const float*)Vh, KBASE((t) + 1)); }  \
                            else { SLOAD_H(Kh, Vh, KBASE((t) + 1)); } SBAR(); }                                               \
        pv_tile<VB, SK>(o, vb0, pa0, pa1, pa2, pa3, ACT((t) - 1)); MASKT(PX0, PX1, (t)); partialSM(PX0, PX1, m_reg, mnX, alX);                                        \
        __syncthreads();                                                                                                      \
        if ((t) + 1 < NT) { VMW(); if constexpr (F32) { SWRITE_VF(SB); SBAR(); if ((t) + 2 < NT) SLOAD_F((const float*)Kh, KBASE((t) + 2)); } \
                            else { SWRITE_H(SB); } }                                                                          \
        RESC(alX); __syncthreads(); } while (0)
    for (int t = 1; t + 1 < NT; t += 2) {
        HALF_STEP(pB0, pB1, mnB, alB, pA0, pA1, alA, t, 1, 0, 0);
        HALF_STEP(pA0, pA1, mnA, alA, pB0, pB1, alB, t + 1, 0, 1, 1);
    }
    {
    int tidz_ = mk_tid(); asm volatile("" : "+v"(tidz_));
    const int tid = tidz_, lane = tid & 63, r32 = lane & 31, hi = lane >> 5;
    const int sr = tid >> 4, sc = (tid & 15) * 8, vst0 = v_st(sr, sc), vst1 = v_st(32 + sr, sc), kws = KSWZ(sr, sc * 2);
    const int vb0 = (int)(uintptr_t)V_lds + v_rd_base(lane);
    (void)vst0; (void)vst1; (void)kws; (void)vb0; (void)lane;
    const bool even = (NT & 1) == 0;
    if (even) { SBAR(); qkt<1, SK>(pB0, pB1, K_lds, r32, hi, S.qr, ACT(NT - 1)); SBAR(); }
#define QROW(e) (nxt.Q + (size_t)(wid * QBLK + r32) * D + ((e) >> 1) * 16 + hi * 8 + ((e) & 1) * 4)
    if constexpr (F32) { SLOAD_F((const float*)nxt.K, kbn); SBAR();
#pragma unroll
        for (int e = 0; e < 8; ++e) S.tq[e] = *(const f32x4*)QROW(e); }
    else { SLOAD_H(nxt.K, nxt.V, kbn); SBAR();
#pragma unroll
        for (int d0 = 0; d0 < 8; ++d0) S.qr[d0] = load8<TIn>(nxt.Q + (size_t)(enxt == 0xffffffffu ? 0u : (enxt & 0xffffu)) * D + d0 * 16 + hi * 8); }
    SBAR();
    finishSM(pA0, pA1, alA, l_reg, pa0, pa1, pa2, pa3); SBAR();
    if constexpr (F32) {
#pragma unroll
        for (int e = 8; e < 16; ++e) S.tq[e] = *(const f32x4*)QROW(e); SBAR(); }
#undef QROW
    pv_tile<0, SK>(o, vb0, pa0, pa1, pa2, pa3, ACT(even ? NT - 2 : NT - 1));
    if (even) { MASKT(pB0, pB1, NT - 1); partialSM(pB0, pB1, m_reg, mnB, alB); __syncthreads(); RESC(alB);
        finishSM(pB0, pB1, alB, l_reg, pa0, pa1, pa2, pa3); SBAR(); pv_tile<1, SK>(o, vb0, pa0, pa1, pa2, pa3, ACT(NT - 1)); }
    SBAR(); SEAM_K0();
    unsigned* tabE = (unsigned*)(lds + LDS_TAB) + wid * 32;
    if (hi == 0) { li_l[r32] = l_reg; tabE[r32] = S.ecur;
        if (S.ecur != 0xffffffffu) cur.LSE[(size_t)(S.ecur & 0xffffu) * 4 + ((S.ecur >> 16) & 3u)] = m_reg * SCALE + __logf(l_reg); }
    asm volatile("s_waitcnt lgkmcnt(0)" ::: "memory");
    float rli[16];
#pragma unroll
    for (int r = 0; r < 16; ++r) rli[r] = __builtin_amdgcn_rcpf(li_l[crow(r, hi)]);
#pragma unroll
    for (int r = 0; r < 16; ++r) { const unsigned e = tabE[crow(r, hi)]; const bool ok = e != 0xffffffffu;
        TOut* orow_p = cur.O + ((size_t)(e & 0xffffu) * 4 + ((e >> 16) & 3u)) * D;
#pragma unroll
        for (int d0 = 0; d0 < 4; ++d0) { const float v = o[d0][r] * rli[r];
            const float vn = __shfl_xor(v, 1);
            if (ok && (r32 & 1) == 0) *(unsigned*)(orow_p + d0 * 32 + r32) = cvtpk(v, vn); } }
    S.ecur = enxt;
    if constexpr (F32) {
#pragma unroll
        for (int d0 = 0; d0 < 8; ++d0) S.qr[d0] = pack8(S.tq[2 * d0], S.tq[2 * d0 + 1]); }
    }
    __syncthreads();
#undef RESC
#undef KBASE
#undef ACT
#undef MASKT
#undef SEAM_K0
#undef HALF_STEP
}
#undef ROW
#undef ROWV
#undef VMW
#undef VMWN
#undef SLOAD_H
#undef SWRITE_HK
#undef SWRITE_HV
#undef SWRITE_H
#undef SLOAD_F
#undef SWRITE_KF
#undef SWRITE_VF
}

__device__ __forceinline__ void moba_lists(const Frame& F, const unsigned* SEL, unsigned* LIST, unsigned* CNT, unsigned* qhead) {
    if (F.gw == 0 && F.lane == 0) *qhead = 0u;
    for (int p = F.gw; p < BATCH * NH * MB_NB; p += F.NGW) {
        const int j = p % MB_NB, bh = p / MB_NB;
        unsigned cnt = 0u;
        for (int qb = j + 1; qb < MB_NB; ++qb)
#pragma unroll
            for (int g = 0; g < 4; ++g) {
                const int s = qb * MB_BLK + g * 64 + F.lane;
                const unsigned m = SEL[(size_t)bh * SEQ + s];
                const bool sel = ((m >> j) & 1u) != 0u;
                const unsigned long long bal = __ballot(sel);
                const unsigned pos = cnt + (unsigned)__popcll(bal & ((1ull << F.lane) - 1ull));
                if (sel) LIST[((size_t)bh * MB_NB + j) * SEQ + pos] = (unsigned)s | ((unsigned)__popc(m & ((1u << j) - 1u)) << 16);
                cnt += (unsigned)__popcll(bal);
            }
        if (F.lane == 0) CNT[bh * MB_NB + j] = cnt;
    }
}
namespace mattn {
constexpr int W_LDS_V = 0, W_LDS_K = 4 * SHM_V, W_LDS_WS = 4 * SHM_V + 4 * SHM_K, W_LDS_TAB = W_LDS_WS + NW * 64 * 4, W_LDS_Q = W_LDS_TAB + NW * 32 * 4, W_LDS_BYTES = W_LDS_Q + 64;
template <int T> __device__ __forceinline__ void wave_tile(f32x16 (&o)[4], float& m_reg, float& l_reg, const bf16x8 (&qr)[8], const char* K_lds, int vb0, float* al_l, int r32, int hi, bool causal, int dq0) {
    f32x16 p0, p1; float mn, alpha; bf16x8 pa0, pa1, pa2, pa3;
    qkt<T, false>(p0, p1, K_lds, r32, hi, qr, true);
    if (causal) mask_tile(p0, p1, dq0 - T * KVBLK, 1u << 30);
    partialSM(p0, p1, m_reg, mn, alpha);
    if (__any(alpha < 1.f)) { if (hi == 0) al_l[r32] = alpha; asm volatile("s_waitcnt lgkmcnt(0)" ::: "memory");
#pragma unroll
        for (int d_ = 0; d_ < 4; ++d_)
#pragma unroll
            for (int r = 0; r < 16; ++r) o[d_][r] *= al_l[crow(r, hi)]; }
    finishSM(p0, p1, alpha, l_reg, pa0, pa1, pa2, pa3); SBAR();
    pv_tile<T, false>(o, vb0, pa0, pa1, pa2, pa3, true);
}
}
__device__ __forceinline__ void moba_attn_sparse(const Frame& F, char* lds, const bf16* Qh, const bf16* Kh, const bf16* PROJ, const unsigned* LIST, const unsigned* CNT, bf16* OPART, float* LSE, unsigned* qhead) {
    using namespace mattn;
    using T = mattn::bf16;
    constexpr int NPAIR = (MB_NB - 1) * BATCH * NH, NITEM = NPAIR + BATCH * NH;
    volatile unsigned* qw = (volatile unsigned*)(lds + W_LDS_Q);
    char* V_lds = lds + W_LDS_V; char* K_lds = lds + W_LDS_K;
    for (;;) {
        __syncthreads();
        if (F.tid == 0) *qw = atomicAdd(qhead, 1u);
        __syncthreads();
        const int id = __builtin_amdgcn_readfirstlane((int)*qw);
        if (id >= NITEM) break;
        int bh, blk, cnt;
        if (id < NPAIR) { blk = id / (BATCH * NH); bh = id % (BATCH * NH); cnt = __builtin_amdgcn_readfirstlane((int)CNT[bh * MB_NB + blk]); }
        else { bh = id - NPAIR; blk = MB_NB - 1; cnt = 0; }
        const int b = bh / NH, h = bh % NH;
        int tidz = F.tid; asm volatile("" : "+v"(tidz));
        const int tid = tidz, wid = __builtin_amdgcn_readfirstlane(tid >> 6), lane = tid & 63, r32 = lane & 31, hi = lane >> 5;
        {
            const T* Kp = (const T*)Kh + ((size_t)bh * SEQ + (size_t)blk * MB_BLK) * HD;
            const T* Vp = (const T*)PROJ + ((size_t)b * SEQ + (size_t)blk * MB_BLK) * (3 * ::D) + 2 * ::D + h * HD;
            const int sr = tid >> 4, sc = (tid & 15) * 8, vst0 = v_st(sr, sc), vst1 = v_st(32 + sr, sc), kws = KSWZ(sr, sc * 2);
            bf16x8 k0[4], k1[4], v0[4], v1[4];
#pragma unroll
            for (int t = 0; t < 4; ++t) { k0[t] = load8<T>(Kp + (size_t)(64 * t + sr) * HD + sc); k1[t] = load8<T>(Kp + (size_t)(64 * t + 32 + sr) * HD + sc);
                v0[t] = load8<T>(Vp + (size_t)(64 * t + sr) * LDV + sc); v1[t] = load8<T>(Vp + (size_t)(64 * t + 32 + sr) * LDV + sc); }
#pragma unroll
            for (int t = 0; t < 4; ++t) { *(bf16x8*)(K_lds + t * SHM_K + kws) = k0[t]; *(bf16x8*)(K_lds + t * SHM_K + kws + 32 * 256) = k1[t];
                *(bf16x8*)(V_lds + t * SHM_V + vst0) = v0[t]; *(bf16x8*)(V_lds + t * SHM_V + vst1) = v1[t]; }
        }
        __syncthreads();
        const int ng_g = (cnt + 31) >> 5, ngroups = ng_g + MB_BLK / 32;
        const unsigned* rows = LIST + ((size_t)bh * MB_NB + blk) * SEQ;
        const T* Qb = (const T*)Qh + (size_t)bh * SEQ * HD; T* Ob = (T*)OPART + (size_t)bh * SEQ * 4 * HD; float* Lb = LSE + (size_t)bh * SEQ * 4;
        float* al_l = (float*)(lds + W_LDS_WS) + wid * 64 + 32; float* li_l = (float*)(lds + W_LDS_WS) + wid * 64; unsigned* tabE = (unsigned*)(lds + W_LDS_TAB) + wid * 32;
        const int vb0 = (int)(uintptr_t)V_lds + v_rd_base(lane);
        for (int g = wid; g < ngroups; g += NW) {
            const bool own = g >= ng_g;
            const int idx = (own ? g - ng_g : g) * 32 + r32;
            const unsigned e = own ? ((unsigned)(blk * MB_BLK + idx) | (3u << 16)) : (idx < cnt ? rows[idx] : 0xffffffffu);
            const unsigned qrow = e == 0xffffffffu ? 0u : (e & 0xffffu);
            bf16x8 qr[8];
#pragma unroll
            for (int d0 = 0; d0 < 8; ++d0) qr[d0] = load8<T>(Qb + (size_t)qrow * HD + d0 * 16 + hi * 8);
            float m_reg = -1e30f, l_reg = 0.f; f32x16 o[4] = {};
            const int dq0 = idx - 4 * hi;
            wave_tile<0>(o, m_reg, l_reg, qr, K_lds, vb0, al_l, r32, hi, own, dq0);
            wave_tile<1>(o, m_reg, l_reg, qr, K_lds, vb0, al_l, r32, hi, own, dq0);
            wave_tile<2>(o, m_reg, l_reg, qr, K_lds, vb0, al_l, r32, hi, own, dq0);
            wave_tile<3>(o, m_reg, l_reg, qr, K_lds, vb0, al_l, r32, hi, own, dq0);
            if (hi == 0) { li_l[r32] = l_reg; tabE[r32] = e;
                if (e != 0xffffffffu) Lb[(size_t)(e & 0xffffu) * 4 + ((e >> 16) & 3u)] = m_reg * SCALE + __logf(l_reg); }
            asm volatile("s_waitcnt lgkmcnt(0)" ::: "memory");
#pragma unroll
            for (int r = 0; r < 16; ++r) { const unsigned er = tabE[crow(r, hi)]; const bool ok = er != 0xffffffffu; const float rl = __builtin_amdgcn_rcpf(li_l[crow(r, hi)]);
                T* orow_p = Ob + ((size_t)(er & 0xffffu) * 4 + ((er >> 16) & 3u)) * HD;
                if (ok) { uint2 w; w.x = cvtpk(o[0][r] * rl, o[1][r] * rl); w.y = cvtpk(o[2][r] * rl, o[3][r] * rl); *(uint2*)(orow_p + 4 * r32) = w; } }
            asm volatile("s_waitcnt lgkmcnt(0)" ::: "memory");
        }
    }
}
__device__ __forceinline__ void moba_combine(const Frame& F, const bf16* OPART, const float* LSE, bf16* AO) {
    constexpr int RB = 8;
    for (int r0 = F.gw * RB; r0 < BATCH * NH * SEQ; r0 += F.NGW * RB) {
        f32x4 l[RB]; unsigned v[RB][4];
#pragma unroll
        for (int u = 0; u < RB; ++u) { const size_t q = (size_t)(r0 + u); l[u] = *(const GAS f32x4*)(LSE + q * 4);
#pragma unroll
            for (int k = 0; k < 4; ++k) v[u][k] = __builtin_nontemporal_load((const GAS unsigned*)(OPART + (q * 4 + k) * HD + 2 * F.lane)); }
#pragma unroll
        for (int u = 0; u < RB; ++u) {
            const int q = r0 + u, s = q % SEQ, bh = q / SEQ, b = bh / NH, h = bh % NH;
            const float mx = fmaxf(fmaxf(l[u][0], l[u][1]), fmaxf(l[u][2], l[u][3]));
            float o0 = 0.f, o1 = 0.f, den = 0.f;
#pragma unroll
            for (int k = 0; k < 4; ++k) { const float w = __expf(l[u][k] - mx); const bool on = w > 0.f;
                o0 += on ? w * bflo(v[u][k]) : 0.f; o1 += on ? w * bfhi(v[u][k]) : 0.f; den += w; }
            const float id = __builtin_amdgcn_rcpf(den);
            *(GAS unsigned*)(AO + ((size_t)b * SEQ + s) * D + h * HD + 2 * F.lane) = pkbf(o0 * id, o1 * id);
        }
    }
}
constexpr int GD_C = 64, GD_NCH = SEQ / GD_C;
__device__ __forceinline__ float silu_acc(float x) { return x * __builtin_amdgcn_rcpf(1.0f + __expf(-x)); }
__device__ __forceinline__ void gdn_prep(const Frame& F, const bf16* PROJ, const float* AB, const float* cw, const float* a_log, const float* dt_bias,
                                         bf16* QN, bf16* KN, bf16* VN, float* TG, float* TGC, float* TB) {
    for (int unit = F.gw; unit < BATCH * NH * GD_NCH; unit += F.NGW) {
        const int n = unit % GD_NCH, h = (unit / GD_NCH) % NH, b = unit / (GD_NCH * NH);
        const size_t r0 = (size_t)b * SEQ + (size_t)n * GD_C;
        {
            const float a = AB[(r0 + F.lane) * 64 + h], bt = AB[(r0 + F.lane) * 64 + 32 + h];
            const float beta = 1.0f / (1.0f + expf(-bt));
            const float xs = a + dt_bias[h];
            const float sp = xs > 20.f ? xs : log1pf(expf(xs));
            const float g = -expf(a_log[h]) * sp;
            float gc = g;
#pragma unroll
            for (int o = 1; o < 64; o <<= 1) { const float t = __shfl_up(gc, o); if (F.lane >= o) gc += t; }
            TG[(size_t)unit * 64 + F.lane] = g; TGC[(size_t)unit * 64 + F.lane] = gc; TB[(size_t)unit * 64 + F.lane] = beta;
        }
        const int cq = h * HD + 2 * F.lane, ck = D + cq, cv = 2 * D + cq;
        float wq[4][2], wk[4][2], wv[4][2];
#pragma unroll
        for (int t = 0; t < 4; ++t) { wq[t][0] = cw[(size_t)t * 3 * D + cq]; wq[t][1] = cw[(size_t)t * 3 * D + cq + 1]; wk[t][0] = cw[(size_t)t * 3 * D + ck]; wk[t][1] = cw[(size_t)t * 3 * D + ck + 1];
            wv[t][0] = cw[(size_t)t * 3 * D + cv]; wv[t][1] = cw[(size_t)t * 3 * D + cv + 1]; }
        unsigned xq[3] = {0u, 0u, 0u}, xk[3] = {0u, 0u, 0u}, xv[3] = {0u, 0u, 0u};
        if (n > 0) {
#pragma unroll
            for (int t = 0; t < 3; ++t) { const bf16* pr = PROJ + (r0 - 3 + t) * 16384; xq[t] = *(const GAS unsigned*)(pr + cq); xk[t] = *(const GAS unsigned*)(pr + ck); xv[t] = *(const GAS unsigned*)(pr + cv); } }
        const size_t ob = (size_t)unit * GD_C * HD + 2 * F.lane;
#pragma unroll 2
        for (int j = 0; j < GD_C; ++j) {
            const bf16* pr = PROJ + (r0 + j) * 16384;
            const unsigned nq = *(const GAS unsigned*)(pr + cq), nk = *(const GAS unsigned*)(pr + ck), nv = *(const GAS unsigned*)(pr + cv);
            const float q0 = silu_acc(wq[0][0] * bflo(xq[0]) + wq[1][0] * bflo(xq[1]) + wq[2][0] * bflo(xq[2]) + wq[3][0] * bflo(nq));
            const float q1 = silu_acc(wq[0][1] * bfhi(xq[0]) + wq[1][1] * bfhi(xq[1]) + wq[2][1] * bfhi(xq[2]) + wq[3][1] * bfhi(nq));
            const float k0 = silu_acc(wk[0][0] * bflo(xk[0]) + wk[1][0] * bflo(xk[1]) + wk[2][0] * bflo(xk[2]) + wk[3][0] * bflo(nk));
            const float k1 = silu_acc(wk[0][1] * bfhi(xk[0]) + wk[1][1] * bfhi(xk[1]) + wk[2][1] * bfhi(xk[2]) + wk[3][1] * bfhi(nk));
            const float v0 = silu_acc(wv[0][0] * bflo(xv[0]) + wv[1][0] * bflo(xv[1]) + wv[2][0] * bflo(xv[2]) + wv[3][0] * bflo(nv));
            const float v1 = silu_acc(wv[0][1] * bfhi(xv[0]) + wv[1][1] * bfhi(xv[1]) + wv[2][1] * bfhi(xv[2]) + wv[3][1] * bfhi(nv));
            xq[0] = xq[1]; xq[1] = xq[2]; xq[2] = nq; xk[0] = xk[1]; xk[1] = xk[2]; xk[2] = nk; xv[0] = xv[1]; xv[1] = xv[2]; xv[2] = nv;
            const float sq = wave_sum(q0 * q0 + q1 * q1), sk = wave_sum(k0 * k0 + k1 * k1);
            const float rq = 0.08838834764831845f / sqrtf(sq + 1e-6f), rk = 1.0f / sqrtf(sk + 1e-6f);
            *(GAS unsigned*)(QN + ob + (size_t)j * HD) = pkbf(q0 * rq, q1 * rq);
            *(GAS unsigned*)(KN + ob + (size_t)j * HD) = pkbf(k0 * rk, k1 * rk);
            *(GAS unsigned*)(VN + ob + (size_t)j * HD) = pkbf(v0, v1);
        }
    }
}
__device__ __forceinline__ void gdn_scan_naive(const Frame& F, const bf16* QN, const bf16* KN, const bf16* VN, const float* TG, const float* TB, float* O) {
    LAS float* sk = (LAS float*)(F.lds + RING_OFF);
    LAS float* sq = sk + 128;
    LAS float* red = sq + 128;
    LAS float* red2 = red + 512;
    const int c = F.tid & 127, qd = F.tid >> 7;
    for (int bh = F.vcu; bh < BATCH * NH; bh += F.G) {
        const int b = bh / NH, h = bh % NH;
        float S[32];
#pragma unroll
        for (int i = 0; i < 32; ++i) S[i] = 0.f;
        for (int t = 0; t < SEQ; ++t) {
            const size_t ci = (size_t)bh * GD_NCH + (t >> 6); const int j = t & 63;
            const size_t ro = (ci * GD_C + j) * HD;
            __syncthreads();
            if (F.tid < 128) sk[F.tid] = bf2f(KN[ro + F.tid]); else if (F.tid < 256) sq[F.tid - 128] = bf2f(QN[ro + F.tid - 128]);
            const float g = TG[ci * 64 + j], beta = TB[ci * 64 + j], v = bf2f(VN[ro + c]);
            const float eg = expf(g);
            __syncthreads();
            float part = 0.f;
#pragma unroll
            for (int i = 0; i < 32; ++i) { S[i] *= eg; part += sk[qd * 32 + i] * S[i]; }
            red[qd * 128 + c] = part;
            __syncthreads();
            const float ks = (red[c] + red[128 + c]) + (red[256 + c] + red[384 + c]);
            const float vn = beta * (v - ks);
            float po = 0.f;
#pragma unroll
            for (int i = 0; i < 32; ++i) { S[i] += sk[qd * 32 + i] * vn; po += sq[qd * 32 + i] * S[i]; }
            red2[qd * 128 + c] = po;
            __syncthreads();
            if (qd == 0) O[((size_t)b * SEQ + t) * D + h * HD + c] = (red2[c] + red2[128 + c]) + (red2[256 + c] + red2[384 + c]);
        }
    }
}
__device__ __forceinline__ void gdn_outnorm(const Frame& F, const bf16* O, const bf16* PROJ, const float* onorm, bf16* OG) {
    const float g0 = onorm[2 * F.lane], g1 = onorm[2 * F.lane + 1];
    for (int row = F.gw; row < M; row += F.NGW) {
#pragma unroll 4
        for (int h = 0; h < NH; ++h) {
            const unsigned ow = *(const GAS unsigned*)(O + (size_t)row * D + h * HD + 2 * F.lane); f32x2v o; o.x = bflo(ow); o.y = bfhi(ow);
            const unsigned z = *(const GAS unsigned*)(PROJ + (size_t)row * 16384 + 3 * D + h * HD + 2 * F.lane);
            const float ss = wave_sum(o.x * o.x + o.y * o.y);
            const float rs = __builtin_amdgcn_rsqf(ss * (1.0f / 128.0f) + 1e-6f);
            *(GAS unsigned*)(OG + (size_t)row * D + h * HD + 2 * F.lane) = pkbf(o.x * rs * g0 * silu_acc(bflo(z)), o.y * rs * g1 * silu_acc(bfhi(z)));
        }
    }
}
#define MFMA32(a, b, c) __builtin_amdgcn_mfma_f32_32x32x16_bf16((a), (b), (c), 0, 0, 0)
constexpr int GD_WSLOT = 17408;
__device__ __forceinline__ bf16x8 pack_regs(const f32x16& x, int s) {
    v4u w; w.x = pkbf(x[8 * s + 0], x[8 * s + 1]); w.y = pkbf(x[8 * s + 2], x[8 * s + 3]); w.z = pkbf(x[8 * s + 4], x[8 * s + 5]); w.w = pkbf(x[8 * s + 6], x[8 * s + 7]);
    return __builtin_bit_cast(bf16x8, w);
}
__device__ __forceinline__ int sorder_pos(int i, int d) { const int ti = i >> 5, r = i & 31, td = d >> 5, dd = d & 31, s = dd >> 4, e = dd & 15, hh = (e >> 2) & 1, jj = ((e >> 3) << 2) | (e & 3);
    return ((((ti * 4 + td) * 2 + s) * 64 + hh * 32 + r) << 3) + jj; }

__device__ __forceinline__ void gdn_prep2(const Frame& F, const bf16* PROJ, const float* AB, const float* cw, const float* a_log, const float* dt_bias,
                                          bf16* QN, bf16* KN, bf16* QDF, bf16* KDF, bf16* KWT, bf16* VUT, float* TGC, float* TB) {
    LAS unsigned char* slot = F.lds + RING_OFF + F.wave * GD_WSLOT;
    LAS unsigned* tile32 = (LAS unsigned*)slot;
    LAS unsigned short* tile16 = (LAS unsigned short*)slot;
    LAS float* ftab = (LAS float*)(slot + 16640);
    for (int unit = F.gw; unit < BATCH * NH * GD_NCH; unit += F.NGW) {
        int lane_ = F.lane; asm volatile("" : "+v"(lane_));
        const int lane = lane_;
        const int n = unit % GD_NCH, h = (unit / GD_NCH) % NH, b = unit / (GD_NCH * NH);
        const size_t r0 = (size_t)b * SEQ + (size_t)n * GD_C;
        float fq;
        {
            const float a = AB[(r0 + lane) * 64 + h], bt = AB[(r0 + lane) * 64 + 32 + h];
            const float beta = 1.0f / (1.0f + expf(-bt));
            const float xs = a + dt_bias[h];
            const float sp = xs > 20.f ? xs : log1pf(expf(xs));
            const float g = -expf(a_log[h]) * sp;
            float gc = g;
#pragma unroll
            for (int o = 1; o < 64; o <<= 1) { const float t = __shfl_up(gc, o); if (lane >= o) gc += t; }
            const float gl = __shfl(gc, 63);
            TGC[(size_t)unit * 64 + lane] = gc; TB[(size_t)unit * 64 + lane] = beta;
            ftab[lane] = beta * expf(gc); ftab[64 + lane] = expf(gl - gc); ftab[128 + lane] = beta; fq = expf(gc);
        }
        asm volatile("" ::: "memory");
        const int cq = h * HD + 2 * lane, ck = D + cq, cv = 2 * D + cq;
        const size_t ob = (size_t)unit * GD_C * HD;
        {
            float wq[4][2], wk[4][2];
#pragma unroll
            for (int t = 0; t < 4; ++t) { wq[t][0] = cw[(size_t)t * 3 * D + cq]; wq[t][1] = cw[(size_t)t * 3 * D + cq + 1]; wk[t][0] = cw[(size_t)t * 3 * D + ck]; wk[t][1] = cw[(size_t)t * 3 * D + ck + 1]; }
            unsigned xq[3] = {0u, 0u, 0u}, xk[3] = {0u, 0u, 0u};
            if (n > 0) {
#pragma unroll
                for (int t = 0; t < 3; ++t) { const bf16* pr = PROJ + (r0 - 3 + t) * 16384; xq[t] = *(const GAS unsigned*)(pr + cq); xk[t] = *(const GAS unsigned*)(pr + ck); } }
#pragma unroll 1
            for (int jb = 0; jb < GD_C; jb += 16) {
                unsigned rq[16], rk[16];
#pragma unroll
                for (int t = 0; t < 16; ++t) { const bf16* pr = PROJ + (r0 + jb + t) * 16384; rq[t] = __builtin_nontemporal_load((const GAS unsigned*)(pr + cq)); rk[t] = __builtin_nontemporal_load((const GAS unsigned*)(pr + ck)); }
#pragma unroll
                for (int t = 0; t < 16; ++t) {
                    const int j = jb + t; const unsigned nq = rq[t], nk = rk[t];
                    const float q0 = silu_acc(wq[0][0] * bflo(xq[0]) + wq[1][0] * bflo(xq[1]) + wq[2][0] * bflo(xq[2]) + wq[3][0] * bflo(nq));
                    const float q1 = silu_acc(wq[0][1] * bfhi(xq[0]) + wq[1][1] * bfhi(xq[1]) + wq[2][1] * bfhi(xq[2]) + wq[3][1] * bfhi(nq));
                    const float k0 = silu_acc(wk[0][0] * bflo(xk[0]) + wk[1][0] * bflo(xk[1]) + wk[2][0] * bflo(xk[2]) + wk[3][0] * bflo(nk));
                    const float k1 = silu_acc(wk[0][1] * bfhi(xk[0]) + wk[1][1] * bfhi(xk[1]) + wk[2][1] * bfhi(xk[2]) + wk[3][1] * bfhi(nk));
                    xq[0] = xq[1]; xq[1] = xq[2]; xq[2] = nq; xk[0] = xk[1]; xk[1] = xk[2]; xk[2] = nk;
                    const float sq = wave_sum_dpp(q0 * q0 + q1 * q1), sk = wave_sum_dpp(k0 * k0 + k1 * k1);
                    const float rq_ = 0.08838834764831845f * __builtin_amdgcn_rsqf(sq + 1e-6f), rk_ = __builtin_amdgcn_rsqf(sk + 1e-6f);
                    const float eq = __shfl(fq, j);
                    const unsigned kp = pkbf(k0 * rk_, k1 * rk_);
                    *(GAS unsigned*)(QN + ob + (size_t)j * HD + 2 * lane) = pkbf(q0 * rq_, q1 * rq_);
                    *(GAS unsigned*)(KN + ob + (size_t)j * HD + 2 * lane) = kp;
                    *(GAS unsigned*)(QDF + ob + sorder_pos(j, 2 * lane)) = pkbf(q0 * rq_ * eq, q1 * rq_ * eq);
                    tile32[j * 65 + lane] = kp;
                }
            }
            asm volatile("" ::: "memory");
#pragma unroll 1
            for (int dt = 0; dt < 4; ++dt) {
                const int ds = dt >> 1, tj = dt & 1;
                const int d = lane + 64 * ds, td = d >> 5, r = d & 31;
                {
                    float kv[32];
#pragma unroll
                    for (int j = 0; j < 32; ++j) kv[j] = bf2f(tile16[(32 * tj + j) * 130 + d]);
                    GAS v4u* ow = (GAS v4u*)(KWT + ob + (size_t)d * 64 + 32 * tj);
#pragma unroll
                    for (int q = 0; q < 4; ++q) { const LAS float* fw = ftab + 32 * tj + 8 * q; v4u w;
                        w.x = pkbf(kv[8 * q] * fw[0], kv[8 * q + 1] * fw[1]); w.y = pkbf(kv[8 * q + 2] * fw[2], kv[8 * q + 3] * fw[3]);
                        w.z = pkbf(kv[8 * q + 4] * fw[4], kv[8 * q + 5] * fw[5]); w.w = pkbf(kv[8 * q + 6] * fw[6], kv[8 * q + 7] * fw[7]); ow[q] = w; }
#pragma unroll
                    for (int s = 0; s < 2; ++s)
#pragma unroll
                        for (int h2 = 0; h2 < 2; ++h2) { const int j0 = 16 * s + 4 * h2; const LAS float* fd = ftab + 64 + 32 * tj + j0; v4u w;
                            w.x = pkbf(kv[j0] * fd[0], kv[j0 + 1] * fd[1]); w.y = pkbf(kv[j0 + 2] * fd[2], kv[j0 + 3] * fd[3]);
                            w.z = pkbf(kv[j0 + 8] * fd[8], kv[j0 + 9] * fd[9]); w.w = pkbf(kv[j0 + 10] * fd[10], kv[j0 + 11] * fd[11]);
                            *(GAS v4u*)(KDF + ob + (size_t)((((td * 2 + tj) * 2 + s) * 64 + h2 * 32 + r) << 3)) = w; }
                }
            }
        }
        asm volatile("" ::: "memory");
        {
            float wv[4][2];
#pragma unroll
            for (int t = 0; t < 4; ++t) { wv[t][0] = cw[(size_t)t * 3 * D + cv]; wv[t][1] = cw[(size_t)t * 3 * D + cv + 1]; }
            unsigned xv[3] = {0u, 0u, 0u};
            if (n > 0) {
#pragma unroll
                for (int t = 0; t < 3; ++t) xv[t] = *(const GAS unsigned*)(PROJ + (r0 - 3 + t) * 16384 + cv); }
#pragma unroll 1
            for (int jb = 0; jb < GD_C; jb += 32) {
                unsigned rv[32];
#pragma unroll
                for (int t = 0; t < 32; ++t) rv[t] = __builtin_nontemporal_load((const GAS unsigned*)(PROJ + (r0 + jb + t) * 16384 + cv));
#pragma unroll
                for (int t = 0; t < 32; ++t) {
                    const int j = jb + t; const unsigned nv = rv[t];
                    const float v0 = silu_acc(wv[0][0] * bflo(xv[0]) + wv[1][0] * bflo(xv[1]) + wv[2][0] * bflo(xv[2]) + wv[3][0] * bflo(nv));
                    const float v1 = silu_acc(wv[0][1] * bfhi(xv[0]) + wv[1][1] * bfhi(xv[1]) + wv[2][1] * bfhi(xv[2]) + wv[3][1] * bfhi(nv));
                    xv[0] = xv[1]; xv[1] = xv[2]; xv[2] = nv;
                    tile32[j * 65 + lane] = pkbf(v0, v1);
                }
            }
            asm volatile("" ::: "memory");
#pragma unroll 1
            for (int ds = 0; ds < 2; ++ds) {
                const int d = lane + 64 * ds;
                GAS v4u* ow = (GAS v4u*)(VUT + ob + (size_t)d * 64);
#pragma unroll 2
                for (int q = 0; q < 8; ++q) { float x[8];
#pragma unroll
                    for (int e = 0; e < 8; ++e) { const int j = 8 * q + e; x[e] = bf2f(tile16[j * 130 + d]) * ftab[128 + j]; }
                    v4u w; w.x = pkbf(x[0], x[1]); w.y = pkbf(x[2], x[3]); w.z = pkbf(x[4], x[5]); w.w = pkbf(x[6], x[7]); ow[q] = w; }
            }
        }
        asm volatile("" ::: "memory");
    }
}
__device__ __forceinline__ void gdn_chunk(const Frame& F, const bf16* QN, const bf16* KN, const bf16* KWT, const bf16* VUT, const float* TGC, const float* TB,
                                          bf16* WF, float* UU, bf16* QKF) {
    LAS unsigned char* slot = F.lds + RING_OFF + F.wave * GD_WSLOT;
    LAS float* Al = (LAS float*)slot;
    LAS unsigned short* Timg = (LAS unsigned short*)slot;
    LAS float* gtab = (LAS float*)(slot + 16384);
    for (int unit = F.gw; unit < BATCH * NH * GD_NCH; unit += F.NGW) {
        int lane_ = F.lane; asm volatile("" : "+v"(lane_));
        const int lane = lane_, r = lane & 31, hh = lane >> 5;
        const size_t ob = (size_t)unit * GD_C * HD;
        gtab[lane] = TGC[(size_t)unit * 64 + lane]; gtab[64 + lane] = TB[(size_t)unit * 64 + lane];
        const float gcl0 = TGC[(size_t)unit * 64 + r], gcl1 = TGC[(size_t)unit * 64 + 32 + r];
        asm volatile("" ::: "memory");
        bf16x8 kf[2][8], qf[2][8];
#pragma unroll
        for (int t = 0; t < 2; ++t)
#pragma unroll
            for (int s = 0; s < 8; ++s) { kf[t][s] = *(const GAS bf16x8*)(KN + ob + (size_t)(32 * t + r) * HD + 16 * s + 8 * hh); qf[t][s] = *(const GAS bf16x8*)(QN + ob + (size_t)(32 * t + r) * HD + 16 * s + 8 * hh); }
#pragma unroll
        for (int q = 0; q < 3; ++q) {
            const int ti = q ? 1 : 0, tj = q == 2 ? 1 : 0;
            f32x16 x = {};
#pragma unroll
            for (int s = 0; s < 8; ++s) x = MFMA32(kf[ti][s], kf[tj][s], x);
            const float gcj = tj ? gcl1 : gcl0;
#pragma unroll
            for (int g = 0; g < 4; ++g) { const f32x4 gi = *(const LAS f32x4*)(gtab + 32 * ti + 8 * g + 4 * hh), bi = *(const LAS f32x4*)(gtab + 64 + 32 * ti + 8 * g + 4 * hh);
#pragma unroll
                for (int e = 0; e < 4; ++e) { const int i = 32 * ti + 8 * g + 4 * hh + e;
                    Al[i * 64 + 32 * tj + r] = bi[e] * x[4 * g + e] * __expf(fminf(gi[e] - gcj, 0.f)); } }
        }
#pragma unroll
        for (int q = 0; q < 3; ++q) {
            const int ti = q ? 1 : 0, tj = q == 2 ? 1 : 0;
            f32x16 y = {};
#pragma unroll
            for (int s = 0; s < 8; ++s) y = MFMA32(kf[tj][s], qf[ti][s], y);
            const float gci = ti ? gcl1 : gcl0;
#pragma unroll
            for (int g = 0; g < 4; ++g) { const f32x4 gj = *(const LAS f32x4*)(gtab + 32 * tj + 8 * g + 4 * hh);
#pragma unroll
                for (int e = 0; e < 4; ++e) { const int jl = 8 * g + 4 * hh + e;
                    const float v = y[4 * g + e] * __expf(fminf(gci - gj[e], 0.f));
                    y[4 * g + e] = (ti != tj || jl <= r) ? v : 0.f; } }
#pragma unroll
            for (int s = 0; s < 2; ++s) *(GAS bf16x8*)(QKF + (size_t)unit * 4096 + (size_t)(((q * 2 + s) * 64 + lane) << 3)) = pack_regs(y, s);
        }
        bf16x8 kwf[4][4], vuf[4][4];
#pragma unroll
        for (int td = 0; td < 4; ++td)
#pragma unroll
            for (int s = 0; s < 4; ++s) { kwf[td][s] = *(const GAS bf16x8*)(KWT + ob + (size_t)(32 * td + r) * 64 + 16 * s + 8 * hh); vuf[td][s] = *(const GAS bf16x8*)(VUT + ob + (size_t)(32 * td + r) * 64 + 16 * s + 8 * hh); }
        asm volatile("" ::: "memory");
        float t[64];
#pragma unroll
        for (int i = 0; i < 64; ++i) {
            float acc = (lane == i) ? 1.f : 0.f;
#pragma unroll
            for (int j4 = 0; j4 < (i + 3) / 4; ++j4) { const f32x4 a = *(const LAS f32x4*)(Al + i * 64 + 4 * j4);
#pragma unroll
                for (int e = 0; e < 4; ++e) if (4 * j4 + e < i) acc -= a[e] * t[4 * j4 + e]; }
            t[i] = acc;
        }
asm volatile("" ::: "memory");
#pragma unroll
        for (int i = 0; i < 64; ++i) Timg[i * 72 + lane] = (unsigned short)(pkbf(t[i], 0.f) & 0xffffu);
        asm volatile("" ::: "memory");
        bf16x8 tf[2][4];
#pragma unroll
        for (int ti = 0; ti < 2; ++ti)
#pragma unroll
            for (int s = 0; s < 4; ++s) tf[ti][s] = *(const LAS bf16x8*)(Timg + (32 * ti + r) * 72 + 16 * s + 8 * hh);
#pragma unroll
        for (int td = 0; td < 4; ++td) {
#pragma unroll
            for (int ti = 0; ti < 2; ++ti) { f32x16 w = {};
#pragma unroll
                for (int s = 0; s < 4; ++s) w = MFMA32(kwf[td][s], tf[ti][s], w);
#pragma unroll
                for (int s = 0; s < 2; ++s) *(GAS bf16x8*)(WF + ob + (size_t)((((ti * 4 + td) * 2 + s) * 64 + lane) << 3)) = pack_regs(w, s); }
        }
#pragma unroll
        for (int tdv = 0; tdv < 4; ++tdv) {
#pragma unroll
            for (int ti = 0; ti < 2; ++ti) { f32x16 u = {};
#pragma unroll
                for (int s = 0; s < 4; ++s) u = MFMA32(tf[ti][s], vuf[tdv][s], u);
                v4u* up = (v4u*)((unsigned*)UU + (size_t)unit * 4096 + (size_t)((tdv * 2 + ti) * 64 + lane) * 8);
#pragma unroll
                for (int g = 0; g < 2; ++g) { v4u w; w.x = pkbf(u[8 * g], u[8 * g + 1]); w.y = pkbf(u[8 * g + 2], u[8 * g + 3]); w.z = pkbf(u[8 * g + 4], u[8 * g + 5]); w.w = pkbf(u[8 * g + 6], u[8 * g + 7]); up[g] = w; } }
        }
        asm volatile("" ::: "memory");
    }
}
constexpr int GS_BUF = 57344, GS_WF = 0, GS_QD = 16384, GS_KD = 32768, GS_QK = 49152, GS_OB = 2 * GS_BUF, GS_OBSZ = 64 * 272;
static_assert(GS_OB + 2 * GS_OBSZ <= RING_BYTES, "scan LDS map");
#define GS_BAR_COMPUTE() asm volatile("s_waitcnt lgkmcnt(0)\n\ts_barrier" ::: "memory")
#define GS_BAR_LOADER() asm volatile("s_waitcnt vmcnt(0) lgkmcnt(0)\n\ts_barrier" ::: "memory")
__device__ __forceinline__ void gdn_scan(const Frame& F, const bf16* WF, const bf16* QDF, const bf16* KDF, const bf16* QKF, const float* UU, const float* TGC, bf16* GO, unsigned* prog) {
    if (F.bx >= BATCH * NH) return;
    const int bh = F.bx, b = bh / NH, h = bh % NH;
    LAS unsigned char* lbase = F.lds + RING_OFF;
    const size_t cb = (size_t)bh * GD_NCH;
#define GS_ISSUE(n_) do { const int lw_ = F.wave - 4; LAS unsigned char* dst_ = lbase + ((n_) & 1) * GS_BUF + lw_ * 1024; const size_t co_ = (cb + (n_)) * 8192;     \
        const unsigned lo_ = (unsigned)(lw_ * 512 + lane * 8); \
        _Pragma("unroll") for (int p_ = 0; p_ < 4; ++p_) { \
            __builtin_amdgcn_global_load_lds((const unsigned*)(WF + co_ + p_ * 2048 + lo_), (LAS unsigned*)(dst_ + GS_WF + p_ * 4096), 16, 0, 0); \
            __builtin_amdgcn_global_load_lds((const unsigned*)(QDF + co_ + p_ * 2048 + lo_), (LAS unsigned*)(dst_ + GS_QD + p_ * 4096), 16, 0, 0); \
            __builtin_amdgcn_global_load_lds((const unsigned*)(KDF + co_ + p_ * 2048 + lo_), (LAS unsigned*)(dst_ + GS_KD + p_ * 4096), 16, 0, 0); } \
        __builtin_amdgcn_global_load_lds((const unsigned*)(QKF + (cb + (n_)) * 4096 + lo_), (LAS unsigned*)(dst_ + GS_QK), 16, 0, 0); \
        if (lw_ < 2) __builtin_amdgcn_global_load_lds((const unsigned*)(QKF + (cb + (n_)) * 4096 + 2048 + lo_), (LAS unsigned*)(dst_ + GS_QK + 4096), 16, 0, 0); } while (0)
#define GS_OSTORE(n_) do { const int lw_ = F.wave - 4; const LAS unsigned char* ob_ = lbase + GS_OB + ((n_) & 1) * GS_OBSZ; \
        _Pragma("unroll") for (int q_ = 0; q_ < 4; ++q_) { const int row_ = 16 * lw_ + 4 * q_ + (lane >> 4), cg_ = lane & 15; \
            const v4u v_ = *(const LAS v4u*)(ob_ + row_ * 272 + cg_ * 16); \
            *(GAS v4u*)(GO + ((size_t)b * SEQ + (size_t)(n_) * GD_C + row_) * D + h * HD + cg_ * 8) = v_; } } while (0)
    if (F.wave >= 4) {
        const int lane = F.lane;
        GS_ISSUE(0);
        GS_BAR_LOADER();
        for (int n = 0; n < GD_NCH; ++n) {
            if (n + 1 < GD_NCH) GS_ISSUE(n + 1);
            if (n > 0) GS_OSTORE(n - 1);
            if (F.wave == 4 && lane == 0) __hip_atomic_store(prog + 16 * bh, (unsigned)(n + 1), __ATOMIC_RELAXED, __HIP_MEMORY_SCOPE_AGENT);
            GS_BAR_LOADER();
        }
        GS_OSTORE(GD_NCH - 1);
    } else {
        f32x16 S[4] = {};
        f32x16 uc[2];
        float egn;
        { const int lane = F.lane;
#pragma unroll
          for (int ti = 0; ti < 2; ++ti) { const v4u* up = (const v4u*)((const unsigned*)UU + cb * 4096 + (size_t)((F.wave * 2 + ti) * 64 + lane) * 8);
#pragma unroll
              for (int g = 0; g < 2; ++g) { const v4u x = up[g]; uc[ti][8 * g] = bflo(x.x); uc[ti][8 * g + 1] = bfhi(x.x); uc[ti][8 * g + 2] = bflo(x.y); uc[ti][8 * g + 3] = bfhi(x.y);
                  uc[ti][8 * g + 4] = bflo(x.z); uc[ti][8 * g + 5] = bfhi(x.z); uc[ti][8 * g + 6] = bflo(x.w); uc[ti][8 * g + 7] = bfhi(x.w); } }
          egn = TGC[cb * 64 + 63]; }
        GS_BAR_COMPUTE();
        for (int n = 0; n < GD_NCH; ++n) {
            int lq_ = F.lane; asm volatile("" : "+v"(lq_));
            const int lane = lq_, r = lane & 31, hh = lane >> 5;
            const LAS unsigned char* B = lbase + (n & 1) * GS_BUF;
            const float eg = __expf(egn);
            bf16x8 Sb[4][2];
#pragma unroll
            for (int td = 0; td < 4; ++td) { Sb[td][0] = pack_regs(S[td], 0); Sb[td][1] = pack_regs(S[td], 1); }
            bf16x8 Vb[2][2];
            f32x16 P[2] = {}, O[2] = {};
#define FRG(off_) (*(const LAS bf16x8*)(B + (off_) + lane * 16))
            bf16x8 fr0, fr1, fr2, fr3, fr4, fr5, fr6, fr7;
            fr0 = FRG(GS_WF + 0);
            fr1 = FRG(GS_WF + 8192);
            fr2 = FRG(GS_WF + 1024);
            fr3 = FRG(GS_WF + 9216);
            fr4 = FRG(GS_WF + 2048);
            fr5 = FRG(GS_WF + 10240);
            fr6 = FRG(GS_WF + 3072); P[0] = MFMA32(fr0, Sb[0][0], P[0]); __builtin_amdgcn_sched_barrier(0);
            fr7 = FRG(GS_WF + 11264); P[1] = MFMA32(fr1, Sb[0][0], P[1]); __builtin_amdgcn_sched_barrier(0);
            fr0 = FRG(GS_WF + 4096); P[0] = MFMA32(fr2, Sb[0][1], P[0]); __builtin_amdgcn_sched_barrier(0);
            fr1 = FRG(GS_WF + 12288); P[1] = MFMA32(fr3, Sb[0][1], P[1]); __builtin_amdgcn_sched_barrier(0);
            fr2 = FRG(GS_WF + 5120); P[0] = MFMA32(fr4, Sb[1][0], P[0]); __builtin_amdgcn_sched_barrier(0);
            fr3 = FRG(GS_WF + 13312); P[1] = MFMA32(fr5, Sb[1][0], P[1]); __builtin_amdgcn_sched_barrier(0);
            fr4 = FRG(GS_WF + 6144); P[0] = MFMA32(fr6, Sb[1][1], P[0]); __builtin_amdgcn_sched_barrier(0);
            fr5 = FRG(GS_WF + 14336); P[1] = MFMA32(fr7, Sb[1][1], P[1]); __builtin_amdgcn_sched_barrier(0);
            fr6 = FRG(GS_WF + 7168); P[0] = MFMA32(fr0, Sb[2][0], P[0]); __builtin_amdgcn_sched_barrier(0);
            fr7 = FRG(GS_WF + 15360); P[1] = MFMA32(fr1, Sb[2][0], P[1]); __builtin_amdgcn_sched_barrier(0);
            fr0 = FRG(GS_KD + 0); P[0] = MFMA32(fr2, Sb[2][1], P[0]); __builtin_amdgcn_sched_barrier(0);
            fr1 = FRG(GS_KD + 4096); P[1] = MFMA32(fr3, Sb[2][1], P[1]); __builtin_amdgcn_sched_barrier(0);
            fr2 = FRG(GS_KD + 8192); P[0] = MFMA32(fr4, Sb[3][0], P[0]); __builtin_amdgcn_sched_barrier(0);
            fr3 = FRG(GS_KD + 12288); P[1] = MFMA32(fr5, Sb[3][0], P[1]); __builtin_amdgcn_sched_barrier(0);
            fr4 = FRG(GS_KD + 1024); P[0] = MFMA32(fr6, Sb[3][1], P[0]); __builtin_amdgcn_sched_barrier(0);
            fr5 = FRG(GS_KD + 5120); P[1] = MFMA32(fr7, Sb[3][1], P[1]); __builtin_amdgcn_sched_barrier(0);
            {
#pragma unroll
                for (int ti = 0; ti < 2; ++ti) { const f32x16 vn = uc[ti] - P[ti]; Vb[ti][0] = pack_regs(vn, 0); Vb[ti][1] = pack_regs(vn, 1); }
            }
            if (n + 1 < GD_NCH) {
#pragma unroll
                for (int ti = 0; ti < 2; ++ti) { const v4u* up = (const v4u*)((const unsigned*)UU + (cb + n + 1) * 4096 + (size_t)((F.wave * 2 + ti) * 64 + lane) * 8);
#pragma unroll
                    for (int g = 0; g < 2; ++g) { const v4u x = up[g]; uc[ti][8 * g] = bflo(x.x); uc[ti][8 * g + 1] = bfhi(x.x); uc[ti][8 * g + 2] = bflo(x.y); uc[ti][8 * g + 3] = bfhi(x.y);
                        uc[ti][8 * g + 4] = bflo(x.z); uc[ti][8 * g + 5] = bfhi(x.z); uc[ti][8 * g + 6] = bflo(x.w); uc[ti][8 * g + 7] = bfhi(x.w); } }
                egn = TGC[(cb + n + 1) * 64 + 63]; }
#pragma unroll
            for (int td = 0; td < 4; ++td) S[td] = S[td] * eg;
            __builtin_amdgcn_sched_barrier(0);
            fr6 = FRG(GS_KD + 9216); S[0] = MFMA32(fr0, Vb[0][0], S[0]); __builtin_amdgcn_sched_barrier(0);
            fr7 = FRG(GS_KD + 13312); S[1] = MFMA32(fr1, Vb[0][0], S[1]); __builtin_amdgcn_sched_barrier(0);
            fr0 = FRG(GS_KD + 2048); S[2] = MFMA32(fr2, Vb[0][0], S[2]); __builtin_amdgcn_sched_barrier(0);
            fr1 = FRG(GS_KD + 6144); S[3] = MFMA32(fr3, Vb[0][0], S[3]); __builtin_amdgcn_sched_barrier(0);
            fr2 = FRG(GS_KD + 10240); S[0] = MFMA32(fr4, Vb[0][1], S[0]); __builtin_amdgcn_sched_barrier(0);
            fr3 = FRG(GS_KD + 14336); S[1] = MFMA32(fr5, Vb[0][1], S[1]); __builtin_amdgcn_sched_barrier(0);
            fr4 = FRG(GS_KD + 3072); S[2] = MFMA32(fr6, Vb[0][1], S[2]); __builtin_amdgcn_sched_barrier(0);
            fr5 = FRG(GS_KD + 7168); S[3] = MFMA32(fr7, Vb[0][1], S[3]); __builtin_amdgcn_sched_barrier(0);
            fr6 = FRG(GS_KD + 11264); S[0] = MFMA32(fr0, Vb[1][0], S[0]); __builtin_amdgcn_sched_barrier(0);
            fr7 = FRG(GS_KD + 15360); S[1] = MFMA32(fr1, Vb[1][0], S[1]); __builtin_amdgcn_sched_barrier(0);
            fr0 = FRG(GS_QD + 0); S[2] = MFMA32(fr2, Vb[1][0], S[2]); __builtin_amdgcn_sched_barrier(0);
            fr1 = FRG(GS_QD + 8192); S[3] = MFMA32(fr3, Vb[1][0], S[3]); __builtin_amdgcn_sched_barrier(0);
            fr2 = FRG(GS_QD + 1024); S[0] = MFMA32(fr4, Vb[1][1], S[0]); __builtin_amdgcn_sched_barrier(0);
            fr3 = FRG(GS_QD + 9216); S[1] = MFMA32(fr5, Vb[1][1], S[1]); __builtin_amdgcn_sched_barrier(0);
            fr4 = FRG(GS_QD + 2048); S[2] = MFMA32(fr6, Vb[1][1], S[2]); __builtin_amdgcn_sched_barrier(0);
            fr5 = FRG(GS_QD + 10240); S[3] = MFMA32(fr7, Vb[1][1], S[3]); __builtin_amdgcn_sched_barrier(0);
            fr6 = FRG(GS_QD + 3072); O[0] = MFMA32(fr0, Sb[0][0], O[0]); __builtin_amdgcn_sched_barrier(0);
            fr7 = FRG(GS_QD + 11264); O[1] = MFMA32(fr1, Sb[0][0], O[1]); __builtin_amdgcn_sched_barrier(0);
            fr0 = FRG(GS_QD + 4096); O[0] = MFMA32(fr2, Sb[0][1], O[0]); __builtin_amdgcn_sched_barrier(0);
            fr1 = FRG(GS_QD + 12288); O[1] = MFMA32(fr3, Sb[0][1], O[1]); __builtin_amdgcn_sched_barrier(0);
            fr2 = FRG(GS_QD + 5120); O[0] = MFMA32(fr4, Sb[1][0], O[0]); __builtin_amdgcn_sched_barrier(0);
            fr3 = FRG(GS_QD + 13312); O[1] = MFMA32(fr5, Sb[1][0], O[1]); __builtin_amdgcn_sched_barrier(0);
            fr4 = FRG(GS_QD + 6144); O[0] = MFMA32(fr6, Sb[1][1], O[0]); __builtin_amdgcn_sched_barrier(0);
            fr5 = FRG(GS_QD + 14336); O[1] = MFMA32(fr7, Sb[1][1], O[1]); __builtin_amdgcn_sched_barrier(0);
            fr6 = FRG(GS_QD + 7168); O[0] = MFMA32(fr0, Sb[2][0], O[0]); __builtin_amdgcn_sched_barrier(0);
            fr7 = FRG(GS_QD + 15360); O[1] = MFMA32(fr1, Sb[2][0], O[1]); __builtin_amdgcn_sched_barrier(0);
            fr0 = FRG(GS_QK + 0); O[0] = MFMA32(fr2, Sb[2][1], O[0]); __builtin_amdgcn_sched_barrier(0);
            fr1 = FRG(GS_QK + 2048); O[1] = MFMA32(fr3, Sb[2][1], O[1]); __builtin_amdgcn_sched_barrier(0);
            fr2 = FRG(GS_QK + 4096); O[0] = MFMA32(fr4, Sb[3][0], O[0]); __builtin_amdgcn_sched_barrier(0);
            fr3 = FRG(GS_QK + 1024); O[1] = MFMA32(fr5, Sb[3][0], O[1]); __builtin_amdgcn_sched_barrier(0);
            fr4 = FRG(GS_QK + 3072); O[0] = MFMA32(fr6, Sb[3][1], O[0]); __builtin_amdgcn_sched_barrier(0);
            fr5 = FRG(GS_QK + 5120); O[1] = MFMA32(fr7, Sb[3][1], O[1]); __builtin_amdgcn_sched_barrier(0);
            O[0] = MFMA32(fr0, Vb[0][0], O[0]); __builtin_amdgcn_sched_barrier(0);
            O[1] = MFMA32(fr1, Vb[0][0], O[1]); __builtin_amdgcn_sched_barrier(0);
            O[1] = MFMA32(fr2, Vb[1][0], O[1]); __builtin_amdgcn_sched_barrier(0);
            O[0] = MFMA32(fr3, Vb[0][1], O[0]); __builtin_amdgcn_sched_barrier(0);
            O[1] = MFMA32(fr4, Vb[0][1], O[1]); __builtin_amdgcn_sched_barrier(0);
            O[1] = MFMA32(fr5, Vb[1][1], O[1]); __builtin_amdgcn_sched_barrier(0);
#undef FRG
            {
                LAS unsigned short* ob = (LAS unsigned short*)(lbase + GS_OB + (n & 1) * GS_OBSZ) + (4 * hh) * 136 + 32 * F.wave + r;
#pragma unroll
                for (int ti = 0; ti < 2; ++ti)
#pragma unroll
                    for (int g = 0; g < 16; ++g) ob[(32 * ti + (g & 3) + 8 * (g >> 2)) * 136] = (unsigned short)(pkbf(O[ti][g], 0.f) & 0xffffu);
            }
            GS_BAR_COMPUTE();
        }
    }
#undef GS_ISSUE
#undef GS_OSTORE
}

__device__ __forceinline__ void gdn_scan_helper(const Frame& F, const bf16* WF, const bf16* QDF, const bf16* KDF, const bf16* QKF, const float* UU, const unsigned* prog) {
    const int k = (F.bx - BATCH * NH) >> 3;
    if (k < 0 || k >= 24) return;
    const int bh = (F.bx & 7) + 8 * (k & 7), role = k >> 3;
    const size_t cb = (size_t)bh * GD_NCH;
    unsigned dummy = 0u; int touched = 0;
    for (int it = 0; it < (1 << 20) && touched < GD_NCH; ++it) {
        const int p = __builtin_amdgcn_readfirstlane((int)__hip_atomic_load(prog + 16 * bh, __ATOMIC_RELAXED, __HIP_MEMORY_SCOPE_AGENT));
        const int target = p + 5 < GD_NCH ? p + 5 : GD_NCH;
        for (; touched < target; ++touched) {
            const size_t c = cb + touched; const char* a; int nlines;
            if (role == 0) { a = (const char*)(WF + c * 8192); nlines = 128; }
            else if (role == 1) { a = (const char*)(QDF + c * 8192); nlines = 128; }
            else { a = (const char*)(KDF + c * 8192); nlines = 128; }
            if (F.tid < nlines) { const char* q_ = a + F.tid * 128; asm volatile("global_load_dword %0, %1, off" : "+v"(dummy) : "v"(q_) : "memory"); }
            const char* a2 = role == 0 ? (const char*)(QKF + c * 4096) : (const char*)((const unsigned*)UU + c * 4096) + (role - 1) * 8192;
            const int n2 = role == 0 ? 48 : 64;
            if (F.tid >= 128 && F.tid < 128 + n2) { const char* q_ = a2 + (F.tid - 128) * 128; asm volatile("global_load_dword %0, %1, off" : "+v"(dummy) : "v"(q_) : "memory"); }
        }
        if (p >= GD_NCH) break;
        __builtin_amdgcn_s_sleep(8);
    }
    asm volatile("s_waitcnt vmcnt(0)" : "+v"(dummy) :: "memory");
}


template <class Epi, bool F8 = false> __device__ __forceinline__ void run_gemm(const Frame& F, const bf16* A, const bf16* Bt, int N, int K, const Epi& E) {
    pg8::Gemm g{A, Bt, M, N, F8 ? K / 2 : K}; pg8::StaticOrder S; S.init(M, N, F.G, F.bx);
    pg8::gemm_phase<Epi, pg8::StaticOrder, true, true, F8>(F.lds + RING_OFF, g, S, E);
}
#ifndef MK_F8_FFNS
#define MK_F8_FFNS 4
#endif
__host__ __device__ constexpr bool ffn_f8(int f) { return f >= 8 - MK_F8_FFNS; }
#ifndef MK_F8_IN
#define MK_F8_IN 3
#endif
static_assert(MK_F8_IN <= 7 && MK_F8_IN <= MK_F8_FFNS, "fp8 in-projections: never the first FFN (its rows come from P0), and only FFNs whose out-projection is fp8 too");
__host__ __device__ constexpr bool ffn_in_f8(int f) { return f < 8 && f >= 8 - MK_F8_IN; }
constexpr float F8_UNSCALE_IN = 1.0f / (pg8::F8_XS * pg8::F8_WS);
#define P_X8 WSP(unsigned char, WS_X8)
constexpr float F8_UNSCALE = 1.0f / (pg8::F8_HS * pg8::F8_WS);
__host__ __device__ constexpr int layer_base(int L) { return L == 0 ? 1 : L == 1 ? 11 : L == 2 ? 18 : 29; }
constexpr int NPH = 39;
#define WSP(T, off) ((T*)(F.ws + (off)))
#define P_XB   WSP(bf16, WS_XB)
#define P_HID  WSP(bf16, WS_HID)
#define P_RSS(v) (WSP(unsigned long long, WS_ROWSS) + (size_t)(v) * M)
#define P_WB(g) WSP(bf16, ((g) & 1) ? WS_WB1 : WS_WB0)

#define MI_(i) ((unsigned)__builtin_amdgcn_readfirstlane((int)((const volatile LAS unsigned*)((LAS unsigned char*)lds + MISC_OFF))[(i)]))
#define KP0() ((kargp)(((unsigned long long)MI_(19) << 32) | (unsigned long long)MI_(18)))
#define IN(k) ({ kargp k_ = KP0(); const int lo_ = karg<int>(k_, 192), hi_ = karg<int>(k_, 196); lo_ <= (k) && (k) < hi_; })
#define SEAM(k) do { kargp k_ = KP0(); if ((k) + 1 < karg<int>(k_, 196)) { XcdBarrier b_; b_.bar = (unsigned*)(ARG_WS(k_) + WS_CTL) + CW_BAR; b_.x = xb_xcc_id(); b_.st = (volatile LAS unsigned*)((LAS unsigned char*)lds + MISC_OFF) + 8; xcd_barrier(b_); } } while (0)
#define HWSLOT() ((int)(__builtin_amdgcn_s_getreg((5 << 11) | 4) & 63u))
#define ENTER() constexpr int L = Lrt; kargp kp_ = KP0(); do { int t_ = mk_tid(); asm volatile("" : "+v"(t_)); const int g_ = (int)MI_(17), bx_ = (int)MI_(16); \
        F.tid = t_; F.lane = t_ & 63; F.wave = __builtin_amdgcn_readfirstlane(t_ >> 6); F.G = g_; F.bx = bx_; F.vcu = (g_ % 8 == 0) ? (bx_ % 8) * (g_ / 8) + bx_ / 8 : bx_; \
        F.gw = F.vcu * NWAVES + F.wave; F.NGW = g_ * NWAVES; F.ws = ARG_WS(kp_); } while (0); \
    constexpr int g0 = 6 * L, jj = L == 3 ? 1 : 0; (void)g0; (void)jj
#define REFRESH() do { kp_ = KP0(); F.ws = ARG_WS(kp_); } while (0)

template <int Lrt> __device__ __forceinline__ void run_layer(Frame& F, unsigned char* lds) {
    constexpr int pb = layer_base(Lrt), kind = Lrt == 1 ? 1 : Lrt == 2 ? 2 : 0;
        constexpr bool f8a = ffn_f8(2 * Lrt), f8b = ffn_f8(2 * Lrt + 1), f8ia = ffn_in_f8(2 * Lrt), f8ib = ffn_in_f8(2 * Lrt + 1), f8in = ffn_in_f8(2 * Lrt + 2);
        if (IN(pb + 0)) { ENTER(); CVT_FFN_OUT(kp_, 6, L, P_WB(g0 + 1), f8a); REFRESH();
            pg8::EpiIn<0, f8a> E{P_RSS(3 * L), P_HID, nullptr, nullptr, FF, f8ia ? F8_UNSCALE_IN : 1.0f}; run_gemm<pg8::EpiIn<0, f8a>, f8ia>(F, f8ia ? (const bf16*)P_X8 : P_XB, P_WB(g0), 2 * FF, D, E); SEAM(pb + 0); }
        if (IN(pb + 1)) { ENTER(); CVT_MIX_IN(kp_, kind, L, jj, P_WB(g0 + 2)); REFRESH();
            pg8::EpiRes<false> E{nullptr, P_XB, P_RSS(3 * L + 1), f8a ? 0.5f * F8_UNSCALE : 0.5f}; run_gemm<pg8::EpiRes<false>, f8a>(F, P_HID, P_WB(g0 + 1), D, FF, E); SEAM(pb + 1); }
        constexpr int pf = kind == 0 ? pb + 8 : kind == 1 ? pb + 5 : pb + 9;
        if constexpr (kind == 0) {
            if (IN(pb + 2)) { ENTER(); CVT_MIX_OUT(kp_, 14, jj, P_WB(g0 + 3), false); REFRESH();
                pg8::EpiIn<3> E{P_RSS(3 * L + 1), WSP(bf16, WS_GD_PROJ), nullptr, WSP(float, WS_GD_AB), 16384}; run_gemm(F, P_XB, P_WB(g0 + 2), GDN_NP, D, E); SEAM(pb + 2); }
            if (IN(pb + 3)) { ENTER(); gdn_prep2(F, WSP(bf16, WS_GD_PROJ), WSP(float, WS_GD_AB), ARG_IN(kp_, 10) + (size_t)jj * 4 * 3 * D, ARG_IN(kp_, 11) + jj * NH, ARG_IN(kp_, 12) + jj * NH,
                                       WSP(bf16, WS_GD_QN), WSP(bf16, WS_GD_KN), WSP(bf16, WS_GD_QD), WSP(bf16, WS_GD_KDT), WSP(bf16, WS_GD_KWT), WSP(bf16, WS_GD_VUT),
                                       WSP(float, WS_GD_TAB), WSP(float, WS_GD_TAB) + (size_t)BATCH * NH * SEQ); SEAM(pb + 3); }
            if (IN(pb + 4)) { ENTER(); gdn_chunk(F, WSP(bf16, WS_GD_QN), WSP(bf16, WS_GD_KN), WSP(bf16, WS_GD_KWT), WSP(bf16, WS_GD_VUT), WSP(float, WS_GD_TAB), WSP(float, WS_GD_TAB) + (size_t)BATCH * NH * SEQ,
                                       WSP(bf16, WS_GD_WF), WSP(float, WS_GD_U), WSP(bf16, WS_GD_QKM)); SEAM(pb + 4); }
            if (IN(pb + 5)) { ENTER(); unsigned* prog = (unsigned*)(F.ws + WS_CTL) + CW_PROG + jj * 1024;
                if (F.bx < BATCH * NH) gdn_scan(F, WSP(bf16, WS_GD_WF), WSP(bf16, WS_GD_QD), WSP(bf16, WS_GD_KDT), WSP(bf16, WS_GD_QKM), WSP(float, WS_GD_U), WSP(float, WS_GD_TAB), WSP(bf16, WS_GD_O), prog);
                else gdn_scan_helper(F, WSP(bf16, WS_GD_WF), WSP(bf16, WS_GD_QD), WSP(bf16, WS_GD_KDT), WSP(bf16, WS_GD_QKM), WSP(float, WS_GD_U), prog);
                SEAM(pb + 5); }
            if (IN(pb + 6)) { ENTER(); gdn_outnorm(F, WSP(bf16, WS_GD_O), WSP(bf16, WS_GD_PROJ), ARG_IN(kp_, 13) + jj * HD, WSP(bf16, WS_GD_OG)); SEAM(pb + 6); }
            if (IN(pb + 7)) { ENTER(); CVT_FFN_IN(kp_, 7, 4, L, P_WB(g0 + 4), f8ib); REFRESH();
                pg8::EpiRes<false, f8ib> E{nullptr, P_XB, P_RSS(3 * L + 2), 1.0f, P_X8}; run_gemm(F, WSP(bf16, WS_GD_OG), P_WB(g0 + 3), D, D, E); SEAM(pb + 7); }
        } else if constexpr (kind == 1) {
            if (IN(pb + 2)) { ENTER(); CVT_MIX_OUT(kp_, 17, 0, P_WB(g0 + 3), false); REFRESH();
                pg8::EpiIn<2> E{P_RSS(3 * L + 1), WSP(bf16, WS_SC_U), WSP(bf16, WS_SC_GB), nullptr, D}; run_gemm(F, P_XB, P_WB(g0 + 2), 3 * D, D, E); SEAM(pb + 2); }
            if (IN(pb + 3)) { ENTER(); sc_conv(F, WSP(bf16, WS_SC_U), WSP(bf16, WS_SC_GB), ARG_IN(kp_, 16) + (size_t)jj * 3 * D, WSP(bf16, WS_SC_A2)); SEAM(pb + 3); }
            if (IN(pb + 4)) { ENTER(); CVT_FFN_IN(kp_, 7, 4, L, P_WB(g0 + 4), f8ib); REFRESH();
                pg8::EpiRes<false, f8ib> E{nullptr, P_XB, P_RSS(3 * L + 2), 1.0f, P_X8}; run_gemm(F, WSP(bf16, WS_SC_A2), P_WB(g0 + 3), D, D, E); SEAM(pb + 4); }
        } else {
            if (IN(pb + 2)) { ENTER(); CVT_MIX_OUT(kp_, 21, 0, P_WB(g0 + 3), true); REFRESH();
                pg8::EpiIn<1> E{P_RSS(3 * L + 1), WSP(bf16, WS_MB_PROJ), nullptr, nullptr, 3 * D}; run_gemm(F, P_XB, P_WB(g0 + 2), 3 * D, D, E); SEAM(pb + 2); }
            if (IN(pb + 3)) { ENTER(); moba_prep(F, WSP(bf16, WS_MB_PROJ), ARG_IN(kp_, 19) + jj * HD, ARG_IN(kp_, 20) + jj * HD, WSP(float, WS_ROPE), WSP(bf16, WS_MB_Q), WSP(bf16, WS_MB_K), WSP(float, WS_MB_KMEAN)); SEAM(pb + 3); }
            if (IN(pb + 4)) { ENTER(); moba_select(F, WSP(bf16, WS_MB_Q), WSP(float, WS_MB_KMEAN), WSP(unsigned, WS_MB_SEL), WSP(float, WS_MB_LSE)); SEAM(pb + 4); }
            if (IN(pb + 5)) { ENTER(); moba_lists(F, WSP(unsigned, WS_MB_SEL), WSP(unsigned, WS_MB_LIST), WSP(unsigned, WS_MB_CNT), (unsigned*)(F.ws + WS_CTL) + CW_QHEAD); SEAM(pb + 5); }
            if (IN(pb + 6)) { ENTER(); moba_attn_sparse(F, (char*)lds, WSP(bf16, WS_MB_Q), WSP(bf16, WS_MB_K), WSP(bf16, WS_MB_PROJ), WSP(unsigned, WS_MB_LIST), WSP(unsigned, WS_MB_CNT),
                                               WSP(bf16, WS_MB_OPART), WSP(float, WS_MB_LSE), (unsigned*)(F.ws + WS_CTL) + CW_QHEAD); SEAM(pb + 6); }
            if (IN(pb + 7)) { ENTER(); moba_combine(F, WSP(bf16, WS_MB_OPART), WSP(float, WS_MB_LSE), WSP(bf16, WS_MB_O)); SEAM(pb + 7); }
            if (IN(pb + 8)) { ENTER(); CVT_FFN_IN(kp_, 7, 4, L, P_WB(g0 + 4), f8ib); REFRESH();
                pg8::EpiRes<false, f8ib> E{nullptr, P_XB, P_RSS(3 * L + 2), 1.0f, P_X8}; run_gemm(F, WSP(bf16, WS_MB_O), P_WB(g0 + 3), D, D, E); SEAM(pb + 8); }
        }
        if (IN(pf)) { ENTER(); CVT_FFN_OUT(kp_, 8, L, P_WB(g0 + 5), f8b); REFRESH();
            pg8::EpiIn<0, f8b> E{P_RSS(3 * L + 2), P_HID, nullptr, nullptr, FF, f8ib ? F8_UNSCALE_IN : 1.0f}; run_gemm<pg8::EpiIn<0, f8b>, f8ib>(F, f8ib ? (const bf16*)P_X8 : P_XB, P_WB(g0 + 4), 2 * FF, D, E); SEAM(pf); }
        if (IN(pf + 1)) { ENTER(); if (L + 1 < DEPTH) CVT_FFN_IN(kp_, 5, 2, L + 1, P_WB(g0 + 6), f8in); REFRESH();
            pg8::EpiRes<(L == DEPTH - 1), f8in> E{ARG_OUT(kp_), P_XB, P_RSS(3 * L + 3), f8b ? 0.5f * F8_UNSCALE : 0.5f, P_X8}; run_gemm<pg8::EpiRes<(L == DEPTH - 1), f8in>, f8b>(F, P_HID, P_WB(g0 + 5), D, FF, E); SEAM(pf + 1); }

}

__global__ void __launch_bounds__(NWAVES * 64, 2) mk_fwd(Args args) {
    extern __shared__ __attribute__((aligned(16))) unsigned char lds[];
    Frame F;
    F.lds = (LAS unsigned char*)lds;
    F.MISC = (volatile LAS unsigned*)(F.lds + MISC_OFF);
    F.tid = threadIdx.x;
    if (F.tid == 0) { const unsigned long long kpv = (unsigned long long)__builtin_amdgcn_kernarg_segment_ptr(); F.MISC[16] = blockIdx.x; F.MISC[17] = gridDim.x; F.MISC[18] = (unsigned)kpv; F.MISC[19] = (unsigned)(kpv >> 32); }
    if ((F.tid & 63) == 0) F.MISC[32 + mk_hwslot()] = F.tid >> 6;
    for (int u = F.tid; u < (LDS_BYTES - LDSCTL_OFF) / 4; u += NWAVES * 64) { const int mi = u - (MISC_OFF - LDSCTL_OFF) / 4; if (mi < 16 || (mi > 19 && mi < 32) || mi >= 96) ((LAS unsigned*)(F.lds + LDSCTL_OFF))[u] = 0u; }
    __syncthreads();
    { kargp k_ = KP0(); (void)xcd_barrier_post((unsigned*)(ARG_WS(k_) + WS_CTL) + CW_BAR, (volatile LAS unsigned*)((LAS unsigned char*)lds + MISC_OFF) + 8); }
    if (IN(0)) { constexpr int Lrt = 0; ENTER(); p0_rows(F, ARG_IN(kp_, 0), P_XB, P_RSS(0)); rope_table(F, (const int*)ARG_IN(kp_, 1), WSP(float, WS_ROPE)); CVT_FFN_IN(kp_, 5, 2, 0, P_WB(0), false); REFRESH(); SEAM(0); }
    run_layer<0>(F, lds); run_layer<1>(F, lds); run_layer<2>(F, lds); run_layer<3>(F, lds);
#ifdef MK_PROBE_LIST
    if (IN(40)) { constexpr int Lrt = 0; ENTER(); pg8::EpiRes<false> E{nullptr, WSP(bf16, WS_GD_O), P_RSS(12), 0.5f}; run_gemm(F, P_HID, P_WB(1), D, FF, E); }
    if (IN(41)) { constexpr int Lrt = 0; ENTER(); pg8::EpiIn<1> E{P_RSS(0), WSP(bf16, WS_GD_O), nullptr, nullptr, D}; run_gemm(F, P_HID, P_WB(1), D, FF, E); }
#endif
}
#undef IN
#undef SEAM
#undef ENTER
#undef REFRESH

#ifndef MK_MULTI
#define MK_MULTI 0
#endif
extern "C" void kernel_launch(void* const* d_in, const int* in_sizes, int n_in, void* d_out, int out_size, void* d_ws, size_t ws_size, hipStream_t stream) {
    static int grid = 0;
    if (grid == 0) {
        if (n_in != 22 || out_size != M * D || ws_size < WS_END) { fprintf(stderr, "kernel_launch: unexpected shapes (n_in %d out %d ws %zu)\n", n_in, out_size, ws_size); grid = -1; return; }
        int dev = 0, cus = 0, per_cu = 0;
        if (hipGetDevice(&dev) != hipSuccess || hipDeviceGetAttribute(&cus, hipDeviceAttributeMultiprocessorCount, dev) != hipSuccess) { grid = -1; return; }
        if (hipFuncSetAttribute((const void*)mk_fwd, hipFuncAttributeMaxDynamicSharedMemorySize, LDS_BYTES) != hipSuccess) { fprintf(stderr, "kernel_launch: hipFuncSetAttribute failed\n"); grid = -1; return; }
        if (hipOccupancyMaxActiveBlocksPerMultiprocessor(&per_cu, (const void*)mk_fwd, NWAVES * 64, LDS_BYTES) != hipSuccess || per_cu < 1) { fprintf(stderr, "kernel_launch: occupancy query reports %d\n", per_cu); per_cu = 1; }
        (void)hipGetLastError();
        grid = cus;
    }
    if (grid < 0) return;
    if (hipMemsetAsync((char*)d_ws + WS_CTL, 0, CTL_ZERO_BYTES, stream) != hipSuccess) return;
    Args a{};
    for (int i = 0; i < 22; ++i) a.in[i] = (const float*)d_in[i];
    a.out = (float*)d_out; a.ws = (unsigned char*)d_ws;
#if MK_MULTI
    for (int p = 0; p < NPH; ++p) { a.ph_lo = p; a.ph_hi = p + 1; hipLaunchKernelGGL(mk_fwd, dim3(grid), dim3(NWAVES * 64), LDS_BYTES, stream, a); }
#else
    a.ph_lo = 0; a.ph_hi = NPH;
    hipLaunchKernelGGL(mk_fwd, dim3(grid), dim3(NWAVES * 64), LDS_BYTES, stream, a);
#ifdef MK_PROBE_LIST
    { const int plist[] = {MK_PROBE_LIST};
      for (int p : plist) { a.ph_lo = p; a.ph_hi = p + 1; (void)hipMemsetAsync((char*)d_ws + WS_CTL + 4 * CW_QHEAD, 0, 4, stream); hipLaunchKernelGGL(mk_fwd, dim3(grid), dim3(NWAVES * 64), LDS_BYTES, stream, a); } }
#endif
#endif
}
```

```cpp
#include <hip/hip_runtime.h>
#include <cstdio>
#include <cstdint>
#define MK_LAS __attribute__((address_space(3)))
constexpr int MK_MISC_ABS = 155648 + 320;
__device__ __forceinline__ int mk_hwslot() { return (int)(__builtin_amdgcn_s_getreg((5 << 11) | 4) & 63u); }
__device__ __forceinline__ int mk_tid() {
    const unsigned w = ((const volatile MK_LAS unsigned*)(unsigned)MK_MISC_ABS)[32 + mk_hwslot()];
    int l_; asm volatile("v_mbcnt_lo_u32_b32 %0, -1, 0\n\tv_mbcnt_hi_u32_b32 %0, -1, %0" : "=v"(l_));
    return __builtin_amdgcn_readfirstlane((int)w) * 64 + l_;
}
namespace pg8 {
#define PG8_LAS __attribute__((address_space(3)))
typedef unsigned short bf16_t;
typedef short bf16x8 __attribute__((ext_vector_type(8)));
typedef float f32x4 __attribute__((ext_vector_type(4)));
typedef unsigned u32x4 __attribute__((ext_vector_type(4)));
typedef int i32x4 __attribute__((ext_vector_type(4)));
typedef int i32x8 __attribute__((ext_vector_type(8)));
__device__ __forceinline__ f32x4 mma_f8(bf16x8 a0, bf16x8 a1, bf16x8 b0, bf16x8 b1, f32x4 c) {
    const i32x8 A = __builtin_shufflevector(__builtin_bit_cast(i32x4, a0), __builtin_bit_cast(i32x4, a1), 0, 1, 2, 3, 4, 5, 6, 7);
    const i32x8 B = __builtin_shufflevector(__builtin_bit_cast(i32x4, b0), __builtin_bit_cast(i32x4, b1), 0, 1, 2, 3, 4, 5, 6, 7);
    return __builtin_amdgcn_mfma_scale_f32_16x16x128_f8f6f4(A, B, c, 0, 0, 0, 0, 0, 0);
}
constexpr int BM = 256, BK = 64, HALF = 128, HTB = HALF * BK * 2  , STAGE_BYTES = 8 * HTB, NXCD = 8, WGM = 8;

__host__ __device__ __forceinline__ int lds_byte(int r, int c) { const int st = (r >> 4) * 2 + (c >> 5), rr = r & 15, cc = c & 31, ob = rr * 64 + cc * 2; return st * 1024 + (ob ^ (((ob >> 9) & 1) << 5)); }
__host__ __device__ __forceinline__ void stage_rc(int b, int& R, int& C) { const int st = b / 1024, sb = b % 1024, swz = sb ^ (((sb >> 9) & 1) << 5); R = (st >> 1) * 16 + swz / 64; C = (st & 1) * 32 + (swz % 64) / 2; }
__host__ __device__ __forceinline__ int perm32(int rho) { const int n = rho >> 4, i = rho & 15; return 8 * (i >> 2) + 4 * n + (i & 3); }

struct Unit { int pm, pn; };
struct Gemm { const bf16_t* A; const bf16_t* Bt; int M, N, K; };

struct StaticOrder {
    int nM, nN, nwg, G, c;
    __host__ __device__ void init(int M, int N, int G_, int c_) { nM = M / BM; nN = N / BM; nwg = nM * nN; G = G_; c = c_; }
    __host__ __device__ bool next(int i, Unit& u) const {
        const long L = (long)i * G + c; if (L >= nwg) return false;
        int wgid = (int)L; { const int q = nwg / NXCD, r = nwg % NXCD, xcd = wgid % NXCD, off = wgid / NXCD; wgid = (xcd < r ? xcd * (q + 1) : r * (q + 1) + (xcd - r) * q) + off; }
        const int nig = WGM * nN, gid = wgid / nig, fm = gid * WGM, gsz = (nM - fm) < WGM ? (nM - fm) : WGM;
        u.pm = fm + ((wgid % nig) % gsz); u.pn = (wgid % nig) / gsz; return true;
    }
    __device__ __forceinline__ void a_ready(const Unit&) const {}
    __device__ __forceinline__ void done(const Unit&) const {}
};
typedef float f32x2v __attribute__((ext_vector_type(2)));
typedef __bf16 bf2v __attribute__((ext_vector_type(2)));
__device__ __forceinline__ unsigned pkbf(float lo, float hi) { f32x2v v = {lo, hi}; return __builtin_bit_cast(unsigned, __builtin_convertvector(v, bf2v)); }
__device__ __forceinline__ float silu_f(float x) { return x * __builtin_amdgcn_rcpf(1.0f + __builtin_amdgcn_exp2f(-1.4426950408889634f * x)); }
__device__ __forceinline__ u32x4 pack8f(f32x4 a, f32x4 b) { u32x4 w; w.x = pkbf(a[0], a[1]); w.y = pkbf(a[2], a[3]); w.z = pkbf(b[0], b[1]); w.w = pkbf(b[2], b[3]); return w; }
constexpr float RMS_EPS = 1e-6f;
constexpr float F8_HS = 8.0f, F8_WS = 1024.0f, F8_XS = 16.0f;
typedef unsigned u32x2 __attribute__((ext_vector_type(2)));
__device__ __forceinline__ float f8c(float v, float sc) { return __builtin_amdgcn_fmed3f(v * sc, -448.f, 448.f); }
__device__ __forceinline__ unsigned pk4f8(float a, float b, float c, float d, float sc) { int w = __builtin_amdgcn_cvt_pk_fp8_f32(f8c(a, sc), f8c(b, sc), 0, false); w = __builtin_amdgcn_cvt_pk_fp8_f32(f8c(c, sc), f8c(d, sc), w, true); return (unsigned)w; }
template <int MODE, bool O8 = false> struct EpiIn {
    static constexpr bool PERM = true, AFTER_DRAIN = false;
    const unsigned long long* rowss; bf16_t* O0; bf16_t* O1; float* OF; int ldc; float usc = 1.0f;
    __device__ __forceinline__ void operator()(const f32x4 (&acc)[2][2][4][2], const Unit& u, int wr, int wc, int fr, int fq) const {
        const int row0 = u.pm * BM + wr * 64 + fr; const int cw = wc * 32 + 8 * fq;
#pragma unroll
        for (int ai = 0; ai < 2; ++ai)
#pragma unroll
            for (int m = 0; m < 4; ++m) {
                const int row = row0 + ai * HALF + m * 16;
                const float rs = usc * __builtin_amdgcn_rsqf((float)rowss[row] * (1.0f / (4096.0f * 16777216.0f)) + RMS_EPS);
                if constexpr (MODE == 0) {
                    f32x4 g0 = acc[ai][0][m][0] * rs, g1 = acc[ai][0][m][1] * rs, u0 = acc[ai][1][m][0] * rs, u1 = acc[ai][1][m][1] * rs;
#pragma unroll
                    for (int j = 0; j < 4; ++j) { g0[j] = silu_f(g0[j]) * u0[j]; g1[j] = silu_f(g1[j]) * u1[j]; }
                    if constexpr (O8) { u32x2 w; w.x = pk4f8(g0[0], g0[1], g0[2], g0[3], F8_HS); w.y = pk4f8(g1[0], g1[1], g1[2], g1[3], F8_HS);
                        *(u32x2*)((unsigned char*)O0 + (size_t)row * ldc + u.pn * HALF + cw) = w; }
                    else *(u32x4*)(O0 + (size_t)row * ldc + u.pn * HALF + cw) = pack8f(g0, g1);
                } else if constexpr (MODE == 1) {
#pragma unroll
                    for (int bj = 0; bj < 2; ++bj) *(u32x4*)(O0 + (size_t)row * ldc + u.pn * BM + bj * HALF + cw) = pack8f(acc[ai][bj][m][0] * rs, acc[ai][bj][m][1] * rs);
                } else if constexpr (MODE == 2) {
                    if (u.pn < 32) { const f32x4 a0 = (acc[ai][0][m][0] * rs) * (acc[ai][1][m][0] * rs), a1 = (acc[ai][0][m][1] * rs) * (acc[ai][1][m][1] * rs);
                        *(u32x4*)(O0 + (size_t)row * 4096 + u.pn * HALF + cw) = pack8f(a0, a1); }
                    else {
#pragma unroll
                        for (int bj = 0; bj < 2; ++bj) *(u32x4*)(O1 + (size_t)row * 4096 + (u.pn - 32) * BM + bj * HALF + cw) = pack8f(acc[ai][bj][m][0] * rs, acc[ai][bj][m][1] * rs); }
                } else {
                    if (u.pn < 64) {
#pragma unroll
                        for (int bj = 0; bj < 2; ++bj) *(u32x4*)(O0 + (size_t)row * 16384 + u.pn * BM + bj * HALF + cw) = pack8f(acc[ai][bj][m][0] * rs, acc[ai][bj][m][1] * rs); }
                    else if (wc < 2) { *(f32x4*)(OF + (size_t)row * 64 + cw) = acc[ai][0][m][0] * rs; *(f32x4*)(OF + (size_t)row * 64 + cw + 4) = acc[ai][0][m][1] * rs; }
                }
            }
    }
};
template <bool FINAL, bool X8 = false> struct EpiRes {
    static constexpr bool PERM = true, AFTER_DRAIN = false;
    float* out; bf16_t* xb; unsigned long long* rowss_next; float scale; unsigned char* x8 = nullptr;
    __device__ __forceinline__ void operator()(const f32x4 (&acc)[2][2][4][2], const Unit& u, int wr, int wc, int fr, int fq) const {
        const int row0 = u.pm * BM + wr * 64 + fr, col0 = u.pn * BM + wc * 32 + 8 * fq;
#pragma unroll
        for (int ai = 0; ai < 2; ++ai) {
            u32x4 bs[4][2];
#pragma unroll
            for (int m = 0; m < 4; ++m)
#pragma unroll
                for (int bj = 0; bj < 2; ++bj) bs[m][bj] = *(const u32x4*)(xb + (size_t)(row0 + ai * HALF + m * 16) * 4096 + col0 + bj * HALF);
#pragma unroll
            for (int m = 0; m < 4; ++m) {
                const int row = row0 + ai * HALF + m * 16; const size_t off = (size_t)row * 4096 + col0; float ss = 0.f;
#pragma unroll
                for (int bj = 0; bj < 2; ++bj) {
                    const u32x4 b = bs[m][bj];
                    f32x4 o0, o1;
                    o0[0] = __builtin_bit_cast(float, b.x << 16) + acc[ai][bj][m][0][0] * scale; o0[1] = __builtin_bit_cast(float, b.x & 0xffff0000u) + acc[ai][bj][m][0][1] * scale;
                    o0[2] = __builtin_bit_cast(float, b.y << 16) + acc[ai][bj][m][0][2] * scale; o0[3] = __builtin_bit_cast(float, b.y & 0xffff0000u) + acc[ai][bj][m][0][3] * scale;
                    o1[0] = __builtin_bit_cast(float, b.z << 16) + acc[ai][bj][m][1][0] * scale; o1[1] = __builtin_bit_cast(float, b.z & 0xffff0000u) + acc[ai][bj][m][1][1] * scale;
                    o1[2] = __builtin_bit_cast(float, b.w << 16) + acc[ai][bj][m][1][2] * scale; o1[3] = __builtin_bit_cast(float, b.w & 0xffff0000u) + acc[ai][bj][m][1][3] * scale;
                    if constexpr (FINAL) { *(f32x4*)(out + off + bj * HALF) = o0; *(f32x4*)(out + off + bj * HALF + 4) = o1; }
                    else { const u32x4 w = pack8f(o0, o1); *(u32x4*)(xb + off + bj * HALF) = w;
                        const float r0 = __builtin_bit_cast(float, w.x << 16), r1 = __builtin_bit_cast(float, w.x & 0xffff0000u), r2 = __builtin_bit_cast(float, w.y << 16), r3 = __builtin_bit_cast(float, w.y & 0xffff0000u);
                        const float r4 = __builtin_bit_cast(float, w.z << 16), r5 = __builtin_bit_cast(float, w.z & 0xffff0000u), r6 = __builtin_bit_cast(float, w.w << 16), r7 = __builtin_bit_cast(float, w.w & 0xffff0000u);
                        ss += ((r0 * r0 + r1 * r1) + (r2 * r2 + r3 * r3)) + ((r4 * r4 + r5 * r5) + (r6 * r6 + r7 * r7));
                        if constexpr (X8) { u32x2 w8; w8.x = pk4f8(r0, r1, r2, r3, F8_XS); w8.y = pk4f8(r4, r5, r6, r7, F8_XS); *(u32x2*)(x8 + off + bj * HALF) = w8; } }
                }
                if constexpr (!FINAL) { ss += __shfl_xor(ss, 16); ss += __shfl_xor(ss, 32);
                    if (fq == 0) __hip_atomic_fetch_add(rowss_next + row, (unsigned long long)(ss * 16777216.0f + 0.5f), __ATOMIC_RELAXED, __HIP_MEMORY_SCOPE_AGENT); }
            }
            asm volatile("" ::: "memory");
        }
    }
};
template <class Epi, class Sched, bool ALIGN_EPI = false, bool SP2 = false, bool F8 = false>
__device__ __forceinline__ void gemm_phase(PG8_LAS unsigned char* lds, const Gemm g, const Sched& S, const Epi& E) {
    int tid_ = mk_tid(); asm volatile("" : "+v"(tid_));
    const int tid = tid_, wid = __builtin_amdgcn_readfirstlane(tid >> 6), lane = tid & 63, wr = wid >> 2, wc = wid & 3, fr = lane & 15, fq = lane >> 4;
    const int K = g.K, nt = K / BK;
    unsigned voffA[2], voffB[2];
#pragma unroll
    for (int i = 0; i < 2; ++i) { int R, C; stage_rc(tid * 16 + i * 8192, R, C); const int Rb = Epi::PERM ? ((R & ~31) + perm32(R & 31)) : R;
        voffA[i] = (unsigned)(R * K + C) * 2u; voffB[i] = (unsigned)(Rb * K + C) * 2u; }
    const size_t kstep = (size_t)(BK * 2);
    const size_t hstep = (size_t)HALF * K * 2;
    const size_t tstep = 2 * hstep;
    const unsigned ldsw = (unsigned)wid * 1024u;
    const int aoff = lds_byte(wr * 64 + fr, fq * 8), boff = lds_byte(wc * 32 + fr, fq * 8);
#define PG8_SA(b, h) (((b) * 2 + (h)) * HTB)
#define PG8_SB(b, h) ((4 + (b) * 2 + (h)) * HTB)
#define PG8_STAGE(bufoff, gbase, voff) do { const char* gb_ = (const char*)(gbase); if constexpr (F8) asm volatile("" : "+s"(gb_));     \
        _Pragma("unroll") for (int _i = 0; _i < 2; ++_i) \
        __builtin_amdgcn_global_load_lds((const unsigned*)(gb_ + (voff)[_i]), (PG8_LAS unsigned*)(lds + (bufoff) + ldsw + _i * 8192), 16, 0, 0); } while (0)
#define PG8_LDA(dst, b, h) do { _Pragma("unroll") for (int m = 0; m < 4; ++m) _Pragma("unroll") for (int k = 0; k < 2; ++k) dst[m][k] = *(const PG8_LAS bf16x8*)(lds + PG8_SA(b, h) + aoff + m * 2048 + k * 1024); } while (0)
#define PG8_LDB(dst, b, h) do { _Pragma("unroll") for (int n = 0; n < 2; ++n) _Pragma("unroll") for (int k = 0; k < 2; ++k) dst[n][k] = *(const PG8_LAS bf16x8*)(lds + PG8_SB(b, h) + boff + n * 2048 + k * 1024); } while (0)
#define PG8_MMA(ai, bj, At, Bt) do { __builtin_amdgcn_s_setprio(1); _Pragma("unroll") for (int m = 0; m < 4; ++m) _Pragma("unroll") for (int n = 0; n < 2; ++n) { \
        if constexpr (F8) acc[ai][bj][m][n] = mma_f8(Bt[n][0], Bt[n][1], At[m][0], At[m][1], acc[ai][bj][m][n]); \
        else { _Pragma("unroll") for (int k = 0; k < 2; ++k) acc[ai][bj][m][n] = __builtin_amdgcn_mfma_f32_16x16x32_bf16(Bt[n][k], At[m][k], acc[ai][bj][m][n], 0, 0, 0); } } __builtin_amdgcn_s_setprio(0); } while (0)
#define PG8_WAIT_V(n) asm volatile("s_waitcnt vmcnt(" #n ")" ::: "memory")
#define PG8_WAIT_L(n) asm volatile("s_waitcnt lgkmcnt(" #n ")" ::: "memory")
#define PG8_BAR __builtin_amdgcn_s_barrier()
#define PG8_SCHED __builtin_amdgcn_sched_barrier(0)
    Unit cur, nxt; int ui = 0;
    if (!S.next(0, cur)) return;
    f32x4 acc[2][2][4][2];
#pragma unroll
    for (int a = 0; a < 2; ++a)
#pragma unroll
        for (int b = 0; b < 2; ++b)
#pragma unroll
            for (int m = 0; m < 4; ++m)
#pragma unroll
                for (int n = 0; n < 2; ++n) acc[a][b][m][n] = (f32x4){0.f, 0.f, 0.f, 0.f};
    bf16x8 At[4][2], B0[2][2], B1[2][2];
    const char* cA = (const char*)g.A + (size_t)cur.pm * tstep; const char* cB = (const char*)g.Bt + (size_t)cur.pn * tstep;
    S.a_ready(cur);
    if constexpr (SP2) {
        PG8_STAGE(PG8_SB(0, 0), cB, voffB); PG8_STAGE(PG8_SB(0, 1), cB + hstep, voffB); PG8_STAGE(PG8_SA(0, 0), cA, voffA); PG8_STAGE(PG8_SA(0, 1), cA + hstep, voffA);
        if (wr == 1) PG8_BAR;
        PG8_WAIT_V(2); PG8_BAR;
        PG8_STAGE(PG8_SB(1, 0), cB + kstep, voffB); PG8_STAGE(PG8_SA(1, 0), cA + kstep, voffA); PG8_STAGE(PG8_SB(1, 1), cB + hstep + kstep, voffB);
        PG8_WAIT_V(6); PG8_BAR;
    } else {
        PG8_STAGE(PG8_SB(0, 0), cB, voffB); PG8_STAGE(PG8_SA(0, 0), cA, voffA); PG8_STAGE(PG8_SB(0, 1), cB + hstep, voffB); PG8_STAGE(PG8_SA(0, 1), cA + hstep, voffA);
        if (wr == 1) PG8_BAR;
        PG8_WAIT_V(4); PG8_BAR;
        PG8_STAGE(PG8_SB(1, 0), cB + kstep, voffB); PG8_STAGE(PG8_SA(1, 0), cA + kstep, voffA); PG8_STAGE(PG8_SB(1, 1), cB + hstep + kstep, voffB);
        PG8_WAIT_V(6); PG8_BAR;
    }
    for (;;) {
        const bool has_next = S.next(ui + 1, nxt);
        const char* nA = has_next ? (const char*)g.A + (size_t)nxt.pm * tstep : cA; const char* nB = has_next ? (const char*)g.Bt + (size_t)nxt.pn * tstep : cB;
        for (int t = 0; t < nt; t += 2) {
            const bool last = (t == nt - 2);
            const char* a1 = cA + (size_t)(t + 1) * kstep;
            const char* a2 = last ? nA : cA + (size_t)(t + 2) * kstep; const char* b2 = last ? nB : cB + (size_t)(t + 2) * kstep;
            const char* a3 = a2 + kstep; const char* b3 = b2 + kstep;
            if (last && has_next) S.a_ready(nxt);
            if constexpr (SP2) {
            PG8_LDB(B0, 0, 0); PG8_LDB(B1, 0, 1); PG8_SCHED; PG8_LDA(At, 0, 0); PG8_STAGE(PG8_SA(1, 1), a1 + hstep, voffA);
            PG8_WAIT_V(8); PG8_WAIT_L(0); PG8_BAR; PG8_MMA(0, 0, At, B0); PG8_MMA(0, 1, At, B1); PG8_BAR; PG8_SCHED;
            PG8_LDA(At, 0, 1); PG8_STAGE(PG8_SB(0, 0), b2, voffB); PG8_STAGE(PG8_SB(0, 1), b2 + hstep, voffB); PG8_STAGE(PG8_SA(0, 0), a2, voffA);
            PG8_WAIT_V(8); PG8_WAIT_L(0); PG8_BAR; PG8_MMA(1, 0, At, B0); PG8_MMA(1, 1, At, B1); PG8_BAR; PG8_SCHED;
            PG8_LDB(B0, 1, 0); PG8_LDB(B1, 1, 1); PG8_SCHED; PG8_LDA(At, 1, 0); PG8_STAGE(PG8_SA(0, 1), a2 + hstep, voffA);
            PG8_WAIT_V(8); PG8_WAIT_L(0); PG8_BAR; PG8_MMA(0, 0, At, B0); PG8_MMA(0, 1, At, B1); PG8_BAR; PG8_SCHED;
            PG8_LDA(At, 1, 1); PG8_STAGE(PG8_SB(1, 0), b3, voffB); PG8_STAGE(PG8_SB(1, 1), b3 + hstep, voffB); PG8_STAGE(PG8_SA(1, 0), a3, voffA);
            PG8_WAIT_V(8); PG8_WAIT_L(0); PG8_BAR; PG8_MMA(1, 0, At, B0); PG8_MMA(1, 1, At, B1); PG8_BAR; PG8_SCHED;
            } else {
            PG8_LDB(B0, 0, 0); PG8_SCHED; PG8_LDA(At, 0, 0); PG8_STAGE(PG8_SA(1, 1), a1 + hstep, voffA);
            PG8_WAIT_L(8); PG8_BAR; PG8_WAIT_L(0); PG8_MMA(0, 0, At, B0); PG8_BAR; PG8_SCHED;
            PG8_LDB(B1, 0, 1); PG8_STAGE(PG8_SB(0, 0), b2, voffB);
            PG8_BAR; PG8_WAIT_L(0); PG8_MMA(0, 1, At, B1); PG8_BAR;
            PG8_LDA(At, 0, 1); PG8_STAGE(PG8_SA(0, 0), a2, voffA);
            PG8_BAR; PG8_WAIT_L(0); PG8_MMA(1, 0, At, B0); PG8_BAR; PG8_SCHED;
            PG8_STAGE(PG8_SB(0, 1), b2 + hstep, voffB);
            PG8_WAIT_V(6); PG8_BAR; PG8_MMA(1, 1, At, B1); PG8_BAR;
            PG8_LDB(B0, 1, 0); PG8_SCHED; PG8_LDA(At, 1, 0); PG8_STAGE(PG8_SA(0, 1), a2 + hstep, voffA);
            PG8_WAIT_L(8); PG8_BAR; PG8_WAIT_L(0); PG8_MMA(0, 0, At, B0); PG8_BAR; PG8_SCHED;
            PG8_LDB(B1, 1, 1); PG8_STAGE(PG8_SB(1, 0), b3, voffB);
            PG8_BAR; PG8_WAIT_L(0); PG8_MMA(0, 1, At, B1); PG8_BAR;
            PG8_LDA(At, 1, 1); PG8_STAGE(PG8_SA(1, 0), a3, voffA);
            PG8_BAR; PG8_WAIT_L(0); PG8_MMA(1, 0, At, B0); PG8_BAR; PG8_SCHED;
            PG8_STAGE(PG8_SB(1, 1), b3 + hstep, voffB);
            PG8_WAIT_V(6); PG8_BAR; PG8_MMA(1, 1, At, B1); PG8_BAR;
            }
        }
        if constexpr (ALIGN_EPI) { if (wr == 0) PG8_BAR; }
        if constexpr (!Epi::AFTER_DRAIN) {
            if constexpr (F8) { int t2_; asm volatile("v_mbcnt_lo_u32_b32 %0, -1, 0\n\tv_mbcnt_hi_u32_b32 %0, -1, %0" : "=v"(t2_)); E(acc, cur, wr, wc, t2_ & 15, t2_ >> 4); }
            else E(acc, cur, wr, wc, fr, fq);
            S.done(cur); }
        if (!has_next) break;
#pragma unroll
        for (int a = 0; a < 2; ++a)
#pragma unroll
            for (int b = 0; b < 2; ++b)
#pragma unroll
                for (int m = 0; m < 4; ++m)
#pragma unroll
                    for (int n = 0; n < 2; ++n) acc[a][b][m][n] = (f32x4){0.f, 0.f, 0.f, 0.f};
        cur = nxt; cA = nA; cB = nB; ++ui;
        if constexpr (ALIGN_EPI) { if (wr == 1) PG8_BAR; }
    }
    PG8_WAIT_V(0);
    if constexpr (!ALIGN_EPI) { if (wr == 0) PG8_BAR; }
    PG8_BAR;
    if constexpr (Epi::AFTER_DRAIN) { E.fused(acc, cur, wr, wc, fr, fq, lds, wid, lane); S.done(cur); }
#undef PG8_SA
#undef PG8_SB
#undef PG8_STAGE
#undef PG8_LDA
#undef PG8_LDB
#undef PG8_MMA
#undef PG8_WAIT_V
#undef PG8_WAIT_L
#undef PG8_BAR
#undef PG8_SCHED
}
}
constexpr int NWAVES = 8;
constexpr int BATCH = 2, SEQ = 8192, D = 4096, FF = 5632, NH = 32, HD = 128, DEPTH = 4;
constexpr int M = BATCH * SEQ;
constexpr int GDN_N = 16448, GDN_NP = 16640;
constexpr size_t MiB = 1u << 20;
constexpr size_t WS_CTL = 0, CTL_ZERO_BYTES = 3 * MiB;
constexpr size_t WS_ROWSS = 1 * MiB;
constexpr size_t WS_ROPE = 4 * MiB;
constexpr size_t WS_WB0 = 16 * MiB, WS_WB1 = 160 * MiB;
constexpr size_t WS_XB = 304 * MiB;
constexpr size_t WS_SCR = 432 * MiB;
constexpr size_t WS_HID = WS_SCR;
constexpr size_t WS_SC_U = WS_SCR, WS_SC_GB = WS_SCR + 128 * MiB, WS_SC_A2 = WS_SCR + 256 * MiB;
constexpr size_t WS_MB_PROJ = WS_SCR;
constexpr size_t WS_MB_Q = WS_SCR + 384 * MiB, WS_MB_K = WS_SCR + 512 * MiB;
constexpr size_t WS_MB_O = WS_SCR + 640 * MiB;
constexpr size_t WS_MB_KMEAN = WS_SCR + 768 * MiB;
constexpr size_t WS_MB_SEL = WS_SCR + 770 * MiB;
constexpr size_t WS_MB_LIST = WS_SCR + 772 * MiB;
constexpr size_t WS_MB_CNT = WS_SCR + 836 * MiB;
constexpr size_t WS_MB_LSE = WS_SCR + 838 * MiB;
constexpr size_t WS_MB_OPART = WS_SCR + 848 * MiB;
constexpr size_t WS_GD_PROJ = WS_SCR;
constexpr size_t WS_GD_AB = WS_SCR + 512 * MiB;
constexpr size_t WS_GD_TAB = WS_SCR + 516 * MiB;
constexpr size_t WS_GD_QN = WS_SCR + 524 * MiB, WS_GD_KN = WS_GD_QN + 128 * MiB, WS_GD_KWT = WS_GD_KN + 128 * MiB, WS_GD_VUT = WS_GD_KWT + 128 * MiB,
                 WS_GD_KDT = WS_GD_VUT + 128 * MiB, WS_GD_QD = WS_GD_KDT + 128 * MiB, WS_GD_WF = WS_GD_QD + 128 * MiB, WS_GD_QKM = WS_GD_WF + 128 * MiB,
                 WS_GD_U = WS_GD_QKM + 64 * MiB, WS_GD_O = WS_GD_U + 256 * MiB, WS_GD_OG = WS_GD_O + 256 * MiB, WS_X8 = WS_GD_OG + 128 * MiB  , WS_END = WS_X8 + 64 * MiB;
static_assert(WS_END <= (size_t)3400 * MiB, "d_ws map must stay below the guaranteed workspace size");
constexpr int CW_TMO = 0, CW_CODE = 1, CW_QHEAD = 1024, CW_PROG = 2048  , CW_BAR = 4096;
constexpr int RING_OFF = 0, RING_BYTES = 155648;
constexpr int LDSCTL_OFF = RING_BYTES, MISC_OFF = LDSCTL_OFF + 320;
constexpr int LDS_BYTES = 163840;
static_assert(MISC_OFF + 4 * 96 <= LDS_BYTES && MISC_OFF == MK_MISC_ABS, "LDS map");

#define GAS __attribute__((address_space(1)))
#define LAS __attribute__((address_space(3)))
typedef unsigned short bf16;
typedef unsigned v4u __attribute__((ext_vector_type(4)));
typedef unsigned v2u __attribute__((ext_vector_type(2)));
typedef float f32x4 __attribute__((ext_vector_type(4)));
typedef float f32x16 __attribute__((ext_vector_type(16)));
typedef float f32x2v __attribute__((ext_vector_type(2)));
typedef short bf16x8 __attribute__((ext_vector_type(8)));
typedef GAS unsigned gu32;
typedef GAS unsigned long long gu64;
#define RLX_AGENT __ATOMIC_RELAXED, __HIP_MEMORY_SCOPE_AGENT
#define LDS_WAIT() asm volatile("s_waitcnt lgkmcnt(0)" ::: "memory")
#define VM_WAIT() asm volatile("s_waitcnt vmcnt(0)" ::: "memory")
using pg8::pkbf;
__device__ __forceinline__ float bf2f(unsigned short b) { return __builtin_bit_cast(float, (unsigned)b << 16); }
__device__ __forceinline__ float bflo(unsigned w) { return __builtin_bit_cast(float, w << 16); }
__device__ __forceinline__ float bfhi(unsigned w) { return __builtin_bit_cast(float, w & 0xffff0000u); }
#define DPP_ADD(x, ctrl) ((x) + __builtin_bit_cast(float, __builtin_amdgcn_update_dpp(0, __builtin_bit_cast(int, (x)), (ctrl), 0xf, 0xf, true)))
__device__ __forceinline__ float wave_sum_dpp(float v) {
    v = DPP_ADD(v, 0xB1);
    v = DPP_ADD(v, 0x4E);
    v = DPP_ADD(v, 0x141);
    v = DPP_ADD(v, 0x140);
    const int b = __builtin_bit_cast(int, v);
    return (__builtin_bit_cast(float, __builtin_amdgcn_readlane(b, 0)) + __builtin_bit_cast(float, __builtin_amdgcn_readlane(b, 16))) +
           (__builtin_bit_cast(float, __builtin_amdgcn_readlane(b, 32)) + __builtin_bit_cast(float, __builtin_amdgcn_readlane(b, 48)));
}
__device__ __forceinline__ float row16_sum_dpp(float v) {
    v = DPP_ADD(v, 0xB1); v = DPP_ADD(v, 0x4E); v = DPP_ADD(v, 0x141); v = DPP_ADD(v, 0x140); return v;
}
__device__ __forceinline__ float wave_sum(float v) {
#pragma unroll
    for (int o = 1; o < 64; o <<= 1) v += __shfl_xor(v, o);
    return v;
}
#define XB_TMO      128
#define XB_XCNT(j)  (256  + 64 * (j))
#define XB_XSUB(j)  (1280 + 64 * (j))
#define XB_XGEN(j)  (2304 + 64 * (j))
#define XB_TOP      3328
#define XB_TOPGEN   3392
#define XCD_BAR_WORDS 3456
#define XB_SPIN_CAP (1u << 27)

__device__ __forceinline__ unsigned xb_ld(unsigned* p)              { return __hip_atomic_load(p, __ATOMIC_RELAXED, __HIP_MEMORY_SCOPE_AGENT); }
__device__ __forceinline__ unsigned xb_add(unsigned* p, unsigned v) { return __hip_atomic_fetch_add(p, v, __ATOMIC_RELAXED, __HIP_MEMORY_SCOPE_AGENT); }
__device__ __forceinline__ unsigned xb_xcc_id() { return (unsigned)__builtin_amdgcn_s_getreg((3 << 11) | 20) & 0xFu; }
#define XB_SPIN(cond, bar) do { unsigned _sp = 0; while (cond) { __builtin_amdgcn_s_sleep(1); \
    if ((++_sp & 255u) == 0u) { if (xb_ld(&(bar)[XB_TMO])) break; if (_sp > XB_SPIN_CAP) { atomicAdd(&(bar)[XB_TMO], 1u); break; } } } } while (0)

struct XcdBarrier {
    unsigned* bar; unsigned x;
    volatile LAS unsigned* st;
};

__device__ __forceinline__ XcdBarrier xcd_barrier_post(unsigned* bar, volatile LAS unsigned* st) {
    XcdBarrier b; b.bar = bar; b.x = xb_xcc_id(); b.st = st;
    if (mk_tid() == 0) (void)xb_add(&bar[XB_XCNT(b.x)], 1u);
    return b;
}
__device__ __forceinline__ void xcd_barrier_complete(unsigned* bar, unsigned x, unsigned& nloc, unsigned& nx, unsigned G) {
    unsigned sum, cnt, mine, sp = 0u;
    for (;;) {
        sum = 0u; cnt = 0u; mine = 0u;
#pragma unroll
        for (unsigned j = 0; j < 16; ++j) { const unsigned c = xb_ld(&bar[XB_XCNT(j)]); sum += c; cnt += (c > 0u) ? 1u : 0u; mine = (j == x) ? c : mine; }
        if (sum == G) break;
        __builtin_amdgcn_s_sleep(1);
        if ((++sp & 255u) == 0u) { if (xb_ld(&bar[XB_TMO])) break; if (sp > XB_SPIN_CAP) { atomicAdd(&bar[XB_TMO], 1u); break; } }
    }
    nloc = mine > 0u ? mine : 1u; nx = cnt > 0u ? cnt : 1u;
}

__device__ __attribute__((noinline)) void xcd_barrier_fn(unsigned* bar_, unsigned x_, volatile LAS unsigned* st_) {
    XcdBarrier b; b.bar = bar_; b.x = x_; b.st = st_;
    asm volatile("s_waitcnt vmcnt(0)" ::: "memory");
    __syncthreads();
    if (mk_tid() == 0) {
        unsigned* bar = b.bar;
        __builtin_amdgcn_s_waitcnt(0);
        unsigned nloc = b.st[0], nx = b.st[1];
        if (nloc == 0u) { xcd_barrier_complete(bar, b.x, nloc, nx, b.st[9]); b.st[0] = nloc; b.st[1] = nx; }
        const unsigned old = xb_add(&bar[XB_XSUB(b.x)], 1u);
        const unsigned gen = old / nloc;
        if (old + 1u == (gen + 1u) * nloc) {
            __builtin_amdgcn_fence(__ATOMIC_RELEASE, "agent");
            asm volatile("s_waitcnt vmcnt(0)" ::: "memory");
            const unsigned og = xb_add(&bar[XB_TOP], 1u);
            const unsigned tg = og / nx;
            if (og + 1u == (tg + 1u) * nx) xb_add(&bar[XB_TOPGEN], 1u);
            else XB_SPIN(xb_ld(&bar[XB_TOPGEN]) == tg, bar);
            __builtin_amdgcn_fence(__ATOMIC_ACQUIRE, "agent");
            xb_add(&bar[XB_XGEN(b.x)], 1u);
            asm volatile("s_waitcnt vmcnt(0)" ::: "memory");
        } else {
            XB_SPIN(xb_ld(&bar[XB_XGEN(b.x)]) == gen, bar);
            __builtin_amdgcn_fence(__ATOMIC_ACQUIRE, "agent");
            asm volatile("s_waitcnt vmcnt(0)" ::: "memory");
        }
    }
    __syncthreads();
}

__device__ __forceinline__ void xcd_barrier(const XcdBarrier& b) { xcd_barrier_fn(b.bar, b.x, b.st); }
struct Frame {
    LAS unsigned char* lds;
    volatile LAS unsigned* MISC;
    gu32* ctl;
    int tid, lane, wave;
    int vcu, G, gw, NGW, bx;
    unsigned char* ws;
};
struct Args { const float* in[22]; float* out; unsigned char* ws; int ph_lo, ph_hi; };
#define AS4 __attribute__((address_space(4)))
typedef const char AS4* kargp;
template <class T> __device__ __forceinline__ T karg(kargp kp, int byteoff) { typedef T AS4 TA; return *(const TA*)(kp + byteoff); }
#define ARG_IN(kp, i) karg<const float*>(kp, 8 * (i))
#define ARG_OUT(kp) karg<float*>(kp, 176)
#define ARG_WS(kp) karg<unsigned char*>(kp, 184)
static_assert(sizeof(Args) == 200, "Args layout");

template <int MODE, int N> __device__ __forceinline__ int cvt_src_col(int nd) {
    if (MODE == 0) return nd < N ? nd : -1;
    const int t = nd >> 8, r = nd & 255;
    if (MODE == 1) return r < 128 ? 128 * t + r : FF + 128 * t + (r - 128);
    if (t < 32) return r < 128 ? D + 128 * t + r : 2 * D + 128 * t + (r - 128);
    return (t - 32) * 256 + r;
}
template <int K, int N, int ND, int MODE, bool Q8 = false, bool KP = false> __device__ __forceinline__ void cvt_weights(const Frame& F, const float* W, const float* gain, bf16* dst) {
    constexpr int nbn = ND / 64, nwitems = (K / 512) * nbn;
    static_assert(K % 512 == 0, "8 k blocks per workgroup item");
    for (int wit = F.vcu; wit < nwitems; wit += F.G) {
        const int kg = wit / nbn, nb = wit - kg * nbn, kb = kg * 8 + F.wave, k0 = kb * 64, nd = nb * 64 + F.lane;
        const int c = cvt_src_col<MODE, N>(nd);
        float v[64];
        const float* p = W + (size_t)(KP ? ((k0 & ~127) + ((k0 & 64) >> 2)) : k0) * N + (c >= 0 ? c : 0);
#pragma unroll
        for (int q = 0; q < 8; ++q) {
            const float* pq = p + (size_t)q * (KP ? 2 : 8) * N; asm volatile("" : "+v"(pq));
#pragma unroll
            for (int i = 0; i < 8; ++i) v[8 * q + i] = __builtin_nontemporal_load(pq + (size_t)(KP ? ((i & 3) * 32 + (i >> 2)) : i) * N); }
        if (MODE == 0 && ND != N) { if (c < 0) {
#pragma unroll
            for (int i = 0; i < 64; ++i) v[i] = 0.f; } }
        if (gain) { const int gvb = __builtin_bit_cast(int, gain[k0 + F.lane]);
#pragma unroll
            for (int i = 0; i < 64; ++i) v[i] *= __builtin_bit_cast(float, __builtin_amdgcn_readlane(gvb, i)); }
        if constexpr (Q8) {
            GAS v4u* o8 = (GAS v4u*)((unsigned char*)dst + (size_t)nd * K + k0);
#pragma unroll
            for (int q = 0; q < 4; ++q) { v4u w; w.x = pg8::pk4f8(v[16 * q], v[16 * q + 1], v[16 * q + 2], v[16 * q + 3], pg8::F8_WS); w.y = pg8::pk4f8(v[16 * q + 4], v[16 * q + 5], v[16 * q + 6], v[16 * q + 7], pg8::F8_WS);
                w.z = pg8::pk4f8(v[16 * q + 8], v[16 * q + 9], v[16 * q + 10], v[16 * q + 11], pg8::F8_WS); w.w = pg8::pk4f8(v[16 * q + 12], v[16 * q + 13], v[16 * q + 14], v[16 * q + 15], pg8::F8_WS); o8[q] = w; }
            continue; }
        GAS v4u* o = (GAS v4u*)(dst + (size_t)nd * K + k0);
#pragma unroll
        for (int q = 0; q < 8; ++q) { v4u w; w.x = pkbf(v[8 * q], v[8 * q + 1]); w.y = pkbf(v[8 * q + 2], v[8 * q + 3]); w.z = pkbf(v[8 * q + 4], v[8 * q + 5]); w.w = pkbf(v[8 * q + 6], v[8 * q + 7]); o[q] = w; }
    }
}
#define CVT_FFN_IN(kp, widx, gidx, L, dst, Q8)  cvt_weights<D, 2 * FF, 2 * FF, 1, Q8>(F, ARG_IN(kp, widx) + (size_t)(L) * D * 2 * FF, ARG_IN(kp, gidx) + (L) * D, dst)
#define CVT_FFN_OUT(kp, widx, L, dst, Q8)   cvt_weights<FF, D, D, 0, Q8>(F, ARG_IN(kp, widx) + (size_t)(L) * FF * D, nullptr, dst)
#define CVT_MIX_IN(kp, kind, L, jj, dst) do { const float* g_ = ARG_IN(kp, 3) + (L) * D; \
        if ((kind) == 0) cvt_weights<D, GDN_N, GDN_NP, 0>(F, ARG_IN(kp, 9) + (size_t)(jj) * D * GDN_N, g_, dst); \
        else if ((kind) == 1) cvt_weights<D, 3 * D, 3 * D, 2>(F, ARG_IN(kp, 15), g_, dst); \
        else cvt_weights<D, 3 * D, 3 * D, 0>(F, ARG_IN(kp, 18), g_, dst); } while (0)
#define CVT_MIX_OUT(kp, widx, jj, dst, KP)  cvt_weights<D, D, D, 0, false, KP>(F, ARG_IN(kp, widx) + (size_t)(jj) * D * D, nullptr, dst)
__device__ __forceinline__ void p0_rows(const Frame& F, const float* x, bf16* xb, unsigned long long* rowss) {
    for (int row = F.gw; row < M; row += F.NGW) {
        const GAS f32x4* xr = (const GAS f32x4*)(x + (size_t)row * D) + F.lane;
        GAS v2u* o8 = (GAS v2u*)(xb + (size_t)row * D) + F.lane;
        f32x4 v[16]; float s = 0.f;
#pragma unroll
        for (int j = 0; j < 16; ++j) { v[j] = __builtin_nontemporal_load(xr + 64 * j); s += (v[j].x * v[j].x + v[j].y * v[j].y) + (v[j].z * v[j].z + v[j].w * v[j].w); }
#pragma unroll
        for (int j = 0; j < 16; ++j) { v2u w; w.x = pkbf(v[j].x, v[j].y); w.y = pkbf(v[j].z, v[j].w); o8[64 * j] = w; }
        s = wave_sum(s);
        if (F.lane == 0) rowss[row] = (unsigned long long)(s * 16777216.0f + 0.5f);
    }
}
__device__ __forceinline__ void sc_conv(const Frame& F, const bf16* U, const bf16* GB, const float* cw, bf16* A2) {
    for (int unit = F.gw; unit < (M / 64) * 8; unit += F.NGW) {
        const int rc = unit >> 3, cs = unit & 7, r0 = rc * 64, c0 = cs * 512 + F.lane * 8;
        float w0[8], w1[8], w2[8];
#pragma unroll
        for (int j = 0; j < 8; ++j) { w0[j] = cw[c0 + j]; w1[j] = cw[D + c0 + j]; w2[j] = cw[2 * D + c0 + j]; }
        v4u p2 = {0u, 0u, 0u, 0u}, p1 = {0u, 0u, 0u, 0u};
        if ((r0 % SEQ) != 0) { p2 = *(const GAS v4u*)(U + (size_t)(r0 - 2) * D + c0); p1 = *(const GAS v4u*)(U + (size_t)(r0 - 1) * D + c0); }
#pragma unroll 4
        for (int r = 0; r < 64; ++r) {
            const size_t off = (size_t)(r0 + r) * D + c0;
            const v4u cu = __builtin_nontemporal_load((const GAS v4u*)(U + off)), g = __builtin_nontemporal_load((const GAS v4u*)(GB + off));
            v4u o;
#pragma unroll
            for (int q = 0; q < 4; ++q) {
                const float lo = bflo(g[q]) * (w0[2 * q] * bflo(p2[q]) + w1[2 * q] * bflo(p1[q]) + w2[2 * q] * bflo(cu[q]));
                const float hi = bfhi(g[q]) * (w0[2 * q + 1] * bfhi(p2[q]) + w1[2 * q + 1] * bfhi(p1[q]) + w2[2 * q + 1] * bfhi(cu[q]));
                o[q] = pkbf(lo, hi); }
            *(GAS v4u*)(A2 + off) = o;
            p2 = p1; p1 = cu;
        }
    }
}
constexpr int MB_BLK = 256, MB_NB = SEQ / MB_BLK, MB_TOPK = 3;
__device__ __forceinline__ void rope_table(const Frame& F, const int* pos, float* tab) {
    for (int i = F.gw * 64 + F.lane; i < M * 64; i += F.NGW * 64) {
        const int row = i >> 6, fi = i & 63;
        const double inv = exp2(-(double)fi * (13.287712379549449 / 64.0));
        const double ang = (double)pos[row] * inv; double s, c; sincos(ang, &s, &c);
        tab[i] = (float)c; tab[(size_t)M * 64 + i] = (float)s;
    }
}
__device__ __forceinline__ void moba_prep(const Frame& F, const bf16* PROJ, const float* qg, const float* kg, const float* rope, bf16* Qh, bf16* Kh, float* kmean) {
    LAS float* red = (LAS float*)(F.lds + RING_OFF);
    const int l5 = F.lane & 31, tp = F.lane >> 5;
    const float gq0 = qg[2 * l5], gq1 = qg[2 * l5 + 1], gq2 = qg[64 + 2 * l5], gq3 = qg[65 + 2 * l5];
    const float gk0 = kg[2 * l5], gk1 = kg[2 * l5 + 1], gk2 = kg[64 + 2 * l5], gk3 = kg[65 + 2 * l5];
    for (int unit = F.vcu; unit < BATCH * NH * MB_NB; unit += F.G) {
        const int blk = unit % MB_NB, h = (unit / MB_NB) % NH, b = unit / (MB_NB * NH);
        float ks0 = 0.f, ks1 = 0.f, ks2 = 0.f, ks3 = 0.f;
#pragma unroll 1
        for (int ib = 0; ib < 16; ib += 8) {
            unsigned lqa[8], lqb[8], lka[8], lkb[8]; float lc0[8], lc1[8], ls0[8], ls1[8];
#pragma unroll
            for (int t = 0; t < 8; ++t) {
                const int s = blk * MB_BLK + F.wave * 32 + (ib + t) * 2 + tp; const size_t row = (size_t)b * SEQ + s;
                const bf16* pq = PROJ + row * (3 * D) + h * HD; const bf16* pk = pq + D;
                lqa[t] = __builtin_nontemporal_load((const GAS unsigned*)(pq + 2 * l5)); lqb[t] = __builtin_nontemporal_load((const GAS unsigned*)(pq + 64 + 2 * l5));
                lka[t] = __builtin_nontemporal_load((const GAS unsigned*)(pk + 2 * l5)); lkb[t] = __builtin_nontemporal_load((const GAS unsigned*)(pk + 64 + 2 * l5));
                lc0[t] = rope[row * 64 + 2 * l5]; lc1[t] = rope[row * 64 + 2 * l5 + 1]; ls0[t] = rope[(size_t)M * 64 + row * 64 + 2 * l5]; ls1[t] = rope[(size_t)M * 64 + row * 64 + 2 * l5 + 1];
            }
#pragma unroll
            for (int t = 0; t < 8; ++t) {
                const int s = blk * MB_BLK + F.wave * 32 + (ib + t) * 2 + tp;
                const unsigned qa = lqa[t], qb = lqb[t], ka = lka[t], kb = lkb[t];
                const float c0 = lc0[t], c1 = lc1[t], s0 = ls0[t], s1 = ls1[t];
                float q0 = bflo(qa), q1 = bfhi(qa), q2 = bflo(qb), q3 = bfhi(qb), k0 = bflo(ka), k1 = bfhi(ka), k2 = bflo(kb), k3 = bfhi(kb);
                float sq = (q0 * q0 + q1 * q1) + (q2 * q2 + q3 * q3), sk = (k0 * k0 + k1 * k1) + (k2 * k2 + k3 * k3);
                sq = row16_sum_dpp(sq); sk = row16_sum_dpp(sk); sq += __shfl_xor(sq, 16); sk += __shfl_xor(sk, 16);
                const float rq = 1.0f / sqrtf(sq * (1.0f / 128.0f) + 1e-6f), rk = 1.0f / sqrtf(sk * (1.0f / 128.0f) + 1e-6f);
                q0 *= rq * gq0; q1 *= rq * gq1; q2 *= rq * gq2; q3 *= rq * gq3; k0 *= rk * gk0; k1 *= rk * gk1; k2 *= rk * gk2; k3 *= rk * gk3;
                const float qo0 = q0 * c0 - q2 * s0, qo1 = q1 * c1 - q3 * s1, qo2 = q2 * c0 + q0 * s0, qo3 = q3 * c1 + q1 * s1;
                const float ko0 = k0 * c0 - k2 * s0, ko1 = k1 * c1 - k3 * s1, ko2 = k2 * c0 + k0 * s0, ko3 = k3 * c1 + k1 * s1;
                const size_t ho = ((size_t)(b * NH + h) * SEQ + s) * HD;
                *(GAS unsigned*)(Qh + ho + 2 * l5) = pkbf(qo0, qo1); *(GAS unsigned*)(Qh + ho + 64 + 2 * l5) = pkbf(qo2, qo3);
                *(GAS unsigned*)(Kh + ho + 2 * l5) = pkbf(ko0, ko1); *(GAS unsigned*)(Kh + ho + 64 + 2 * l5) = pkbf(ko2, ko3);
                ks0 += ko0; ks1 += ko1; ks2 += ko2; ks3 += ko3;
            }
        }
        ks0 += __shfl_xor(ks0, 32); ks1 += __shfl_xor(ks1, 32); ks2 += __shfl_xor(ks2, 32); ks3 += __shfl_xor(ks3, 32);
        if (tp == 0) { red[F.wave * 128 + 2 * l5] = ks0; red[F.wave * 128 + 2 * l5 + 1] = ks1; red[F.wave * 128 + 64 + 2 * l5] = ks2; red[F.wave * 128 + 65 + 2 * l5] = ks3; }
        __syncthreads();
        if (F.tid < 128) { float a = 0.f;
#pragma unroll
            for (int w = 0; w < 8; ++w) a += red[w * 128 + F.tid];
            kmean[((size_t)(b * NH + h) * MB_NB + blk) * HD + F.tid] = a * (1.0f / 256.0f); }
        __syncthreads();
    }
}
__device__ __forceinline__ void moba_select(const Frame& F, const bf16* Qh, const float* kmean, unsigned* sel, float* LSE) {
    LAS float* km = (LAS float*)(F.lds + RING_OFF);
    for (int unit = F.vcu; unit < BATCH * NH * (SEQ / 512); unit += F.G) {
        const int part = unit % (SEQ / 512), bh = unit / (SEQ / 512);
        __syncthreads();
        for (int i = F.tid; i < MB_NB * HD; i += NWAVES * 64) km[i] = kmean[(size_t)bh * MB_NB * HD + i];
        __syncthreads();
        const int s = part * 512 + F.wave * 64 + F.lane, qblk = (part * 512 + F.wave * 64) / MB_BLK;
        const GAS v4u* qp = (const GAS v4u*)(Qh + ((size_t)bh * SEQ + s) * HD);
        v4u qv[16];
#pragma unroll
        for (int i = 0; i < 16; ++i) qv[i] = qp[i];
        float v0 = -INFINITY, v1 = -INFINITY, v2 = -INFINITY; int i0 = -1, i1 = -1, i2 = -1;
        for (int n = 0; n < qblk; ++n) {
            const LAS f32x4* kr = (const LAS f32x4*)(km + n * HD);
            float a0 = 0.f, a1 = 0.f;
#pragma unroll
            for (int i = 0; i < 16; ++i) { const f32x4 ka = kr[2 * i], kb = kr[2 * i + 1];
                a0 += bflo(qv[i].x) * ka.x + bfhi(qv[i].x) * ka.y; a1 += bflo(qv[i].y) * ka.z + bfhi(qv[i].y) * ka.w;
                a0 += bflo(qv[i].z) * kb.x + bfhi(qv[i].z) * kb.y; a1 += bflo(qv[i].w) * kb.z + bfhi(qv[i].w) * kb.w; }
            const float x = a0 + a1;
            if (x > v0) { v2 = v1; i2 = i1; v1 = v0; i1 = i0; v0 = x; i0 = n; }
            else if (x > v1) { v2 = v1; i2 = i1; v1 = x; i1 = n; }
            else if (x > v2) { v2 = x; i2 = n; }
        }
        unsigned mask = 0u;
        if (i0 >= 0) mask |= 1u << i0; if (i1 >= 0) mask |= 1u << i1; if (i2 >= 0) mask |= 1u << i2;
        sel[(size_t)bh * SEQ + s] = mask;
        { const float ninf = -INFINITY; float* lp = LSE + ((size_t)bh * SEQ + s) * 4; lp[0] = ninf; lp[1] = ninf; lp[2] = ninf; }
    }
}
__device__ __forceinline__ void moba_attn_naive(const Frame& F, const bf16* Qh, const bf16* Kh, const bf16* PROJ, const unsigned* sel, bf16* O) {
    const float scale = 0.08838834764831845f;
    for (int qi = F.gw; qi < BATCH * NH * SEQ; qi += F.NGW) {
        const int s = qi % SEQ, bh = qi / SEQ, b = bh / NH, h = bh % NH, qblk = s / MB_BLK;
        const GAS v4u* qp = (const GAS v4u*)(Qh + ((size_t)bh * SEQ + s) * HD);
        v4u qv[16];
#pragma unroll
        for (int i = 0; i < 16; ++i) qv[i] = qp[i];
        const unsigned mask = sel[(size_t)bh * SEQ + s] | (1u << qblk);
        float m = -1e30f, l = 0.f, o0 = 0.f, o1 = 0.f;
        for (int j = 0; j <= qblk; ++j) {
            if (!((mask >> j) & 1u)) continue;
            for (int t = 0; t < 4; ++t) {
                const int key0 = j * MB_BLK + t * 64; if (key0 > s) break;
                const int key = key0 + F.lane;
                const GAS v4u* kp = (const GAS v4u*)(Kh + ((size_t)bh * SEQ + key) * HD);
                float a0 = 0.f, a1 = 0.f;
#pragma unroll
                for (int i = 0; i < 16; ++i) { const v4u kv = kp[i];
                    a0 += bflo(qv[i].x) * bflo(kv.x) + bfhi(qv[i].x) * bfhi(kv.x); a1 += bflo(qv[i].y) * bflo(kv.y) + bfhi(qv[i].y) * bfhi(kv.y);
                    a0 += bflo(qv[i].z) * bflo(kv.z) + bfhi(qv[i].z) * bfhi(kv.z); a1 += bflo(qv[i].w) * bflo(kv.w) + bfhi(qv[i].w) * bfhi(kv.w); }
                float sc = (a0 + a1) * scale; if (key > s) sc = -INFINITY;
                float tm = sc;
#pragma unroll
                for (int o = 1; o < 64; o <<= 1) tm = fmaxf(tm, __shfl_xor(tm, o));
                const float mn = fmaxf(m, tm), alpha = __expf(m - mn), p = __expf(sc - mn);
                const float ps = wave_sum(p);
                l = l * alpha + ps; o0 *= alpha; o1 *= alpha; m = mn;
                const bf16* vp = PROJ + ((size_t)b * SEQ + key0) * (3 * D) + 2 * D + h * HD + 2 * F.lane;
#pragma unroll 8
                for (int kk = 0; kk < 64; ++kk) { const float pk = __shfl(p, kk); const unsigned vv = *(const GAS unsigned*)(vp + (size_t)kk * (3 * D)); o0 += pk * bflo(vv); o1 += pk * bfhi(vv); }
            }
        }
        const float il = 1.0f / l;
        *(GAS unsigned*)(O + ((size_t)b * SEQ + s) * D + h * HD + 2 * F.lane) = pkbf(o0 * il, o1 * il);
    }
}
#include <hip/hip_bf16.h>
namespace mattn {
constexpr int D = 128, LDV = 3 * 4096;
constexpr float THR = 8.f;
constexpr bool WSKIP = false;
constexpr float SCALE = 0.08838834764831845f;
constexpr int NW = 8, QBLK = 32, KVBLK = 64, QB = NW * QBLK;
constexpr int SHM_V = KVBLK * D * 2, SHM_K = KVBLK * D * 2;
constexpr int LDS_TAB = 2 * SHM_V + 2 * SHM_K + NW * 64 * 4;
constexpr int LDS_BYTES = LDS_TAB + NW * 32 * 4 + 64;
using bf16 = __hip_bfloat16;
typedef short bf16x8 __attribute__((ext_vector_type(8)));
typedef short s16x4 __attribute__((ext_vector_type(4)));
typedef float f32x16 __attribute__((ext_vector_type(16)));
typedef float f32x4 __attribute__((ext_vector_type(4)));
typedef unsigned u32x4 __attribute__((ext_vector_type(4)));
template <class A, class Bt> struct same_t { static constexpr bool v = false; };
template <class A> struct same_t<A, A> { static constexpr bool v = true; };

#define KSWZ(row, colB) ((row) * 256 + ((colB) ^ (((row) & 7) << 4)))
#define SBAR() __builtin_amdgcn_sched_barrier(0)
__device__ __forceinline__ int v_st(int k, int c) { const int kk = (k & ~0xC) | ((k & 4) << 1) | ((k & 8) >> 1); return ((kk >> 3) * 4 + (c >> 5)) * 512 + ((kk & 7) * 32 + (c & 31)) * 2; }
__device__ __forceinline__ int v_rd_base(int lane) { return ((lane & 3) << 3) | (((lane >> 2) & 3) << 6) | (((lane >> 4) & 1) << 5) | (((lane >> 5) & 1) << 8); }
constexpr int v_rd_off(int d0, int ks, int half) { return d0 * 512 + ks * 4096 + half * 2048; }
__device__ __forceinline__ int crow(int r, int hi) { return (r & 3) + 8 * (r >> 2) + 4 * hi; }
__device__ __forceinline__ unsigned cvtpk(float lo, float hi) {
    unsigned r; asm volatile("v_cvt_pk_bf16_f32 %0, %1, %2" : "=v"(r) : "v"(lo), "v"(hi)); return r;
}
__device__ __forceinline__ bf16x8 pack8(f32x4 a, f32x4 b) {
    u32x4 w = {cvtpk(a[0], a[1]), cvtpk(a[2], a[3]), cvtpk(b[0], b[1]), cvtpk(b[2], b[3])};
    return *reinterpret_cast<bf16x8*>(&w);
}
template <class T> __device__ __forceinline__ bf16x8 load8(const T* p) {
    if constexpr (same_t<T, float>::v) { return pack8(*(const f32x4*)p, *(const f32x4*)(p + 4)); }
    else { return *reinterpret_cast<const bf16x8*>(p); }
}
__device__ __forceinline__ void mask_tile(f32x16& p0, f32x16& p1, int dq, unsigned W) {
    const float NEG = -__builtin_inff();
#pragma unroll
    for (int r = 0; r < 16; ++r) {
        const int c = (r & 3) + 8 * (r >> 2);
        if ((unsigned)(dq - c) >= W) p0[r] = NEG;
        if ((unsigned)(dq - c - 32) >= W) p1[r] = NEG;
    }
}
__device__ __forceinline__ void partialSM(f32x16& p0, f32x16& p1, float& m_reg, float& mn, float& alpha) {
    float pmax = p0[0]; for (int r = 1; r < 16; ++r) pmax = fmaxf(pmax, p0[r]); for (int r = 0; r < 16; ++r) pmax = fmaxf(pmax, p1[r]);
    { auto rr = __builtin_amdgcn_permlane32_swap(__float_as_uint(pmax), __float_as_uint(pmax), false, false);
      pmax = fmaxf(__uint_as_float(rr[0]), __uint_as_float(rr[1])); }
    constexpr float C2 = 1.4426950408889634f * SCALE;
    if (__builtin_expect(__all((pmax - m_reg) * SCALE <= THR), 1)) { mn = m_reg; alpha = 1.f; }
    else { mn = fmaxf(m_reg, pmax); alpha = __builtin_amdgcn_exp2f((m_reg - mn) * C2); m_reg = mn; }
    const float mnL = -mn * C2;
    for (int r = 0; r < 16; ++r) p0[r] = fmaf(p0[r], C2, mnL); for (int r = 0; r < 16; ++r) p1[r] = fmaf(p1[r], C2, mnL);
    for (int r = 0; r < 16; ++r) p0[r] = __builtin_amdgcn_exp2f(p0[r]);
}
__device__ __forceinline__ void finishSM(f32x16& p0, f32x16& p1, float alpha, float& l_reg, bf16x8& pa0, bf16x8& pa1, bf16x8& pa2, bf16x8& pa3) {
    for (int r = 0; r < 16; ++r) p1[r] = __builtin_amdgcn_exp2f(p1[r]);
    float ps = 0; for (int r = 0; r < 16; ++r) ps += p0[r]; for (int r = 0; r < 16; ++r) ps += p1[r];
    { auto rr = __builtin_amdgcn_permlane32_swap(__float_as_uint(ps), __float_as_uint(ps), false, false);
      ps = __uint_as_float(rr[0]) + __uint_as_float(rr[1]); }
    l_reg = l_reg * alpha + ps;
#define PK4(P, B_, OUT) do { unsigned a0 = cvtpk(P[B_+0], P[B_+1]), a1 = cvtpk(P[B_+2], P[B_+3]);                          \
        unsigned b0 = cvtpk(P[B_+4], P[B_+5]), b1 = cvtpk(P[B_+6], P[B_+7]);                                             \
        auto r0 = __builtin_amdgcn_permlane32_swap(a0, b0, false, false); auto r1 = __builtin_amdgcn_permlane32_swap(a1, b1, false, false); \
        u32x4 w = {r0[0], r1[0], r0[1], r1[1]}; OUT = *reinterpret_cast<bf16x8*>(&w); } while (0)
    PK4(p0, 0, pa0); PK4(p0, 8, pa1); PK4(p1, 0, pa2); PK4(p1, 8, pa3);
#undef PK4
}
template <int KB, bool SK>
__device__ __forceinline__ void qkt(f32x16& p0, f32x16& p1, const char* K_lds, int r32, int hi, const bf16x8* qr, bool act) {
    if (SK && !act) { const float NEG = -__builtin_inff();
#pragma unroll
        for (int r = 0; r < 16; ++r) { p0[r] = NEG; p1[r] = NEG; } return; }
    p0 = f32x16{}; p1 = f32x16{};
    const char* kb[4];
#pragma unroll
    for (int dd = 0; dd < 4; ++dd) kb[dd] = K_lds + KB * SHM_K + KSWZ(r32, (dd * 16 + hi * 8) * 2);
#pragma unroll
    for (int d0 = 0; d0 < 8; ++d0) { const char* a = kb[d0 & 3] + (d0 >> 2) * 128;
        bf16x8 b0 = *reinterpret_cast<const bf16x8*>(a);
        bf16x8 b1 = *reinterpret_cast<const bf16x8*>(a + 32 * 256);
        p0 = __builtin_amdgcn_mfma_f32_32x32x16_bf16(b0, qr[d0], p0, 0, 0, 0);
        p1 = __builtin_amdgcn_mfma_f32_32x32x16_bf16(b1, qr[d0], p1, 0, 0, 0); }
}
template <int VB, bool SK>
__device__ __forceinline__ void pv_tile(f32x16* o, int vb0, bf16x8 pa0, bf16x8 pa1, bf16x8 pa2, bf16x8 pa3, bool act) {
    if (SK && !act) return;
#define TRRD(dst, off) asm volatile("ds_read_b64_tr_b16 %0, %1 offset:%2" : "=&v"(dst) : "v"(vb0), "i"(off) : "memory")
#define PV_D0(d0) do { s16x4 l0, l1, l2, l3, h0, h1, h2, h3; constexpr int b_ = VB * SHM_V + v_rd_off(d0, 0, 0);     \
        TRRD(l0, b_); TRRD(h0, b_ + 2048); TRRD(l1, b_ + 4096); TRRD(h1, b_ + 6144); TRRD(l2, b_ + 8192); TRRD(h2, b_ + 10240); TRRD(l3, b_ + 12288); TRRD(h3, b_ + 14336); \
        asm volatile("s_waitcnt lgkmcnt(0)" ::: "memory"); SBAR();                 \
        o[d0] = __builtin_amdgcn_mfma_f32_32x32x16_bf16(pa0, (bf16x8){l0[0], l0[1], l0[2], l0[3], h0[0], h0[1], h0[2], h0[3]}, o[d0], 0, 0, 0);   \
        o[d0] = __builtin_amdgcn_mfma_f32_32x32x16_bf16(pa1, (bf16x8){l1[0], l1[1], l1[2], l1[3], h1[0], h1[1], h1[2], h1[3]}, o[d0], 0, 0, 0);   \
        o[d0] = __builtin_amdgcn_mfma_f32_32x32x16_bf16(pa2, (bf16x8){l2[0], l2[1], l2[2], l2[3], h2[0], h2[1], h2[2], h2[3]}, o[d0], 0, 0, 0);   \
        o[d0] = __builtin_amdgcn_mfma_f32_32x32x16_bf16(pa3, (bf16x8){l3[0], l3[1], l3[2], l3[3], h3[0], h3[1], h3[2], h3[3]}, o[d0], 0, 0, 0); } while (0)
    PV_D0(0); PV_D0(1); PV_D0(2); PV_D0(3);
#undef PV_D0
#undef TRRD
}

template <class TIn, class TOut> struct BlockRef { const TIn* Q; const TIn* K; const TIn* V; TOut* O; float* LSE; const unsigned* ROWS; int NR, ROW0, P0; };
template <class R> __device__ __forceinline__ unsigned blk_entry(const R& b, int idx) { return b.ROWS ? (idx < b.NR ? b.ROWS[idx] : 0xffffffffu) : ((unsigned)(b.ROW0 + idx) | (3u << 16)); }
template <class TIn> struct Seam {
    bf16x8 qr[8];
    unsigned ecur;
    bf16x8 st_v0, st_v1, st_k0, st_k1; f32x4 sf0, sf1, sf2, sf3;
    f32x4 tq[16];
};
__device__ __forceinline__ int swa_jlo(int P0, int W) { const int lowk = P0 - W + 1; return lowk > 0 ? lowk / KVBLK : 0; }
#define ROW(p, k0, rr) ((p) + (size_t)((k0) + (rr)) * D + sc)
#define ROWV(p, k0, rr) ((p) + (size_t)((k0) + (rr)) * LDV + sc)
#define VMW() asm volatile("s_waitcnt vmcnt(0)" ::: "memory")
#define VMWN(n) asm volatile("s_waitcnt vmcnt(%0)" :: "i"(n) : "memory")
#define SLOAD_H(Kp, Vp, k0) do { S.st_v0 = load8<TIn>(ROWV(Vp, k0, sr)); S.st_v1 = load8<TIn>(ROWV(Vp, k0, 32 + sr));              \
                         S.st_k0 = load8<TIn>(ROW(Kp, k0, sr)); S.st_k1 = load8<TIn>(ROW(Kp, k0, 32 + sr)); } while (0)
#define SWRITE_HK(bf) do { *(bf16x8*)(K_lds + (bf) * SHM_K + kws) = S.st_k0; *(bf16x8*)(K_lds + (bf) * SHM_K + kws + 32 * 256) = S.st_k1; } while (0)
#define SWRITE_HV(bf) do { *(bf16x8*)(V_lds + (bf) * SHM_V + vst0) = S.st_v0; *(bf16x8*)(V_lds + (bf) * SHM_V + vst1) = S.st_v1; } while (0)
#define SWRITE_H(bf) do { SWRITE_HV(bf); SWRITE_HK(bf); } while (0)
#define SLOAD_F(p, k0) do { S.sf0 = *(const f32x4*)ROW(p, k0, sr); S.sf1 = *(const f32x4*)(ROW(p, k0, sr) + 4);                \
                            S.sf2 = *(const f32x4*)ROW(p, k0, 32 + sr); S.sf3 = *(const f32x4*)(ROW(p, k0, 32 + sr) + 4); } while (0)
#define SWRITE_KF(bf) do { *(bf16x8*)(K_lds + (bf) * SHM_K + kws) = pack8(S.sf0, S.sf1); *(bf16x8*)(K_lds + (bf) * SHM_K + kws + 32 * 256) = pack8(S.sf2, S.sf3); } while (0)
#define SWRITE_VF(bf) do { *(bf16x8*)(V_lds + (bf) * SHM_V + vst0) = pack8(S.sf0, S.sf1); *(bf16x8*)(V_lds + (bf) * SHM_V + vst1) = pack8(S.sf2, S.sf3); } while (0)
template <class TIn, class TOut>
__device__ __forceinline__ void causal_swa_prime(const BlockRef<TIn, TOut>& cur, int W, char* lds, Seam<TIn>& S) {
    constexpr bool F32 = same_t<TIn, float>::v;
    const int tid = mk_tid(), wid = __builtin_amdgcn_readfirstlane(tid >> 6), lane = tid & 63, r32 = lane & 31, hi = lane >> 5;
    const int sr = tid >> 4, sc = (tid & 15) * 8, kws = KSWZ(sr, sc * 2); char* K_lds = lds + 2 * SHM_V;
    const int kb0 = swa_jlo(cur.P0, W) * KVBLK;
    S.ecur = blk_entry(cur, wid * QBLK + r32);
    { const unsigned qrow = S.ecur == 0xffffffffu ? 0u : (S.ecur & 0xffffu);
      for (int d0 = 0; d0 < 8; ++d0) S.qr[d0] = load8<TIn>(cur.Q + (size_t)qrow * D + d0 * 16 + hi * 8); }
    if constexpr (F32) { SLOAD_F((const float*)cur.K, kb0); VMW(); SWRITE_KF(0); SBAR(); SLOAD_F((const float*)cur.V, kb0); }
    else { SLOAD_H(cur.K, cur.V, kb0); VMW(); SWRITE_HK(0); }
    __syncthreads();
}
template <class TIn, class TOut>
__device__ __forceinline__ void causal_swa_block(const BlockRef<TIn, TOut>& cur, const BlockRef<TIn, TOut>& nxt, int skv, int W, char* lds, Seam<TIn>& S) {
    constexpr bool F32 = same_t<TIn, float>::v;
    const int tid = mk_tid(), wid = __builtin_amdgcn_readfirstlane(tid >> 6), lane = tid & 63, r32 = lane & 31, hi = lane >> 5;
    const int j_lo = swa_jlo(cur.P0, W);
    int j_hi = (cur.P0 + QB - 1) / KVBLK + 1; if (j_hi > skv / KVBLK) j_hi = skv / KVBLK;
    const int NT = j_hi - j_lo;
    const int kbn = swa_jlo(nxt.P0, W) * KVBLK;
    const int qlo = cur.P0 + wid * QBLK, qm = qlo + r32 - 4 * hi;
    char* V_lds = lds; char* K_lds = lds + 2 * SHM_V;
    float* ws = (float*)(lds + 2 * SHM_V + 2 * SHM_K) + wid * 64; float* li_l = ws, * al_l = ws + 32;
    const unsigned enxt = blk_entry(nxt, wid * QBLK + r32);
    float m_reg = -1e30f, l_reg = 0; f32x16 o[4] = {};
    const int sr = tid >> 4, sc = (tid & 15) * 8, vst0 = v_st(sr, sc), vst1 = v_st(32 + sr, sc), kws = KSWZ(sr, sc * 2);
    const int vb0 = (int)(uintptr_t)V_lds + v_rd_base(lane);
    const TIn* Kh = cur.K; const TIn* Vh = cur.V;
#define RESC(a) do { if (__any((a) < 1.f)) { if (hi == 0) al_l[r32] = (a); asm volatile("s_waitcnt lgkmcnt(0)" ::: "memory");              \
                     for (int d_ = 0; d_ < 4; ++d_) for (int r = 0; r < 16; ++r) o[d_][r] *= al_l[crow(r, hi)]; } } while (0)
#define KBASE(t) ((j_lo + (t)) * KVBLK)
#define ACT(t) (KBASE(t) <= qlo + QBLK - 1 && KBASE(t) + KVBLK - 1 >= qlo - W + 1)
#define MASKT(P0_, P1_, t) do { const int kb_ = KBASE(t); if ((!SK || ACT(t)) && (kb_ + KVBLK - 1 > qlo || kb_ <= qlo + QBLK - 1 - W)) mask_tile(P0_, P1_, qm - kb_, (unsigned)W); } while (0)
    constexpr int NQL = F32 ? 16 : 8;
    constexpr bool SK = WSKIP && !F32;
#define SEAM_K0() do { VMWN(NQL); if constexpr (F32) { SWRITE_KF(0); SBAR(); SLOAD_F((const float*)nxt.V, kbn); } else { SWRITE_HK(0); } SBAR(); } while (0)
    f32x16 pA0, pA1, pB0, pB1; float mnA, mnB, alA, alB; bf16x8 pa0, pa1, pa2, pa3;
    if constexpr (F32) { VMW(); SWRITE_VF(0); SBAR(); } else { SWRITE_HV(0); SBAR(); }
    if (NT > 1) { if constexpr (F32) SLOAD_F((const float*)Kh, KBASE(1)); else SLOAD_H(Kh, Vh, KBASE(1)); }
    SBAR(); qkt<0, SK>(pA0, pA1, K_lds, r32, hi, S.qr, ACT(0));
    if constexpr (F32) { if (NT > 1) { VMW(); SWRITE_KF(1); SBAR(); SLOAD_F((const float*)Vh, KBASE(1)); } }
    MASKT(pA0, pA1, 0); partialSM(pA0, pA1, m_reg, mnA, alA);
    if (NT > 1) { VMW(); if constexpr (F32) { SWRITE_VF(1); SBAR(); if (NT > 2) SLOAD_F((const float*)Kh, KBASE(2)); } else SWRITE_H(1); }
    __syncthreads();
#define HALF_STEP(PX0, PX1, mnX, alX, PY0, PY1, alY, t, KB, VB, SB) do {                                                      \
        SBAR(); qkt<KB, SK>(PX0, PX1, K_lds, r32, hi, S.qr, ACT(t));                                             \
        finishSM(PY0, PY1, alY, l_reg, pa0, pa1, pa2, pa3); SBAR();                                                           \
        if ((t) + 1 < NT) { if constexpr (F32) { VMW(); SWRITE_KF(SB); SBAR(); SLOAD_F((const float*)Vh, KBASE((t) + 1)); }  \
                            else { SLOAD_H(Kh, Vh, KBASE((t) + 1)); } SBAR(); }                                               \
        pv_tile<VB, SK>(o, vb0, pa0, pa1, pa2, pa3, ACT((t) - 1)); MASKT(PX0, PX1, (t)); partialSM(PX0, PX1, m_reg, mnX, alX);                                        \
        __syncthreads();                                                                                                      \
        if ((t) + 1 < NT) { VMW(); if constexpr (F32) { SWRITE_VF(SB); SBAR(); if ((t) + 2 < NT) SLOAD_F((const float*)Kh, KBASE((t) + 2)); } \
                            else { SWRITE_H(SB); } }                                                                          \
        RESC(alX); __syncthreads(); } while (0)
    for (int t = 1; t + 1 < NT; t += 2) {
        HALF_STEP(pB0, pB1, mnB, alB, pA0, pA1, alA, t, 1, 0, 0);
        HALF_STEP(pA0, pA1, mnA, alA, pB0, pB1, alB, t + 1, 0, 1, 1);
    }
    {
    int tidz_ = mk_tid(); asm volatile("" : "+v"(tidz_));
    const int tid = tidz_, lane = tid & 63, r32 = lane & 31, hi = lane >> 5;
    const int sr = tid >> 4, sc = (tid & 15) * 8, vst0 = v_st(sr, sc), vst1 = v_st(32 + sr, sc), kws = KSWZ(sr, sc * 2);
    const int vb0 = (int)(uintptr_t)V_lds + v_rd_base(lane);
    (void)vst0; (void)vst1; (void)kws; (void)vb0; (void)lane;
    const bool even = (NT & 1) == 0;
    if (even) { SBAR(); qkt<1, SK>(pB0, pB1, K_lds, r32, hi, S.qr, ACT(NT - 1)); SBAR(); }
#define QROW(e) (nxt.Q + (size_t)(wid * QBLK + r32) * D + ((e) >> 1) * 16 + hi * 8 + ((e) & 1) * 4)
    if constexpr (F32) { SLOAD_F((const float*)nxt.K, kbn); SBAR();
#pragma unroll
        for (int e = 0; e < 8; ++e) S.tq[e] = *(const f32x4*)QROW(e); }
    else { SLOAD_H(nxt.K, nxt.V, kbn); SBAR();
#pragma unroll
        for (int d0 = 0; d0 < 8; ++d0) S.qr[d0] = load8<TIn>(nxt.Q + (size_t)(enxt == 0xffffffffu ? 0u : (enxt & 0xffffu)) * D + d0 * 16 + hi * 8); }
    SBAR();
    finishSM(pA0, pA1, alA, l_reg, pa0, pa1, pa2, pa3); SBAR();
    if constexpr (F32) {
#pragma unroll
        for (int e = 8; e < 16; ++e) S.tq[e] = *(const f32x4*)QROW(e); SBAR(); }
#undef QROW
    pv_tile<0, SK>(o, vb0, pa0, pa1, pa2, pa3, ACT(even ? NT - 2 : NT - 1));
    if (even) { MASKT(pB0, pB1, NT - 1); partialSM(pB0, pB1, m_reg, mnB, alB); __syncthreads(); RESC(alB);
        finishSM(pB0, pB1, alB, l_reg, pa0, pa1, pa2, pa3); SBAR(); pv_tile<1, SK>(o, vb0, pa0, pa1, pa2, pa3, ACT(NT - 1)); }
    SBAR(); SEAM_K0();
    unsigned* tabE = (unsigned*)(lds + LDS_TAB) + wid * 32;
    if (hi == 0) { li_l[r32] = l_reg; tabE[r32] = S.ecur;
        if (S.ecur != 0xffffffffu) cur.LSE[(size_t)(S.ecur & 0xffffu) * 4 + ((S.ecur >> 16) & 3u)] = m_reg * SCALE + __logf(l_reg); }
    asm volatile("s_waitcnt lgkmcnt(0)" ::: "memory");
    float rli[16];
#pragma unroll
    for (int r = 0; r < 16; ++r) rli[r] = __builtin_amdgcn_rcpf(li_l[crow(r, hi)]);
#pragma unroll
    for (int r = 0; r < 16; ++r) { const unsigned e = tabE[crow(r, hi)]; const bool ok = e != 0xffffffffu;
        TOut* orow_p = cur.O + ((size_t)(e & 0xffffu) * 4 + ((e >> 16) & 3u)) * D;
#pragma unroll
        for (int d0 = 0; d0 < 4; ++d0) { const float v = o[d0][r] * rli[r];
            const float vn = __shfl_xor(v, 1);
            if (ok && (r32 & 1) == 0) *(unsigned*)(orow_p + d0 * 32 + r32) = cvtpk(v, vn); } }
    S.ecur = enxt;
    if constexpr (F32) {
#pragma unroll
        for (int d0 = 0; d0 < 8; ++d0) S.qr[d0] = pack8(S.tq[2 * d0], S.tq[2 * d0 + 1]); }
    }
    __syncthreads();
#undef RESC
#undef KBASE
#undef ACT
#undef MASKT
#undef SEAM_K0
#undef HALF_STEP
}
#undef ROW
#undef ROWV
#undef VMW
#undef VMWN
#undef SLOAD_H
#undef SWRITE_HK
#undef SWRITE_HV
#undef SWRITE_H
#undef SLOAD_F
#undef SWRITE_KF
#undef SWRITE_VF
}

__device__ __forceinline__ void moba_lists(const Frame& F, const unsigned* SEL, unsigned* LIST, unsigned* CNT, unsigned* qhead) {
    if (F.gw == 0 && F.lane == 0) *qhead = 0u;
    for (int p = F.gw; p < BATCH * NH * MB_NB; p += F.NGW) {
        const int j = p % MB_NB, bh = p / MB_NB;
        unsigned cnt = 0u;
        for (int qb = j + 1; qb < MB_NB; ++qb)
#pragma unroll
            for (int g = 0; g < 4; ++g) {
                const int s = qb * MB_BLK + g * 64 + F.lane;
                const unsigned m = SEL[(size_t)bh * SEQ + s];
                const bool sel = ((m >> j) & 1u) != 0u;
                const unsigned long long bal = __ballot(sel);
                const unsigned pos = cnt + (unsigned)__popcll(bal & ((1ull << F.lane) - 1ull));
                if (sel) LIST[((size_t)bh * MB_NB + j) * SEQ + pos] = (unsigned)s | ((unsigned)__popc(m & ((1u << j) - 1u)) << 16);
                cnt += (unsigned)__popcll(bal);
            }
        if (F.lane == 0) CNT[bh * MB_NB + j] = cnt;
    }
}
namespace mattn {
constexpr int W_LDS_V = 0, W_LDS_K = 4 * SHM_V, W_LDS_WS = 4 * SHM_V + 4 * SHM_K, W_LDS_TAB = W_LDS_WS + NW * 64 * 4, W_LDS_Q = W_LDS_TAB + NW * 32 * 4, W_LDS_BYTES = W_LDS_Q + 64;
template <int T> __device__ __forceinline__ void wave_tile(f32x16 (&o)[4], float& m_reg, float& l_reg, const bf16x8 (&qr)[8], const char* K_lds, int vb0, float* al_l, int r32, int hi, bool causal, int dq0) {
    f32x16 p0, p1; float mn, alpha; bf16x8 pa0, pa1, pa2, pa3;
    qkt<T, false>(p0, p1, K_lds, r32, hi, qr, true);
    if (causal) mask_tile(p0, p1, dq0 - T * KVBLK, 1u << 30);
    partialSM(p0, p1, m_reg, mn, alpha);
    if (__any(alpha < 1.f)) { if (hi == 0) al_l[r32] = alpha; asm volatile("s_waitcnt lgkmcnt(0)" ::: "memory");
#pragma unroll
        for (int d_ = 0; d_ < 4; ++d_)
#pragma unroll
            for (int r = 0; r < 16; ++r) o[d_][r] *= al_l[crow(r, hi)]; }
    finishSM(p0, p1, alpha, l_reg, pa0, pa1, pa2, pa3); SBAR();
    pv_tile<T, false>(o, vb0, pa0, pa1, pa2, pa3, true);
}
}
__device__ __forceinline__ void moba_attn_sparse(const Frame& F, char* lds, const bf16* Qh, const bf16* Kh, const bf16* PROJ, const unsigned* LIST, const unsigned* CNT, bf16* OPART, float* LSE, unsigned* qhead) {
    using namespace mattn;
    using T = mattn::bf16;
    constexpr int NPAIR = (MB_NB - 1) * BATCH * NH, NITEM = NPAIR + BATCH * NH;
    volatile unsigned* qw = (volatile unsigned*)(lds + W_LDS_Q);
    char* V_lds = lds + W_LDS_V; char* K_lds = lds + W_LDS_K;
    for (;;) {
        __syncthreads();
        if (F.tid == 0) *qw = atomicAdd(qhead, 1u);
        __syncthreads();
        const int id = __builtin_amdgcn_readfirstlane((int)*qw);
        if (id >= NITEM) break;
        int bh, blk, cnt;
        if (id < NPAIR) { blk = id / (BATCH * NH); bh = id % (BATCH * NH); cnt = __builtin_amdgcn_readfirstlane((int)CNT[bh * MB_NB + blk]); }
        else { bh = id - NPAIR; blk = MB_NB - 1; cnt = 0; }
        const int b = bh / NH, h = bh % NH;
        int tidz = F.tid; asm volatile("" : "+v"(tidz));
        const int tid = tidz, wid = __builtin_amdgcn_readfirstlane(tid >> 6), lane = tid & 63, r32 = lane & 31, hi = lane >> 5;
        {
            const T* Kp = (const T*)Kh + ((size_t)bh * SEQ + (size_t)blk * MB_BLK) * HD;
            const T* Vp = (const T*)PROJ + ((size_t)b * SEQ + (size_t)blk * MB_BLK) * (3 * ::D) + 2 * ::D + h * HD;
            const int sr = tid >> 4, sc = (tid & 15) * 8, vst0 = v_st(sr, sc), vst1 = v_st(32 + sr, sc), kws = KSWZ(sr, sc * 2);
            bf16x8 k0[4], k1[4], v0[4], v1[4];
#pragma unroll
            for (int t = 0; t < 4; ++t) { k0[t] = load8<T>(Kp + (size_t)(64 * t + sr) * HD + sc); k1[t] = load8<T>(Kp + (size_t)(64 * t + 32 + sr) * HD + sc);
                v0[t] = load8<T>(Vp + (size_t)(64 * t + sr) * LDV + sc); v1[t] = load8<T>(Vp + (size_t)(64 * t + 32 + sr) * LDV + sc); }
#pragma unroll
            for (int t = 0; t < 4; ++t) { *(bf16x8*)(K_lds + t * SHM_K + kws) = k0[t]; *(bf16x8*)(K_lds + t * SHM_K + kws + 32 * 256) = k1[t];
                *(bf16x8*)(V_lds + t * SHM_V + vst0) = v0[t]; *(bf16x8*)(V_lds + t * SHM_V + vst1) = v1[t]; }
        }
        __syncthreads();
        const int ng_g = (cnt + 31) >> 5, ngroups = ng_g + MB_BLK / 32;
        const unsigned* rows = LIST + ((size_t)bh * MB_NB + blk) * SEQ;
        const T* Qb = (const T*)Qh + (size_t)bh * SEQ * HD; T* Ob = (T*)OPART + (size_t)bh * SEQ * 4 * HD; float* Lb = LSE + (size_t)bh * SEQ * 4;
        float* al_l = (float*)(lds + W_LDS_WS) + wid * 64 + 32; float* li_l = (float*)(lds + W_LDS_WS) + wid * 64; unsigned* tabE = (unsigned*)(lds + W_LDS_TAB) + wid * 32;
        const int vb0 = (int)(uintptr_t)V_lds + v_rd_base(lane);
        for (int g = wid; g < ngroups; g += NW) {
            const bool own = g >= ng_g;
            const int idx = (own ? g - ng_g : g) * 32 + r32;
            const unsigned e = own ? ((unsigned)(blk * MB_BLK + idx) | (3u << 16)) : (idx < cnt ? rows[idx] : 0xffffffffu);
            const unsigned qrow = e == 0xffffffffu ? 0u : (e & 0xffffu);
            bf16x8 qr[8];
#pragma unroll
            for (int d0 = 0; d0 < 8; ++d0) qr[d0] = load8<T>(Qb + (size_t)qrow * HD + d0 * 16 + hi * 8);
            float m_reg = -1e30f, l_reg = 0.f; f32x16 o[4] = {};
            const int dq0 = idx - 4 * hi;
            wave_tile<0>(o, m_reg, l_reg, qr, K_lds, vb0, al_l, r32, hi, own, dq0);
            wave_tile<1>(o, m_reg, l_reg, qr, K_lds, vb0, al_l, r32, hi, own, dq0);
            wave_tile<2>(o, m_reg, l_reg, qr, K_lds, vb0, al_l, r32, hi, own, dq0);
            wave_tile<3>(o, m_reg, l_reg, qr, K_lds, vb0, al_l, r32, hi, own, dq0);
            if (hi == 0) { li_l[r32] = l_reg; tabE[r32] = e;
                if (e != 0xffffffffu) Lb[(size_t)(e & 0xffffu) * 4 + ((e >> 16) & 3u)] = m_reg * SCALE + __logf(l_reg); }
            asm volatile("s_waitcnt lgkmcnt(0)" ::: "memory");
#pragma unroll
            for (int r = 0; r < 16; ++r) { const unsigned er = tabE[crow(r, hi)]; const bool ok = er != 0xffffffffu; const float rl = __builtin_amdgcn_rcpf(li_l[crow(r, hi)]);
                T* orow_p = Ob + ((size_t)(er & 0xffffu) * 4 + ((er >> 16) & 3u)) * HD;
                if (ok) { uint2 w; w.x = cvtpk(o[0][r] * rl, o[1][r] * rl); w.y = cvtpk(o[2][r] * rl, o[3][r] * rl); *(uint2*)(orow_p + 4 * r32) = w; } }
            asm volatile("s_waitcnt lgkmcnt(0)" ::: "memory");
        }
    }
}
__device__ __forceinline__ void moba_combine(const Frame& F, const bf16* OPART, const float* LSE, bf16* AO) {
    constexpr int RB = 8;
    for (int r0 = F.gw * RB; r0 < BATCH * NH * SEQ; r0 += F.NGW * RB) {
        f32x4 l[RB]; unsigned v[RB][4];
#pragma unroll
        for (int u = 0; u < RB; ++u) { const size_t q = (size_t)(r0 + u); l[u] = *(const GAS f32x4*)(LSE + q * 4);
#pragma unroll
            for (int k = 0; k < 4; ++k) v[u][k] = __builtin_nontemporal_load((const GAS unsigned*)(OPART + (q * 4 + k) * HD + 2 * F.lane)); }
#pragma unroll
        for (int u = 0; u < RB; ++u) {
            const int q = r0 + u, s = q % SEQ, bh = q / SEQ, b = bh / NH, h = bh % NH;
            const float mx = fmaxf(fmaxf(l[u][0], l[u][1]), fmaxf(l[u][2], l[u][3]));
            float o0 = 0.f, o1 = 0.f, den = 0.f;
#pragma unroll
            for (int k = 0; k < 4; ++k) { const float w = __expf(l[u][k] - mx); const bool on = w > 0.f;
                o0 += on ? w * bflo(v[u][k]) : 0.f; o1 += on ? w * bfhi(v[u][k]) : 0.f; den += w; }
            const float id = 1.0f / den;
            *(GAS unsigned*)(AO + ((size_t)b * SEQ + s) * D + h * HD + 2 * F.lane) = pkbf(o0 * id, o1 * id);
        }
    }
}
constexpr int GD_C = 64, GD_NCH = SEQ / GD_C;
__device__ __forceinline__ float silu_acc(float x) { return x * __builtin_amdgcn_rcpf(1.0f + __expf(-x)); }
__device__ __forceinline__ void gdn_prep(const Frame& F, const bf16* PROJ, const float* AB, const float* cw, const float* a_log, const float* dt_bias,
                                         bf16* QN, bf16* KN, bf16* VN, float* TG, float* TGC, float* TB) {
    for (int unit = F.gw; unit < BATCH * NH * GD_NCH; unit += F.NGW) {
        const int n = unit % GD_NCH, h = (unit / GD_NCH) % NH, b = unit / (GD_NCH * NH);
        const size_t r0 = (size_t)b * SEQ + (size_t)n * GD_C;
        {
            const float a = AB[(r0 + F.lane) * 64 + h], bt = AB[(r0 + F.lane) * 64 + 32 + h];
            const float beta = 1.0f / (1.0f + expf(-bt));
            const float xs = a + dt_bias[h];
            const float sp = xs > 20.f ? xs : log1pf(expf(xs));
            const float g = -expf(a_log[h]) * sp;
            float gc = g;
#pragma unroll
            for (int o = 1; o < 64; o <<= 1) { const float t = __shfl_up(gc, o); if (F.lane >= o) gc += t; }
            TG[(size_t)unit * 64 + F.lane] = g; TGC[(size_t)unit * 64 + F.lane] = gc; TB[(size_t)unit * 64 + F.lane] = beta;
        }
        const int cq = h * HD + 2 * F.lane, ck = D + cq, cv = 2 * D + cq;
        float wq[4][2], wk[4][2], wv[4][2];
#pragma unroll
        for (int t = 0; t < 4; ++t) { wq[t][0] = cw[(size_t)t * 3 * D + cq]; wq[t][1] = cw[(size_t)t * 3 * D + cq + 1]; wk[t][0] = cw[(size_t)t * 3 * D + ck]; wk[t][1] = cw[(size_t)t * 3 * D + ck + 1];
            wv[t][0] = cw[(size_t)t * 3 * D + cv]; wv[t][1] = cw[(size_t)t * 3 * D + cv + 1]; }
        unsigned xq[3] = {0u, 0u, 0u}, xk[3] = {0u, 0u, 0u}, xv[3] = {0u, 0u, 0u};
        if (n > 0) {
#pragma unroll
            for (int t = 0; t < 3; ++t) { const bf16* pr = PROJ + (r0 - 3 + t) * 16384; xq[t] = *(const GAS unsigned*)(pr + cq); xk[t] = *(const GAS unsigned*)(pr + ck); xv[t] = *(const GAS unsigned*)(pr + cv); } }
        const size_t ob = (size_t)unit * GD_C * HD + 2 * F.lane;
#pragma unroll 2
        for (int j = 0; j < GD_C; ++j) {
            const bf16* pr = PROJ + (r0 + j) * 16384;
            const unsigned nq = *(const GAS unsigned*)(pr + cq), nk = *(const GAS unsigned*)(pr + ck), nv = *(const GAS unsigned*)(pr + cv);
            const float q0 = silu_acc(wq[0][0] * bflo(xq[0]) + wq[1][0] * bflo(xq[1]) + wq[2][0] * bflo(xq[2]) + wq[3][0] * bflo(nq));
            const float q1 = silu_acc(wq[0][1] * bfhi(xq[0]) + wq[1][1] * bfhi(xq[1]) + wq[2][1] * bfhi(xq[2]) + wq[3][1] * bfhi(nq));
            const float k0 = silu_acc(wk[0][0] * bflo(xk[0]) + wk[1][0] * bflo(xk[1]) + wk[2][0] * bflo(xk[2]) + wk[3][0] * bflo(nk));
            const float k1 = silu_acc(wk[0][1] * bfhi(xk[0]) + wk[1][1] * bfhi(xk[1]) + wk[2][1] * bfhi(xk[2]) + wk[3][1] * bfhi(nk));
            const float v0 = silu_acc(wv[0][0] * bflo(xv[0]) + wv[1][0] * bflo(xv[1]) + wv[2][0] * bflo(xv[2]) + wv[3][0] * bflo(nv));
            const float v1 = silu_acc(wv[0][1] * bfhi(xv[0]) + wv[1][1] * bfhi(xv[1]) + wv[2][1] * bfhi(xv[2]) + wv[3][1] * bfhi(nv));
            xq[0] = xq[1]; xq[1] = xq[2]; xq[2] = nq; xk[0] = xk[1]; xk[1] = xk[2]; xk[2] = nk; xv[0] = xv[1]; xv[1] = xv[2]; xv[2] = nv;
            const float sq = wave_sum(q0 * q0 + q1 * q1), sk = wave_sum(k0 * k0 + k1 * k1);
            const float rq = 0.08838834764831845f / sqrtf(sq + 1e-6f), rk = 1.0f / sqrtf(sk + 1e-6f);
            *(GAS unsigned*)(QN + ob + (size_t)j * HD) = pkbf(q0 * rq, q1 * rq);
            *(GAS unsigned*)(KN + ob + (size_t)j * HD) = pkbf(k0 * rk, k1 * rk);
            *(GAS unsigned*)(VN + ob + (size_t)j * HD) = pkbf(v0, v1);
        }
    }
}
__device__ __forceinline__ void gdn_scan_naive(const Frame& F, const bf16* QN, const bf16* KN, const bf16* VN, const float* TG, const float* TB, float* O) {
    LAS float* sk = (LAS float*)(F.lds + RING_OFF);
    LAS float* sq = sk + 128;
    LAS float* red = sq + 128;
    LAS float* red2 = red + 512;
    const int c = F.tid & 127, qd = F.tid >> 7;
    for (int bh = F.vcu; bh < BATCH * NH; bh += F.G) {
        const int b = bh / NH, h = bh % NH;
        float S[32];
#pragma unroll
        for (int i = 0; i < 32; ++i) S[i] = 0.f;
        for (int t = 0; t < SEQ; ++t) {
            const size_t ci = (size_t)bh * GD_NCH + (t >> 6); const int j = t & 63;
            const size_t ro = (ci * GD_C + j) * HD;
            __syncthreads();
            if (F.tid < 128) sk[F.tid] = bf2f(KN[ro + F.tid]); else if (F.tid < 256) sq[F.tid - 128] = bf2f(QN[ro + F.tid - 128]);
            const float g = TG[ci * 64 + j], beta = TB[ci * 64 + j], v = bf2f(VN[ro + c]);
            const float eg = expf(g);
            __syncthreads();
            float part = 0.f;
#pragma unroll
            for (int i = 0; i < 32; ++i) { S[i] *= eg; part += sk[qd * 32 + i] * S[i]; }
            red[qd * 128 + c] = part;
            __syncthreads();
            const float ks = (red[c] + red[128 + c]) + (red[256 + c] + red[384 + c]);
            const float vn = beta * (v - ks);
            float po = 0.f;
#pragma unroll
            for (int i = 0; i < 32; ++i) { S[i] += sk[qd * 32 + i] * vn; po += sq[qd * 32 + i] * S[i]; }
            red2[qd * 128 + c] = po;
            __syncthreads();
            if (qd == 0) O[((size_t)b * SEQ + t) * D + h * HD + c] = (red2[c] + red2[128 + c]) + (red2[256 + c] + red2[384 + c]);
        }
    }
}
__device__ __forceinline__ void gdn_outnorm(const Frame& F, const bf16* O, const bf16* PROJ, const float* onorm, bf16* OG) {
    const float g0 = onorm[2 * F.lane], g1 = onorm[2 * F.lane + 1];
    for (int row = F.gw; row < M; row += F.NGW) {
#pragma unroll 4
        for (int h = 0; h < NH; ++h) {
            const unsigned ow = *(const GAS unsigned*)(O + (size_t)row * D + h * HD + 2 * F.lane); f32x2v o; o.x = bflo(ow); o.y = bfhi(ow);
            const unsigned z = *(const GAS unsigned*)(PROJ + (size_t)row * 16384 + 3 * D + h * HD + 2 * F.lane);
            const float ss = wave_sum(o.x * o.x + o.y * o.y);
            const float rs = __builtin_amdgcn_rsqf(ss * (1.0f / 128.0f) + 1e-6f);
            *(GAS unsigned*)(OG + (size_t)row * D + h * HD + 2 * F.lane) = pkbf(o.x * rs * g0 * silu_acc(bflo(z)), o.y * rs * g1 * silu_acc(bfhi(z)));
        }
    }
}
#define MFMA32(a, b, c) __builtin_amdgcn_mfma_f32_32x32x16_bf16((a), (b), (c), 0, 0, 0)
constexpr int GD_WSLOT = 17408;
__device__ __forceinline__ bf16x8 pack_regs(const f32x16& x, int s) {
    v4u w; w.x = pkbf(x[8 * s + 0], x[8 * s + 1]); w.y = pkbf(x[8 * s + 2], x[8 * s + 3]); w.z = pkbf(x[8 * s + 4], x[8 * s + 5]); w.w = pkbf(x[8 * s + 6], x[8 * s + 7]);
    return __builtin_bit_cast(bf16x8, w);
}
__device__ __forceinline__ int sorder_pos(int i, int d) { const int ti = i >> 5, r = i & 31, td = d >> 5, dd = d & 31, s = dd >> 4, e = dd & 15, hh = (e >> 2) & 1, jj = ((e >> 3) << 2) | (e & 3);
    return ((((ti * 4 + td) * 2 + s) * 64 + hh * 32 + r) << 3) + jj; }

__device__ __forceinline__ void gdn_prep2(const Frame& F, const bf16* PROJ, const float* AB, const float* cw, const float* a_log, const float* dt_bias,
                                          bf16* QN, bf16* KN, bf16* QDF, bf16* KDF, bf16* KWT, bf16* VUT, float* TGC, float* TB) {
    LAS unsigned char* slot = F.lds + RING_OFF + F.wave * GD_WSLOT;
    LAS unsigned* tile32 = (LAS unsigned*)slot;
    LAS unsigned short* tile16 = (LAS unsigned short*)slot;
    LAS float* ftab = (LAS float*)(slot + 16640);
    for (int unit = F.gw; unit < BATCH * NH * GD_NCH; unit += F.NGW) {
        int lane_ = F.lane; asm volatile("" : "+v"(lane_));
        const int lane = lane_;
        const int n = unit % GD_NCH, h = (unit / GD_NCH) % NH, b = unit / (GD_NCH * NH);
        const size_t r0 = (size_t)b * SEQ + (size_t)n * GD_C;
        float fq;
        {
            const float a = AB[(r0 + lane) * 64 + h], bt = AB[(r0 + lane) * 64 + 32 + h];
            const float beta = 1.0f / (1.0f + expf(-bt));
            const float xs = a + dt_bias[h];
            const float sp = xs > 20.f ? xs : log1pf(expf(xs));
            const float g = -expf(a_log[h]) * sp;
            float gc = g;
#pragma unroll
            for (int o = 1; o < 64; o <<= 1) { const float t = __shfl_up(gc, o); if (lane >= o) gc += t; }
            const float gl = __shfl(gc, 63);
            TGC[(size_t)unit * 64 + lane] = gc; TB[(size_t)unit * 64 + lane] = beta;
            ftab[lane] = beta * expf(gc); ftab[64 + lane] = expf(gl - gc); ftab[128 + lane] = beta; fq = expf(gc);
        }
        asm volatile("" ::: "memory");
        const int cq = h * HD + 2 * lane, ck = D + cq, cv = 2 * D + cq;
        const size_t ob = (size_t)unit * GD_C * HD;
        {
            float wq[4][2], wk[4][2];
#pragma unroll
            for (int t = 0; t < 4; ++t) { wq[t][0] = cw[(size_t)t * 3 * D + cq]; wq[t][1] = cw[(size_t)t * 3 * D + cq + 1]; wk[t][0] = cw[(size_t)t * 3 * D + ck]; wk[t][1] = cw[(size_t)t * 3 * D + ck + 1]; }
            unsigned xq[3] = {0u, 0u, 0u}, xk[3] = {0u, 0u, 0u};
            if (n > 0) {
#pragma unroll
                for (int t = 0; t < 3; ++t) { const bf16* pr = PROJ + (r0 - 3 + t) * 16384; xq[t] = *(const GAS unsigned*)(pr + cq); xk[t] = *(const GAS unsigned*)(pr + ck); } }
#pragma unroll 1
            for (int jb = 0; jb < GD_C; jb += 16) {
                unsigned rq[16], rk[16];
#pragma unroll
                for (int t = 0; t < 16; ++t) { const bf16* pr = PROJ + (r0 + jb + t) * 16384; rq[t] = __builtin_nontemporal_load((const GAS unsigned*)(pr + cq)); rk[t] = __builtin_nontemporal_load((const GAS unsigned*)(pr + ck)); }
#pragma unroll
                for (int t = 0; t < 16; ++t) {
                    const int j = jb + t; const unsigned nq = rq[t], nk = rk[t];
                    const float q0 = silu_acc(wq[0][0] * bflo(xq[0]) + wq[1][0] * bflo(xq[1]) + wq[2][0] * bflo(xq[2]) + wq[3][0] * bflo(nq));
                    const float q1 = silu_acc(wq[0][1] * bfhi(xq[0]) + wq[1][1] * bfhi(xq[1]) + wq[2][1] * bfhi(xq[2]) + wq[3][1] * bfhi(nq));
                    const float k0 = silu_acc(wk[0][0] * bflo(xk[0]) + wk[1][0] * bflo(xk[1]) + wk[2][0] * bflo(xk[2]) + wk[3][0] * bflo(nk));
                    const float k1 = silu_acc(wk[0][1] * bfhi(xk[0]) + wk[1][1] * bfhi(xk[1]) + wk[2][1] * bfhi(xk[2]) + wk[3][1] * bfhi(nk));
                    xq[0] = xq[1]; xq[1] = xq[2]; xq[2] = nq; xk[0] = xk[1]; xk[1] = xk[2]; xk[2] = nk;
                    const float sq = wave_sum_dpp(q0 * q0 + q1 * q1), sk = wave_sum_dpp(k0 * k0 + k1 * k1);
                    const float rq_ = 0.08838834764831845f * __builtin_amdgcn_rsqf(sq + 1e-6f), rk_ = __builtin_amdgcn_rsqf(sk + 1e-6f);
                    const float eq = __shfl(fq, j);
                    const unsigned kp = pkbf(k0 * rk_, k1 * rk_);
                    *(GAS unsigned*)(QN + ob + (size_t)j * HD + 2 * lane) = pkbf(q0 * rq_, q1 * rq_);
                    *(GAS unsigned*)(KN + ob + (size_t)j * HD + 2 * lane) = kp;
                    *(GAS unsigned*)(QDF + ob + sorder_pos(j, 2 * lane)) = pkbf(q0 * rq_ * eq, q1 * rq_ * eq);
                    tile32[j * 65 + lane] = kp;
                }
            }
            asm volatile("" ::: "memory");
#pragma unroll 1
            for (int dt = 0; dt < 4; ++dt) {
                const int ds = dt >> 1, tj = dt & 1;
                const int d = lane + 64 * ds, td = d >> 5, r = d & 31;
                {
                    float kv[32];
#pragma unroll
                    for (int j = 0; j < 32; ++j) kv[j] = bf2f(tile16[(32 * tj + j) * 130 + d]);
                    GAS v4u* ow = (GAS v4u*)(KWT + ob + (size_t)d * 64 + 32 * tj);
#pragma unroll
                    for (int q = 0; q < 4; ++q) { const LAS float* fw = ftab + 32 * tj + 8 * q; v4u w;
                        w.x = pkbf(kv[8 * q] * fw[0], kv[8 * q + 1] * fw[1]); w.y = pkbf(kv[8 * q + 2] * fw[2], kv[8 * q + 3] * fw[3]);
                        w.z = pkbf(kv[8 * q + 4] * fw[4], kv[8 * q + 5] * fw[5]); w.w = pkbf(kv[8 * q + 6] * fw[6], kv[8 * q + 7] * fw[7]); ow[q] = w; }
#pragma unroll
                    for (int s = 0; s < 2; ++s)
#pragma unroll
                        for (int h2 = 0; h2 < 2; ++h2) { const int j0 = 16 * s + 4 * h2; const LAS float* fd = ftab + 64 + 32 * tj + j0; v4u w;
                            w.x = pkbf(kv[j0] * fd[0], kv[j0 + 1] * fd[1]); w.y = pkbf(kv[j0 + 2] * fd[2], kv[j0 + 3] * fd[3]);
                            w.z = pkbf(kv[j0 + 8] * fd[8], kv[j0 + 9] * fd[9]); w.w = pkbf(kv[j0 + 10] * fd[10], kv[j0 + 11] * fd[11]);
                            *(GAS v4u*)(KDF + ob + (size_t)((((td * 2 + tj) * 2 + s) * 64 + h2 * 32 + r) << 3)) = w; }
                }
            }
        }
        asm volatile("" ::: "memory");
        {
            float wv[4][2];
#pragma unroll
            for (int t = 0; t < 4; ++t) { wv[t][0] = cw[(size_t)t * 3 * D + cv]; wv[t][1] = cw[(size_t)t * 3 * D + cv + 1]; }
            unsigned xv[3] = {0u, 0u, 0u};
            if (n > 0) {
#pragma unroll
                for (int t = 0; t < 3; ++t) xv[t] = *(const GAS unsigned*)(PROJ + (r0 - 3 + t) * 16384 + cv); }
#pragma unroll 1
            for (int jb = 0; jb < GD_C; jb += 32) {
                unsigned rv[32];
#pragma unroll
                for (int t = 0; t < 32; ++t) rv[t] = __builtin_nontemporal_load((const GAS unsigned*)(PROJ + (r0 + jb + t) * 16384 + cv));
#pragma unroll
                for (int t = 0; t < 32; ++t) {
                    const int j = jb + t; const unsigned nv = rv[t];
                    const float v0 = silu_acc(wv[0][0] * bflo(xv[0]) + wv[1][0] * bflo(xv[1]) + wv[2][0] * bflo(xv[2]) + wv[3][0] * bflo(nv));
                    const float v1 = silu_acc(wv[0][1] * bfhi(xv[0]) + wv[1][1] * bfhi(xv[1]) + wv[2][1] * bfhi(xv[2]) + wv[3][1] * bfhi(nv));
                    xv[0] = xv[1]; xv[1] = xv[2]; xv[2] = nv;
                    tile32[j * 65 + lane] = pkbf(v0, v1);
                }
            }
            asm volatile("" ::: "memory");
#pragma unroll 1
            for (int ds = 0; ds < 2; ++ds) {
                const int d = lane + 64 * ds;
                GAS v4u* ow = (GAS v4u*)(VUT + ob + (size_t)d * 64);
#pragma unroll 2
                for (int q = 0; q < 8; ++q) { float x[8];
#pragma unroll
                    for (int e = 0; e < 8; ++e) { const int j = 8 * q + e; x[e] = bf2f(tile16[j * 130 + d]) * ftab[128 + j]; }
                    v4u w; w.x = pkbf(x[0], x[1]); w.y = pkbf(x[2], x[3]); w.z = pkbf(x[4], x[5]); w.w = pkbf(x[6], x[7]); ow[q] = w; }
            }
        }
        asm volatile("" ::: "memory");
    }
}
__device__ __forceinline__ void gdn_chunk(const Frame& F, const bf16* QN, const bf16* KN, const bf16* KWT, const bf16* VUT, const float* TGC, const float* TB,
                                          bf16* WF, float* UU, bf16* QKF) {
    LAS unsigned char* slot = F.lds + RING_OFF + F.wave * GD_WSLOT;
    LAS float* Al = (LAS float*)slot;
    LAS unsigned short* Timg = (LAS unsigned short*)slot;
    LAS float* gtab = (LAS float*)(slot + 16384);
    for (int unit = F.gw; unit < BATCH * NH * GD_NCH; unit += F.NGW) {
        int lane_ = F.lane; asm volatile("" : "+v"(lane_));
        const int lane = lane_, r = lane & 31, hh = lane >> 5;
        const size_t ob = (size_t)unit * GD_C * HD;
        gtab[lane] = TGC[(size_t)unit * 64 + lane]; gtab[64 + lane] = TB[(size_t)unit * 64 + lane];
        const float gcl0 = TGC[(size_t)unit * 64 + r], gcl1 = TGC[(size_t)unit * 64 + 32 + r];
        asm volatile("" ::: "memory");
        bf16x8 kf[2][8], qf[2][8];
#pragma unroll
        for (int t = 0; t < 2; ++t)
#pragma unroll
            for (int s = 0; s < 8; ++s) { kf[t][s] = *(const GAS bf16x8*)(KN + ob + (size_t)(32 * t + r) * HD + 16 * s + 8 * hh); qf[t][s] = *(const GAS bf16x8*)(QN + ob + (size_t)(32 * t + r) * HD + 16 * s + 8 * hh); }
#pragma unroll
        for (int q = 0; q < 3; ++q) {
            const int ti = q ? 1 : 0, tj = q == 2 ? 1 : 0;
            f32x16 x = {};
#pragma unroll
            for (int s = 0; s < 8; ++s) x = MFMA32(kf[ti][s], kf[tj][s], x);
            const float gcj = tj ? gcl1 : gcl0;
#pragma unroll
            for (int g = 0; g < 4; ++g) { const f32x4 gi = *(const LAS f32x4*)(gtab + 32 * ti + 8 * g + 4 * hh), bi = *(const LAS f32x4*)(gtab + 64 + 32 * ti + 8 * g + 4 * hh);
#pragma unroll
                for (int e = 0; e < 4; ++e) { const int i = 32 * ti + 8 * g + 4 * hh + e;
                    Al[i * 64 + 32 * tj + r] = bi[e] * x[4 * g + e] * __expf(fminf(gi[e] - gcj, 0.f)); } }
        }
#pragma unroll
        for (int q = 0; q < 3; ++q) {
            const int ti = q ? 1 : 0, tj = q == 2 ? 1 : 0;
            f32x16 y = {};
#pragma unroll
            for (int s = 0; s < 8; ++s) y = MFMA32(kf[tj][s], qf[ti][s], y);
            const float gci = ti ? gcl1 : gcl0;
#pragma unroll
            for (int g = 0; g < 4; ++g) { const f32x4 gj = *(const LAS f32x4*)(gtab + 32 * tj + 8 * g + 4 * hh);
#pragma unroll
                for (int e = 0; e < 4; ++e) { const int jl = 8 * g + 4 * hh + e;
                    const float v = y[4 * g + e] * __expf(fminf(gci - gj[e], 0.f));
                    y[4 * g + e] = (ti != tj || jl <= r) ? v : 0.f; } }
#pragma unroll
            for (int s = 0; s < 2; ++s) *(GAS bf16x8*)(QKF + (size_t)unit * 4096 + (size_t)(((q * 2 + s) * 64 + lane) << 3)) = pack_regs(y, s);
        }
        bf16x8 kwf[4][4], vuf[4][4];
#pragma unroll
        for (int td = 0; td < 4; ++td)
#pragma unroll
            for (int s = 0; s < 4; ++s) { kwf[td][s] = *(const GAS bf16x8*)(KWT + ob + (size_t)(32 * td + r) * 64 + 16 * s + 8 * hh); vuf[td][s] = *(const GAS bf16x8*)(VUT + ob + (size_t)(32 * td + r) * 64 + 16 * s + 8 * hh); }
        asm volatile("" ::: "memory");
        float t[64];
#pragma unroll
        for (int i = 0; i < 64; ++i) {
            float acc = (lane == i) ? 1.f : 0.f;
#pragma unroll
            for (int j4 = 0; j4 < (i + 3) / 4; ++j4) { const f32x4 a = *(const LAS f32x4*)(Al + i * 64 + 4 * j4);
#pragma unroll
                for (int e = 0; e < 4; ++e) if (4 * j4 + e < i) acc -= a[e] * t[4 * j4 + e]; }
            t[i] = acc;
        }
asm volatile("" ::: "memory");
#pragma unroll
        for (int i = 0; i < 64; ++i) Timg[i * 72 + lane] = (unsigned short)(pkbf(t[i], 0.f) & 0xffffu);
        asm volatile("" ::: "memory");
        bf16x8 tf[2][4];
#pragma unroll
        for (int ti = 0; ti < 2; ++ti)
#pragma unroll
            for (int s = 0; s < 4; ++s) tf[ti][s] = *(const LAS bf16x8*)(Timg + (32 * ti + r) * 72 + 16 * s + 8 * hh);
#pragma unroll
        for (int td = 0; td < 4; ++td) {
#pragma unroll
            for (int ti = 0; ti < 2; ++ti) { f32x16 w = {};
#pragma unroll
                for (int s = 0; s < 4; ++s) w = MFMA32(kwf[td][s], tf[ti][s], w);
#pragma unroll
                for (int s = 0; s < 2; ++s) *(GAS bf16x8*)(WF + ob + (size_t)((((ti * 4 + td) * 2 + s) * 64 + lane) << 3)) = pack_regs(w, s); }
        }
#pragma unroll
        for (int tdv = 0; tdv < 4; ++tdv) {
#pragma unroll
            for (int ti = 0; ti < 2; ++ti) { f32x16 u = {};
#pragma unroll
                for (int s = 0; s < 4; ++s) u = MFMA32(tf[ti][s], vuf[tdv][s], u);
                v4u* up = (v4u*)((unsigned*)UU + (size_t)unit * 4096 + (size_t)((tdv * 2 + ti) * 64 + lane) * 8);
#pragma unroll
                for (int g = 0; g < 2; ++g) { v4u w; w.x = pkbf(u[8 * g], u[8 * g + 1]); w.y = pkbf(u[8 * g + 2], u[8 * g + 3]); w.z = pkbf(u[8 * g + 4], u[8 * g + 5]); w.w = pkbf(u[8 * g + 6], u[8 * g + 7]); up[g] = w; } }
        }
        asm volatile("" ::: "memory");
    }
}
constexpr int GS_BUF = 57344, GS_WF = 0, GS_QD = 16384, GS_KD = 32768, GS_QK = 49152, GS_OB = 2 * GS_BUF, GS_OBSZ = 64 * 272;
static_assert(GS_OB + 2 * GS_OBSZ <= RING_BYTES, "scan LDS map");
#define GS_BAR_COMPUTE() asm volatile("s_waitcnt lgkmcnt(0)\n\ts_barrier" ::: "memory")
#define GS_BAR_LOADER() asm volatile("s_waitcnt vmcnt(0) lgkmcnt(0)\n\ts_barrier" ::: "memory")
__device__ __forceinline__ void gdn_scan(const Frame& F, const bf16* WF, const bf16* QDF, const bf16* KDF, const bf16* QKF, const float* UU, const float* TGC, bf16* GO, unsigned* prog) {
    if (F.bx >= BATCH * NH) return;
    const int bh = F.bx, b = bh / NH, h = bh % NH;
    LAS unsigned char* lbase = F.lds + RING_OFF;
    const size_t cb = (size_t)bh * GD_NCH;
#define GS_ISSUE(n_) do { const int lw_ = F.wave - 4; LAS unsigned char* dst_ = lbase + ((n_) & 1) * GS_BUF + lw_ * 1024; const size_t co_ = (cb + (n_)) * 8192;     \
        const unsigned lo_ = (unsigned)(lw_ * 512 + lane * 8); \
        _Pragma("unroll") for (int p_ = 0; p_ < 4; ++p_) { \
            __builtin_amdgcn_global_load_lds((const unsigned*)(WF + co_ + p_ * 2048 + lo_), (LAS unsigned*)(dst_ + GS_WF + p_ * 4096), 16, 0, 0); \
            __builtin_amdgcn_global_load_lds((const unsigned*)(QDF + co_ + p_ * 2048 + lo_), (LAS unsigned*)(dst_ + GS_QD + p_ * 4096), 16, 0, 0); \
            __builtin_amdgcn_global_load_lds((const unsigned*)(KDF + co_ + p_ * 2048 + lo_), (LAS unsigned*)(dst_ + GS_KD + p_ * 4096), 16, 0, 0); } \
        __builtin_amdgcn_global_load_lds((const unsigned*)(QKF + (cb + (n_)) * 4096 + lo_), (LAS unsigned*)(dst_ + GS_QK), 16, 0, 0); \
        if (lw_ < 2) __builtin_amdgcn_global_load_lds((const unsigned*)(QKF + (cb + (n_)) * 4096 + 2048 + lo_), (LAS unsigned*)(dst_ + GS_QK + 4096), 16, 0, 0); } while (0)
#define GS_OSTORE(n_) do { const int lw_ = F.wave - 4; const LAS unsigned char* ob_ = lbase + GS_OB + ((n_) & 1) * GS_OBSZ; \
        _Pragma("unroll") for (int q_ = 0; q_ < 4; ++q_) { const int row_ = 16 * lw_ + 4 * q_ + (lane >> 4), cg_ = lane & 15; \
            const v4u v_ = *(const LAS v4u*)(ob_ + row_ * 272 + cg_ * 16); \
            *(GAS v4u*)(GO + ((size_t)b * SEQ + (size_t)(n_) * GD_C + row_) * D + h * HD + cg_ * 8) = v_; } } while (0)
    if (F.wave >= 4) {
        const int lane = F.lane;
        GS_ISSUE(0);
        GS_BAR_LOADER();
        for (int n = 0; n < GD_NCH; ++n) {
            if (n + 1 < GD_NCH) GS_ISSUE(n + 1);
            if (n > 0) GS_OSTORE(n - 1);
            if (F.wave == 4 && lane == 0) __hip_atomic_store(prog + 16 * bh, (unsigned)(n + 1), __ATOMIC_RELAXED, __HIP_MEMORY_SCOPE_AGENT);
            GS_BAR_LOADER();
        }
        GS_OSTORE(GD_NCH - 1);
    } else {
        f32x16 S[4] = {};
        f32x16 uc[2];
        float egn;
        { const int lane = F.lane;
#pragma unroll
          for (int ti = 0; ti < 2; ++ti) { const v4u* up = (const v4u*)((const unsigned*)UU + cb * 4096 + (size_t)((F.wave * 2 + ti) * 64 + lane) * 8);
#pragma unroll
              for (int g = 0; g < 2; ++g) { const v4u x = up[g]; uc[ti][8 * g] = bflo(x.x); uc[ti][8 * g + 1] = bfhi(x.x); uc[ti][8 * g + 2] = bflo(x.y); uc[ti][8 * g + 3] = bfhi(x.y);
                  uc[ti][8 * g + 4] = bflo(x.z); uc[ti][8 * g + 5] = bfhi(x.z); uc[ti][8 * g + 6] = bflo(x.w); uc[ti][8 * g + 7] = bfhi(x.w); } }
          egn = TGC[cb * 64 + 63]; }
        GS_BAR_COMPUTE();
        for (int n = 0; n < GD_NCH; ++n) {
            int lq_ = F.lane; asm volatile("" : "+v"(lq_));
            const int lane = lq_, r = lane & 31, hh = lane >> 5;
            const LAS unsigned char* B = lbase + (n & 1) * GS_BUF;
            const float eg = __expf(egn);
            bf16x8 Sb[4][2];
#pragma unroll
            for (int td = 0; td < 4; ++td) { Sb[td][0] = pack_regs(S[td], 0); Sb[td][1] = pack_regs(S[td], 1); }
            bf16x8 Vb[2][2];
            f32x16 P[2] = {}, O[2] = {};
#define FRG(off_) (*(const LAS bf16x8*)(B + (off_) + lane * 16))
            bf16x8 fr0, fr1, fr2, fr3, fr4, fr5, fr6, fr7;
            fr0 = FRG(GS_WF + 0);
            fr1 = FRG(GS_WF + 8192);
            fr2 = FRG(GS_WF + 1024);
            fr3 = FRG(GS_WF + 9216);
            fr4 = FRG(GS_WF + 2048);
            fr5 = FRG(GS_WF + 10240);
            fr6 = FRG(GS_WF + 3072); P[0] = MFMA32(fr0, Sb[0][0], P[0]); __builtin_amdgcn_sched_barrier(0);
            fr7 = FRG(GS_WF + 11264); P[1] = MFMA32(fr1, Sb[0][0], P[1]); __builtin_amdgcn_sched_barrier(0);
            fr0 = FRG(GS_WF + 4096); P[0] = MFMA32(fr2, Sb[0][1], P[0]); __builtin_amdgcn_sched_barrier(0);
            fr1 = FRG(GS_WF + 12288); P[1] = MFMA32(fr3, Sb[0][1], P[1]); __builtin_amdgcn_sched_barrier(0);
            fr2 = FRG(GS_WF + 5120); P[0] = MFMA32(fr4, Sb[1][0], P[0]); __builtin_amdgcn_sched_barrier(0);
            fr3 = FRG(GS_WF + 13312); P[1] = MFMA32(fr5, Sb[1][0], P[1]); __builtin_amdgcn_sched_barrier(0);
            fr4 = FRG(GS_WF + 6144); P[0] = MFMA32(fr6, Sb[1][1], P[0]); __builtin_amdgcn_sched_barrier(0);
            fr5 = FRG(GS_WF + 14336); P[1] = MFMA32(fr7, Sb[1][1], P[1]); __builtin_amdgcn_sched_barrier(0);
            fr6 = FRG(GS_WF + 7168); P[0] = MFMA32(fr0, Sb[2][0], P[0]); __builtin_amdgcn_sched_barrier(0);
            fr7 = FRG(GS_WF + 15360); P[1] = MFMA32(fr1, Sb[2][0], P[1]); __builtin_amdgcn_sched_barrier(0);
            fr0 = FRG(GS_KD + 0); P[0] = MFMA32(fr2, Sb[2][1], P[0]); __builtin_amdgcn_sched_barrier(0);
            fr1 = FRG(GS_KD + 4096); P[1] = MFMA32(fr3, Sb[2][1], P[1]); __builtin_amdgcn_sched_barrier(0);
            fr2 = FRG(GS_KD + 8192); P[0] = MFMA32(fr4, Sb[3][0], P[0]); __builtin_amdgcn_sched_barrier(0);
            fr3 = FRG(GS_KD + 12288); P[1] = MFMA32(fr5, Sb[3][0], P[1]); __builtin_amdgcn_sched_barrier(0);
            fr4 = FRG(GS_KD + 1024); P[0] = MFMA32(fr6, Sb[3][1], P[0]); __builtin_amdgcn_sched_barrier(0);
            fr5 = FRG(GS_KD + 5120); P[1] = MFMA32(fr7, Sb[3][1], P[1]); __builtin_amdgcn_sched_barrier(0);
            {
#pragma unroll
                for (int ti = 0; ti < 2; ++ti) { const f32x16 vn = uc[ti] - P[ti]; Vb[ti][0] = pack_regs(vn, 0); Vb[ti][1] = pack_regs(vn, 1); }
            }
            if (n + 1 < GD_NCH) {
#pragma unroll
                for (int ti = 0; ti < 2; ++ti) { const v4u* up = (const v4u*)((const unsigned*)UU + (cb + n + 1) * 4096 + (size_t)((F.wave * 2 + ti) * 64 + lane) * 8);
#pragma unroll
                    for (int g = 0; g < 2; ++g) { const v4u x = up[g]; uc[ti][8 * g] = bflo(x.x); uc[ti][8 * g + 1] = bfhi(x.x); uc[ti][8 * g + 2] = bflo(x.y); uc[ti][8 * g + 3] = bfhi(x.y);
                        uc[ti][8 * g + 4] = bflo(x.z); uc[ti][8 * g + 5] = bfhi(x.z); uc[ti][8 * g + 6] = bflo(x.w); uc[ti][8 * g + 7] = bfhi(x.w); } }
                egn = TGC[(cb + n + 1) * 64 + 63]; }
#pragma unroll
            for (int td = 0; td < 4; ++td) S[td] = S[td] * eg;
            __builtin_amdgcn_sched_barrier(0);
            fr6 = FRG(GS_KD + 9216); S[0] = MFMA32(fr0, Vb[0][0], S[0]); __builtin_amdgcn_sched_barrier(0);
            fr7 = FRG(GS_KD + 13312); S[1] = MFMA32(fr1, Vb[0][0], S[1]); __builtin_amdgcn_sched_barrier(0);
            fr0 = FRG(GS_KD + 2048); S[2] = MFMA32(fr2, Vb[0][0], S[2]); __builtin_amdgcn_sched_barrier(0);
            fr1 = FRG(GS_KD + 6144); S[3] = MFMA32(fr3, Vb[0][0], S[3]); __builtin_amdgcn_sched_barrier(0);
            fr2 = FRG(GS_KD + 10240); S[0] = MFMA32(fr4, Vb[0][1], S[0]); __builtin_amdgcn_sched_barrier(0);
            fr3 = FRG(GS_KD + 14336); S[1] = MFMA32(fr5, Vb[0][1], S[1]); __builtin_amdgcn_sched_barrier(0);
            fr4 = FRG(GS_KD + 3072); S[2] = MFMA32(fr6, Vb[0][1], S[2]); __builtin_amdgcn_sched_barrier(0);
            fr5 = FRG(GS_KD + 7168); S[3] = MFMA32(fr7, Vb[0][1], S[3]); __builtin_amdgcn_sched_barrier(0);
            fr6 = FRG(GS_KD + 11264); S[0] = MFMA32(fr0, Vb[1][0], S[0]); __builtin_amdgcn_sched_barrier(0);
            fr7 = FRG(GS_KD + 15360); S[1] = MFMA32(fr1, Vb[1][0], S[1]); __builtin_amdgcn_sched_barrier(0);
            fr0 = FRG(GS_QD + 0); S[2] = MFMA32(fr2, Vb[1][0], S[2]); __builtin_amdgcn_sched_barrier(0);
            fr1 = FRG(GS_QD + 8192); S[3] = MFMA32(fr3, Vb[1][0], S[3]); __builtin_amdgcn_sched_barrier(0);
            fr2 = FRG(GS_QD + 1024); S[0] = MFMA32(fr4, Vb[1][1], S[0]); __builtin_amdgcn_sched_barrier(0);
            fr3 = FRG(GS_QD + 9216); S[1] = MFMA32(fr5, Vb[1][1], S[1]); __builtin_amdgcn_sched_barrier(0);
            fr4 = FRG(GS_QD + 2048); S[2] = MFMA32(fr6, Vb[1][1], S[2]); __builtin_amdgcn_sched_barrier(0);
            fr5 = FRG(GS_QD + 10240); S[3] = MFMA32(fr7, Vb[1][1], S[3]); __builtin_amdgcn_sched_barrier(0);
            fr6 = FRG(GS_QD + 3072); O[0] = MFMA32(fr0, Sb[0][0], O[0]); __builtin_amdgcn_sched_barrier(0);
            fr7 = FRG(GS_QD + 11264); O[1] = MFMA32(fr1, Sb[0][0], O[1]); __builtin_amdgcn_sched_barrier(0);
            fr0 = FRG(GS_QD + 4096); O[0] = MFMA32(fr2, Sb[0][1], O[0]); __builtin_amdgcn_sched_barrier(0);
            fr1 = FRG(GS_QD + 12288); O[1] = MFMA32(fr3, Sb[0][1], O[1]); __builtin_amdgcn_sched_barrier(0);
            fr2 = FRG(GS_QD + 5120); O[0] = MFMA32(fr4, Sb[1][0], O[0]); __builtin_amdgcn_sched_barrier(0);
            fr3 = FRG(GS_QD + 13312); O[1] = MFMA32(fr5, Sb[1][0], O[1]); __builtin_amdgcn_sched_barrier(0);
            fr4 = FRG(GS_QD + 6144); O[0] = MFMA32(fr6, Sb[1][1], O[0]); __builtin_amdgcn_sched_barrier(0);
            fr5 = FRG(GS_QD + 14336); O[1] = MFMA32(fr7, Sb[1][1], O[1]); __builtin_amdgcn_sched_barrier(0);
            fr6 = FRG(GS_QD + 7168); O[0] = MFMA32(fr0, Sb[2][0], O[0]); __builtin_amdgcn_sched_barrier(0);
            fr7 = FRG(GS_QD + 15360); O[1] = MFMA32(fr1, Sb[2][0], O[1]); __builtin_amdgcn_sched_barrier(0);
            fr0 = FRG(GS_QK + 0); O[0] = MFMA32(fr2, Sb[2][1], O[0]); __builtin_amdgcn_sched_barrier(0);
            fr1 = FRG(GS_QK + 2048); O[1] = MFMA32(fr3, Sb[2][1], O[1]); __builtin_amdgcn_sched_barrier(0);
            fr2 = FRG(GS_QK + 4096); O[0] = MFMA32(fr4, Sb[3][0], O[0]); __builtin_amdgcn_sched_barrier(0);
            fr3 = FRG(GS_QK + 1024); O[1] = MFMA32(fr5, Sb[3][0], O[1]); __builtin_amdgcn_sched_barrier(0);
            fr4 = FRG(GS_QK + 3072); O[0] = MFMA32(fr6, Sb[3][1], O[0]); __builtin_amdgcn_sched_barrier(0);
            fr5 = FRG(GS_QK + 5120); O[1] = MFMA32(fr7, Sb[3][1], O[1]); __builtin_amdgcn_sched_barrier(0);
            O[0] = MFMA32(fr0, Vb[0][0], O[0]); __builtin_amdgcn_sched_barrier(0);
            O[1] = MFMA32(fr1, Vb[0][0], O[1]); __builtin_amdgcn_sched_barrier(0);
            O[1] = MFMA32(fr2, Vb[1][0], O[1]); __builtin_amdgcn_sched_barrier(0);
            O[0] = MFMA32(fr3, Vb[0][1], O[0]); __builtin_amdgcn_sched_barrier(0);
            O[1] = MFMA32(fr4, Vb[0][1], O[1]); __builtin_amdgcn_sched_barrier(0);
            O[1] = MFMA32(fr5, Vb[1][1], O[1]); __builtin_amdgcn_sched_barrier(0);
#undef FRG
            {
                LAS unsigned short* ob = (LAS unsigned short*)(lbase + GS_OB + (n & 1) * GS_OBSZ) + (4 * hh) * 136 + 32 * F.wave + r;
#pragma unroll
                for (int ti = 0; ti < 2; ++ti)
#pragma unroll
                    for (int g = 0; g < 16; ++g) ob[(32 * ti + (g & 3) + 8 * (g >> 2)) * 136] = (unsigned short)(pkbf(O[ti][g], 0.f) & 0xffffu);
            }
            GS_BAR_COMPUTE();
        }
    }
#undef GS_ISSUE
#undef GS_OSTORE
}

__device__ __forceinline__ void gdn_scan_helper(const Frame& F, const bf16* WF, const bf16* QDF, const bf16* KDF, const bf16* QKF, const float* UU, const unsigned* prog) {
    const int k = (F.bx - BATCH * NH) >> 3;
    if (k < 0 || k >= 24) return;
    const int bh = (F.bx & 7) + 8 * (k & 7), role = k >> 3;
    const size_t cb = (size_t)bh * GD_NCH;
    unsigned dummy = 0u; int touched = 0;
    for (int it = 0; it < (1 << 20) && touched < GD_NCH; ++it) {
        const int p = __builtin_amdgcn_readfirstlane((int)__hip_atomic_load(prog + 16 * bh, __ATOMIC_RELAXED, __HIP_MEMORY_SCOPE_AGENT));
        const int target = p + 5 < GD_NCH ? p + 5 : GD_NCH;
        for (; touched < target; ++touched) {
            const size_t c = cb + touched; const char* a; int nlines;
            if (role == 0) { a = (const char*)(WF + c * 8192); nlines = 128; }
            else if (role == 1) { a = (const char*)(QDF + c * 8192); nlines = 128; }
            else { a = (const char*)(KDF + c * 8192); nlines = 128; }
            if (F.tid < nlines) { const char* q_ = a + F.tid * 128; asm volatile("global_load_dword %0, %1, off" : "+v"(dummy) : "v"(q_) : "memory"); }
            const char* a2 = role == 0 ? (const char*)(QKF + c * 4096) : (const char*)((const unsigned*)UU + c * 4096) + (role - 1) * 8192;
            const int n2 = role == 0 ? 48 : 64;
            if (F.tid >= 128 && F.tid < 128 + n2) { const char* q_ = a2 + (F.tid - 128) * 128; asm volatile("global_load_dword %0, %1, off" : "+v"(dummy) : "v"(q_) : "memory"); }
        }
        if (p >= GD_NCH) break;
        __builtin_amdgcn_s_sleep(8);
    }
    asm volatile("s_waitcnt vmcnt(0)" : "+v"(dummy) :: "memory");
}


template <class Epi, bool F8 = false> __device__ __forceinline__ void run_gemm(const Frame& F, const bf16* A, const bf16* Bt, int N, int K, const Epi& E) {
    pg8::Gemm g{A, Bt, M, N, F8 ? K / 2 : K}; pg8::StaticOrder S; S.init(M, N, F.G, F.bx);
    pg8::gemm_phase<Epi, pg8::StaticOrder, true, true, F8>(F.lds + RING_OFF, g, S, E);
}
#ifndef MK_F8_FFNS
#define MK_F8_FFNS 4
#endif
__host__ __device__ constexpr bool ffn_f8(int f) { return f >= 8 - MK_F8_FFNS; }
#ifndef MK_F8_IN
#define MK_F8_IN 3
#endif
static_assert(MK_F8_IN <= 7 && MK_F8_IN <= MK_F8_FFNS, "fp8 in-projections: never the first FFN (its rows come from P0), and only FFNs whose out-projection is fp8 too");
__host__ __device__ constexpr bool ffn_in_f8(int f) { return f < 8 && f >= 8 - MK_F8_IN; }
constexpr float F8_UNSCALE_IN = 1.0f / (pg8::F8_XS * pg8::F8_WS);
#define P_X8 WSP(unsigned char, WS_X8)
constexpr float F8_UNSCALE = 1.0f / (pg8::F8_HS * pg8::F8_WS);
__host__ __device__ constexpr int layer_base(int L) { return L == 0 ? 1 : L == 1 ? 11 : L == 2 ? 18 : 29; }
constexpr int NPH = 39;
#define WSP(T, off) ((T*)(F.ws + (off)))
#define P_XB   WSP(bf16, WS_XB)
#define P_HID  WSP(bf16, WS_HID)
#define P_RSS(v) (WSP(unsigned long long, WS_ROWSS) + (size_t)(v) * M)
#define P_WB(g) WSP(bf16, ((g) & 1) ? WS_WB1 : WS_WB0)

#define MI_(i) ((unsigned)__builtin_amdgcn_readfirstlane((int)((const volatile LAS unsigned*)((LAS unsigned char*)lds + MISC_OFF))[(i)]))
#define KP0() ((kargp)(((unsigned long long)MI_(19) << 32) | (unsigned long long)MI_(18)))
#define IN(k) ({ kargp k_ = KP0(); const int lo_ = karg<int>(k_, 192), hi_ = karg<int>(k_, 196); lo_ <= (k) && (k) < hi_; })
#define SEAM(k) do { kargp k_ = KP0(); if ((k) + 1 < karg<int>(k_, 196)) { XcdBarrier b_; b_.bar = (unsigned*)(ARG_WS(k_) + WS_CTL) + CW_BAR; b_.x = xb_xcc_id(); b_.st = (volatile LAS unsigned*)((LAS unsigned char*)lds + MISC_OFF) + 8; xcd_barrier(b_); } } while (0)
#define HWSLOT() ((int)(__builtin_amdgcn_s_getreg((5 << 11) | 4) & 63u))
#define ENTER() constexpr int L = Lrt; kargp kp_ = KP0(); do { int t_ = mk_tid(); asm volatile("" : "+v"(t_)); const int g_ = (int)MI_(17), bx_ = (int)MI_(16); \
        F.tid = t_; F.lane = t_ & 63; F.wave = __builtin_amdgcn_readfirstlane(t_ >> 6); F.G = g_; F.bx = bx_; F.vcu = (g_ % 8 == 0) ? (bx_ % 8) * (g_ / 8) + bx_ / 8 : bx_; \
        F.gw = F.vcu * NWAVES + F.wave; F.NGW = g_ * NWAVES; F.ws = ARG_WS(kp_); } while (0); \
    constexpr int g0 = 6 * L, jj = L == 3 ? 1 : 0; (void)g0; (void)jj
#define REFRESH() do { kp_ = KP0(); F.ws = ARG_WS(kp_); } while (0)

template <int Lrt> __device__ __forceinline__ void run_layer(Frame& F, unsigned char* lds) {
    constexpr int pb = layer_base(Lrt), kind = Lrt == 1 ? 1 : Lrt == 2 ? 2 : 0;
        constexpr bool f8a = ffn_f8(2 * Lrt), f8b = ffn_f8(2 * Lrt + 1), f8ia = ffn_in_f8(2 * Lrt), f8ib = ffn_in_f8(2 * Lrt + 1), f8in = ffn_in_f8(2 * Lrt + 2);
        if (IN(pb + 0)) { ENTER(); CVT_FFN_OUT(kp_, 6, L, P_WB(g0 + 1), f8a); REFRESH();
            pg8::EpiIn<0, f8a> E{P_RSS(3 * L), P_HID, nullptr, nullptr, FF, f8ia ? F8_UNSCALE_IN : 1.0f}; run_gemm<pg8::EpiIn<0, f8a>, f8ia>(F, f8ia ? (const bf16*)P_X8 : P_XB, P_WB(g0), 2 * FF, D, E); SEAM(pb + 0); }
        if (IN(pb + 1)) { ENTER(); CVT_MIX_IN(kp_, kind, L, jj, P_WB(g0 + 2)); REFRESH();
            pg8::EpiRes<false> E{nullptr, P_XB, P_RSS(3 * L + 1), f8a ? 0.5f * F8_UNSCALE : 0.5f}; run_gemm<pg8::EpiRes<false>, f8a>(F, P_HID, P_WB(g0 + 1), D, FF, E); SEAM(pb + 1); }
        constexpr int pf = kind == 0 ? pb + 8 : kind == 1 ? pb + 5 : pb + 9;
        if constexpr (kind == 0) {
            if (IN(pb + 2)) { ENTER(); CVT_MIX_OUT(kp_, 14, jj, P_WB(g0 + 3), false); REFRESH();
                pg8::EpiIn<3> E{P_RSS(3 * L + 1), WSP(bf16, WS_GD_PROJ), nullptr, WSP(float, WS_GD_AB), 16384}; run_gemm(F, P_XB, P_WB(g0 + 2), GDN_NP, D, E); SEAM(pb + 2); }
            if (IN(pb + 3)) { ENTER(); gdn_prep2(F, WSP(bf16, WS_GD_PROJ), WSP(float, WS_GD_AB), ARG_IN(kp_, 10) + (size_t)jj * 4 * 3 * D, ARG_IN(kp_, 11) + jj * NH, ARG_IN(kp_, 12) + jj * NH,
                                       WSP(bf16, WS_GD_QN), WSP(bf16, WS_GD_KN), WSP(bf16, WS_GD_QD), WSP(bf16, WS_GD_KDT), WSP(bf16, WS_GD_KWT), WSP(bf16, WS_GD_VUT),
                                       WSP(float, WS_GD_TAB), WSP(float, WS_GD_TAB) + (size_t)BATCH * NH * SEQ); SEAM(pb + 3); }
            if (IN(pb + 4)) { ENTER(); gdn_chunk(F, WSP(bf16, WS_GD_QN), WSP(bf16, WS_GD_KN), WSP(bf16, WS_GD_KWT), WSP(bf16, WS_GD_VUT), WSP(float, WS_GD_TAB), WSP(float, WS_GD_TAB) + (size_t)BATCH * NH * SEQ,
                                       WSP(bf16, WS_GD_WF), WSP(float, WS_GD_U), WSP(bf16, WS_GD_QKM)); SEAM(pb + 4); }
            if (IN(pb + 5)) { ENTER(); unsigned* prog = (unsigned*)(F.ws + WS_CTL) + CW_PROG + jj * 1024;
                if (F.bx < BATCH * NH) gdn_scan(F, WSP(bf16, WS_GD_WF), WSP(bf16, WS_GD_QD), WSP(bf16, WS_GD_KDT), WSP(bf16, WS_GD_QKM), WSP(float, WS_GD_U), WSP(float, WS_GD_TAB), WSP(bf16, WS_GD_O), prog);
                else gdn_scan_helper(F, WSP(bf16, WS_GD_WF), WSP(bf16, WS_GD_QD), WSP(bf16, WS_GD_KDT), WSP(bf16, WS_GD_QKM), WSP(float, WS_GD_U), prog);
                SEAM(pb + 5); }
            if (IN(pb + 6)) { ENTER(); gdn_outnorm(F, WSP(bf16, WS_GD_O), WSP(bf16, WS_GD_PROJ), ARG_IN(kp_, 13) + jj * HD, WSP(bf16, WS_GD_OG)); SEAM(pb + 6); }
            if (IN(pb + 7)) { ENTER(); CVT_FFN_IN(kp_, 7, 4, L, P_WB(g0 + 4), f8ib); REFRESH();
                pg8::EpiRes<false, f8ib> E{nullptr, P_XB, P_RSS(3 * L + 2), 1.0f, P_X8}; run_gemm(F, WSP(bf16, WS_GD_OG), P_WB(g0 + 3), D, D, E); SEAM(pb + 7); }
        } else if constexpr (kind == 1) {
            if (IN(pb + 2)) { ENTER(); CVT_MIX_OUT(kp_, 17, 0, P_WB(g0 + 3), false); REFRESH();
                pg8::EpiIn<2> E{P_RSS(3 * L + 1), WSP(bf16, WS_SC_U), WSP(bf16, WS_SC_GB), nullptr, D}; run_gemm(F, P_XB, P_WB(g0 + 2), 3 * D, D, E); SEAM(pb + 2); }
            if (IN(pb + 3)) { ENTER(); sc_conv(F, WSP(bf16, WS_SC_U), WSP(bf16, WS_SC_GB), ARG_IN(kp_, 16) + (size_t)jj * 3 * D, WSP(bf16, WS_SC_A2)); SEAM(pb + 3); }
            if (IN(pb + 4)) { ENTER(); CVT_FFN_IN(kp_, 7, 4, L, P_WB(g0 + 4), f8ib); REFRESH();
                pg8::EpiRes<false, f8ib> E{nullptr, P_XB, P_RSS(3 * L + 2), 1.0f, P_X8}; run_gemm(F, WSP(bf16, WS_SC_A2), P_WB(g0 + 3), D, D, E); SEAM(pb + 4); }
        } else {
            if (IN(pb + 2)) { ENTER(); CVT_MIX_OUT(kp_, 21, 0, P_WB(g0 + 3), true); REFRESH();
                pg8::EpiIn<1> E{P_RSS(3 * L + 1), WSP(bf16, WS_MB_PROJ), nullptr, nullptr, 3 * D}; run_gemm(F, P_XB, P_WB(g0 + 2), 3 * D, D, E); SEAM(pb + 2); }
            if (IN(pb + 3)) { ENTER(); moba_prep(F, WSP(bf16, WS_MB_PROJ), ARG_IN(kp_, 19) + jj * HD, ARG_IN(kp_, 20) + jj * HD, WSP(float, WS_ROPE), WSP(bf16, WS_MB_Q), WSP(bf16, WS_MB_K), WSP(float, WS_MB_KMEAN)); SEAM(pb + 3); }
            if (IN(pb + 4)) { ENTER(); moba_select(F, WSP(bf16, WS_MB_Q), WSP(float, WS_MB_KMEAN), WSP(unsigned, WS_MB_SEL), WSP(float, WS_MB_LSE)); SEAM(pb + 4); }
            if (IN(pb + 5)) { ENTER(); moba_lists(F, WSP(unsigned, WS_MB_SEL), WSP(unsigned, WS_MB_LIST), WSP(unsigned, WS_MB_CNT), (unsigned*)(F.ws + WS_CTL) + CW_QHEAD); SEAM(pb + 5); }
            if (IN(pb + 6)) { ENTER(); moba_attn_sparse(F, (char*)lds, WSP(bf16, WS_MB_Q), WSP(bf16, WS_MB_K), WSP(bf16, WS_MB_PROJ), WSP(unsigned, WS_MB_LIST), WSP(unsigned, WS_MB_CNT),
                                               WSP(bf16, WS_MB_OPART), WSP(float, WS_MB_LSE), (unsigned*)(F.ws + WS_CTL) + CW_QHEAD); SEAM(pb + 6); }
            if (IN(pb + 7)) { ENTER(); moba_combine(F, WSP(bf16, WS_MB_OPART), WSP(float, WS_MB_LSE), WSP(bf16, WS_MB_O)); SEAM(pb + 7); }
            if (IN(pb + 8)) { ENTER(); CVT_FFN_IN(kp_, 7, 4, L, P_WB(g0 + 4), f8ib); REFRESH();
                pg8::EpiRes<false, f8ib> E{nullptr, P_XB, P_RSS(3 * L + 2), 1.0f, P_X8}; run_gemm(F, WSP(bf16, WS_MB_O), P_WB(g0 + 3), D, D, E); SEAM(pb + 8); }
        }
        if (IN(pf)) { ENTER(); CVT_FFN_OUT(kp_, 8, L, P_WB(g0 + 5), f8b); REFRESH();
            pg8::EpiIn<0, f8b> E{P_RSS(3 * L + 2), P_HID, nullptr, nullptr, FF, f8ib ? F8_UNSCALE_IN : 1.0f}; run_gemm<pg8::EpiIn<0, f8b>, f8ib>(F, f8ib ? (const bf16*)P_X8 : P_XB, P_WB(g0 + 4), 2 * FF, D, E); SEAM(pf); }
        if (IN(pf + 1)) { ENTER(); if (L + 1 < DEPTH) CVT_FFN_IN(kp_, 5, 2, L + 1, P_WB(g0 + 6), f8in); REFRESH();
            pg8::EpiRes<(L == DEPTH - 1), f8in> E{ARG_OUT(kp_), P_XB, P_RSS(3 * L + 3), f8b ? 0.5f * F8_UNSCALE : 0.5f, P_X8}; run_gemm<pg8::EpiRes<(L == DEPTH - 1), f8in>, f8b>(F, P_HID, P_WB(g0 + 5), D, FF, E); SEAM(pf + 1); }

}

__global__ void __launch_bounds__(NWAVES * 64, 2) mk_fwd(Args args) {
    extern __shared__ __attribute__((aligned(16))) unsigned char lds[];
    Frame F;
    F.lds = (LAS unsigned char*)lds;
    F.MISC = (volatile LAS unsigned*)(F.lds + MISC_OFF);
    F.tid = threadIdx.x;
    if (F.tid == 0) { const unsigned long long kpv = (unsigned long long)__builtin_amdgcn_kernarg_segment_ptr(); F.MISC[16] = blockIdx.x; F.MISC[17] = gridDim.x; F.MISC[18] = (unsigned)kpv; F.MISC[19] = (unsigned)(kpv >> 32); }
    if ((F.tid & 63) == 0) F.MISC[32 + mk_hwslot()] = F.tid >> 6;
    for (int u = F.tid; u < (LDS_BYTES - LDSCTL_OFF) / 4; u += NWAVES * 64) { const int mi = u - (MISC_OFF - LDSCTL_OFF) / 4; if (mi < 16 || (mi > 19 && mi < 32) || mi >= 96) ((LAS unsigned*)(F.lds + LDSCTL_OFF))[u] = 0u; }
    __syncthreads();
    { kargp k_ = KP0(); (void)xcd_barrier_post((unsigned*)(ARG_WS(k_) + WS_CTL) + CW_BAR, (volatile LAS unsigned*)((LAS unsigned char*)lds + MISC_OFF) + 8); }
    if (IN(0)) { constexpr int Lrt = 0; ENTER(); p0_rows(F, ARG_IN(kp_, 0), P_XB, P_RSS(0)); rope_table(F, (const int*)ARG_IN(kp_, 1), WSP(float, WS_ROPE)); CVT_FFN_IN(kp_, 5, 2, 0, P_WB(0), false); REFRESH(); SEAM(0); }
    run_layer<0>(F, lds); run_layer<1>(F, lds); run_layer<2>(F, lds); run_layer<3>(F, lds);
#ifdef MK_PROBE_LIST
    if (IN(40)) { constexpr int Lrt = 0; ENTER(); pg8::EpiRes<false> E{nullptr, WSP(bf16, WS_GD_O), P_RSS(12), 0.5f}; run_gemm(F, P_HID, P_WB(1), D, FF, E); }
    if (IN(41)) { constexpr int Lrt = 0; ENTER(); pg8::EpiIn<1> E{P_RSS(0), WSP(bf16, WS_GD_O), nullptr, nullptr, D}; run_gemm(F, P_HID, P_WB(1), D, FF, E); }
#endif
}
#undef IN
#undef SEAM
#undef ENTER
#undef REFRESH

#ifndef MK_MULTI
#define MK_MULTI 0
#endif
extern "C" void kernel_launch(void* const* d_in, const int* in_sizes, int n_in, void* d_out, int out_size, void* d_ws, size_t ws_size, hipStream_t stream) {
    static int grid = 0;
    if (grid == 0) {
        if (n_in != 22 || out_size != M * D || ws_size < WS_END) { fprintf(stderr, "kernel_launch: unexpected shapes (n_in %d out %d ws %zu)\n", n_in, out_size, ws_size); grid = -1; return; }
        int dev = 0, cus = 0, per_cu = 0;
        if (hipGetDevice(&dev) != hipSuccess || hipDeviceGetAttribute(&cus, hipDeviceAttributeMultiprocessorCount, dev) != hipSuccess) { grid = -1; return; }
        if (hipFuncSetAttribute((const void*)mk_fwd, hipFuncAttributeMaxDynamicSharedMemorySize, LDS_BYTES) != hipSuccess) { fprintf(stderr, "kernel_launch: hipFuncSetAttribute failed\n"); grid = -1; return; }
        if (hipOccupancyMaxActiveBlocksPerMultiprocessor(&per_cu, (const void*)mk_fwd, NWAVES * 64, LDS_BYTES) != hipSuccess || per_cu < 1) { fprintf(stderr, "kernel_launch: occupancy query reports %d\n", per_cu); per_cu = 1; }
        (void)hipGetLastError();
        grid = cus;
    }
    if (grid < 0) return;
    if (hipMemsetAsync((char*)d_ws + WS_CTL, 0, CTL_ZERO_BYTES, stream) != hipSuccess) return;
    Args a{};
    for (int i = 0; i < 22; ++i) a.in[i] = (const float*)d_in[i];
    a.out = (float*)d_out; a.ws = (unsigned char*)d_ws;
#if MK_MULTI
    for (int p = 0; p < NPH; ++p) { a.ph_lo = p; a.ph_hi = p + 1; hipLaunchKernelGGL(mk_fwd, dim3(grid), dim3(NWAVES * 64), LDS_BYTES, stream, a); }
#else
    a.ph_lo = 0; a.ph_hi = NPH;
    hipLaunchKernelGGL(mk_fwd, dim3(grid), dim3(NWAVES * 64), LDS_BYTES, stream, a);
#ifdef MK_PROBE_LIST
    { const int plist[] = {MK_PROBE_LIST};
      for (int p : plist) { a.ph_lo = p; a.ph_hi = p + 1; (void)hipMemsetAsync((char*)d_ws + WS_CTL + 4 * CW_QHEAD, 0, 4, stream); hipLaunchKernelGGL(mk_fwd, dim3(grid), dim3(NWAVES * 64), LDS_BYTES, stream, a); } }
#endif
#endif
}
```

```cpp
#include <hip/hip_runtime.h>
#include <cstdio>
#include <cstdint>
#define MK_LAS __attribute__((address_space(3)))
constexpr int MK_MISC_ABS = 155648 + 320;
__device__ __forceinline__ int mk_hwslot() { return (int)(__builtin_amdgcn_s_getreg((5 << 11) | 4) & 63u); }
__device__ __forceinline__ int mk_tid() {
    const unsigned w = ((const volatile MK_LAS unsigned*)(unsigned)MK_MISC_ABS)[32 + mk_hwslot()];
    int l_; asm volatile("v_mbcnt_lo_u32_b32 %0, -1, 0\n\tv_mbcnt_hi_u32_b32 %0, -1, %0" : "=v"(l_));
    return __builtin_amdgcn_readfirstlane((int)w) * 64 + l_;
}
namespace pg8 {
#define PG8_LAS __attribute__((address_space(3)))
typedef unsigned short bf16_t;
typedef short bf16x8 __attribute__((ext_vector_type(8)));
typedef float f32x4 __attribute__((ext_vector_type(4)));
typedef unsigned u32x4 __attribute__((ext_vector_type(4)));
typedef int i32x4 __attribute__((ext_vector_type(4)));
typedef int i32x8 __attribute__((ext_vector_type(8)));
__device__ __forceinline__ f32x4 mma_f8(bf16x8 a0, bf16x8 a1, bf16x8 b0, bf16x8 b1, f32x4 c) {
    const i32x8 A = __builtin_shufflevector(__builtin_bit_cast(i32x4, a0), __builtin_bit_cast(i32x4, a1), 0, 1, 2, 3, 4, 5, 6, 7);
    const i32x8 B = __builtin_shufflevector(__builtin_bit_cast(i32x4, b0), __builtin_bit_cast(i32x4, b1), 0, 1, 2, 3, 4, 5, 6, 7);
    return __builtin_amdgcn_mfma_scale_f32_16x16x128_f8f6f4(A, B, c, 0, 0, 0, 0, 0, 0);
}
constexpr int BM = 256, BK = 64, HALF = 128, HTB = HALF * BK * 2  , STAGE_BYTES = 8 * HTB, NXCD = 8, WGM = 8;

__host__ __device__ __forceinline__ int lds_byte(int r, int c) { const int st = (r >> 4) * 2 + (c >> 5), rr = r & 15, cc = c & 31, ob = rr * 64 + cc * 2; return st * 1024 + (ob ^ (((ob >> 9) & 1) << 5)); }
__host__ __device__ __forceinline__ void stage_rc(int b, int& R, int& C) { const int st = b / 1024, sb = b % 1024, swz = sb ^ (((sb >> 9) & 1) << 5); R = (st >> 1) * 16 + swz / 64; C = (st & 1) * 32 + (swz % 64) / 2; }
__host__ __device__ __forceinline__ int perm32(int rho) { const int n = rho >> 4, i = rho & 15; return 8 * (i >> 2) + 4 * n + (i & 3); }

struct Unit { int pm, pn; };
struct Gemm { const bf16_t* A; const bf16_t* Bt; int M, N, K; };

struct StaticOrder {
    int nM, nN, nwg, G, c;
    __host__ __device__ void init(int M, int N, int G_, int c_) { nM = M / BM; nN = N / BM; nwg = nM * nN; G = G_; c = c_; }
    __host__ __device__ bool next(int i, Unit& u) const {
        const long L = (long)i * G + c; if (L >= nwg) return false;
        int wgid = (int)L; { const int q = nwg / NXCD, r = nwg % NXCD, xcd = wgid % NXCD, off = wgid / NXCD; wgid = (xcd < r ? xcd * (q + 1) : r * (q + 1) + (xcd - r) * q) + off; }
        const int nig = WGM * nN, gid = wgid / nig, fm = gid * WGM, gsz = (nM - fm) < WGM ? (nM - fm) : WGM;
        u.pm = fm + ((wgid % nig) % gsz); u.pn = (wgid % nig) / gsz; return true;
    }
    __device__ __forceinline__ void a_ready(const Unit&) const {}
    __device__ __forceinline__ void done(const Unit&) const {}
};
typedef float f32x2v __attribute__((ext_vector_type(2)));
typedef __bf16 bf2v __attribute__((ext_vector_type(2)));
__device__ __forceinline__ unsigned pkbf(float lo, float hi) { f32x2v v = {lo, hi}; return __builtin_bit_cast(unsigned, __builtin_convertvector(v, bf2v)); }
__device__ __forceinline__ float silu_f(float x) { return x * __builtin_amdgcn_rcpf(1.0f + __builtin_amdgcn_exp2f(-1.4426950408889634f * x)); }
__device__ __forceinline__ u32x4 pack8f(f32x4 a, f32x4 b) { u32x4 w; w.x = pkbf(a[0], a[1]); w.y = pkbf(a[2], a[3]); w.z = pkbf(b[0], b[1]); w.w = pkbf(b[2], b[3]); return w; }
constexpr float RMS_EPS = 1e-6f;
constexpr float F8_HS = 8.0f, F8_WS = 1024.0f, F8_XS = 16.0f;
typedef unsigned u32x2 __attribute__((ext_vector_type(2)));
__device__ __forceinline__ float f8c(float v, float sc) { return __builtin_amdgcn_fmed3f(v * sc, -448.f, 448.f); }
__device__ __forceinline__ unsigned pk4f8(float a, float b, float c, float d, float sc) { int w = __builtin_amdgcn_cvt_pk_fp8_f32(f8c(a, sc), f8c(b, sc), 0, false); w = __builtin_amdgcn_cvt_pk_fp8_f32(f8c(c, sc), f8c(d, sc), w, true); return (unsigned)w; }
template <int MODE, bool O8 = false> struct EpiIn {
    static constexpr bool PERM = true, AFTER_DRAIN = false;
    const unsigned long long* rowss; bf16_t* O0; bf16_t* O1; float* OF; int ldc; float usc = 1.0f;
    __device__ __forceinline__ void operator()(const f32x4 (&acc)[2][2][4][2], const Unit& u, int wr, int wc, int fr, int fq) const {
        const int row0 = u.pm * BM + wr * 64 + fr; const int cw = wc * 32 + 8 * fq;
#pragma unroll
        for (int ai = 0; ai < 2; ++ai)
#pragma unroll
            for (int m = 0; m < 4; ++m) {
                const int row = row0 + ai * HALF + m * 16;
                const float rs = usc * __builtin_amdgcn_rsqf((float)rowss[row] * (1.0f / (4096.0f * 16777216.0f)) + RMS_EPS);
                if constexpr (MODE == 0) {
                    f32x4 g0 = acc[ai][0][m][0] * rs, g1 = acc[ai][0][m][1] * rs, u0 = acc[ai][1][m][0] * rs, u1 = acc[ai][1][m][1] * rs;
#pragma unroll
                    for (int j = 0; j < 4; ++j) { g0[j] = silu_f(g0[j]) * u0[j]; g1[j] = silu_f(g1[j]) * u1[j]; }
                    if constexpr (O8) { u32x2 w; w.x = pk4f8(g0[0], g0[1], g0[2], g0[3], F8_HS); w.y = pk4f8(g1[0], g1[1], g1[2], g1[3], F8_HS);
                        *(u32x2*)((unsigned char*)O0 + (size_t)row * ldc + u.pn * HALF + cw) = w; }
                    else *(u32x4*)(O0 + (size_t)row * ldc + u.pn * HALF + cw) = pack8f(g0, g1);
                } else if constexpr (MODE == 1) {
#pragma unroll
                    for (int bj = 0; bj < 2; ++bj) *(u32x4*)(O0 + (size_t)row * ldc + u.pn * BM + bj * HALF + cw) = pack8f(acc[ai][bj][m][0] * rs, acc[ai][bj][m][1] * rs);
                } else if constexpr (MODE == 2) {
                    if (u.pn < 32) { const f32x4 a0 = (acc[ai][0][m][0] * rs) * (acc[ai][1][m][0] * rs), a1 = (acc[ai][0][m][1] * rs) * (acc[ai][1][m][1] * rs);
                        *(u32x4*)(O0 + (size_t)row * 4096 + u.pn * HALF + cw) = pack8f(a0, a1); }
                    else {
#pragma unroll
                        for (int bj = 0; bj < 2; ++bj) *(u32x4*)(O1 + (size_t)row * 4096 + (u.pn - 32) * BM + bj * HALF + cw) = pack8f(acc[ai][bj][m][0] * rs, acc[ai][bj][m][1] * rs); }
                } else {
                    if (u.pn < 64) {
#pragma unroll
                        for (int bj = 0; bj < 2; ++bj) *(u32x4*)(O0 + (size_t)row * 16384 + u.pn * BM + bj * HALF + cw) = pack8f(acc[ai][bj][m][0] * rs, acc[ai][bj][m][1] * rs); }
                    else if (wc < 2) { *(f32x4*)(OF + (size_t)row * 64 + cw) = acc[ai][0][m][0] * rs; *(f32x4*)(OF + (size_t)row * 64 + cw + 4) = acc[ai][0][m][1] * rs; }
                }
            }
    }
};
template <bool FINAL, bool X8 = false> struct EpiRes {
    static constexpr bool PERM = true, AFTER_DRAIN = false;
    float* out; bf16_t* xb; unsigned long long* rowss_next; float scale; unsigned char* x8 = nullptr;
    __device__ __forceinline__ void operator()(const f32x4 (&acc)[2][2][4][2], const Unit& u, int wr, int wc, int fr, int fq) const {
        const int row0 = u.pm * BM + wr * 64 + fr, col0 = u.pn * BM + wc * 32 + 8 * fq;
#pragma unroll
        for (int ai = 0; ai < 2; ++ai) {
            u32x4 bs[4][2];
#pragma unroll
            for (int m = 0; m < 4; ++m)
#pragma unroll
                for (int bj = 0; bj < 2; ++bj) bs[m][bj] = *(const u32x4*)(xb + (size_t)(row0 + ai * HALF + m * 16) * 4096 + col0 + bj * HALF);
#pragma unroll
            for (int m = 0; m < 4; ++m) {
                const int row = row0 + ai * HALF + m * 16; const size_t off = (size_t)row * 4096 + col0; float ss = 0.f;
#pragma unroll
                for (int bj = 0; bj < 2; ++bj) {
                    const u32x4 b = bs[m][bj];
                    f32x4 o0, o1;
                    o0[0] = __builtin_bit_cast(float, b.x << 16) + acc[ai][bj][m][0][0] * scale; o0[1] = __builtin_bit_cast(float, b.x & 0xffff0000u) + acc[ai][bj][m][0][1] * scale;
                    o0[2] = __builtin_bit_cast(float, b.y << 16) + acc[ai][bj][m][0][2] * scale; o0[3] = __builtin_bit_cast(float, b.y & 0xffff0000u) + acc[ai][bj][m][0][3] * scale;
                    o1[0] = __builtin_bit_cast(float, b.z << 16) + acc[ai][bj][m][1][0] * scale; o1[1] = __builtin_bit_cast(float, b.z & 0xffff0000u) + acc[ai][bj][m][1][1] * scale;
                    o1[2] = __builtin_bit_cast(float, b.w << 16) + acc[ai][bj][m][1][2] * scale; o1[3] = __builtin_bit_cast(float, b.w & 0xffff0000u) + acc[ai][bj][m][1][3] * scale;
                    if constexpr (FINAL) { *(f32x4*)(out + off + bj * HALF) = o0; *(f32x4*)(out + off + bj * HALF + 4) = o1; }
                    else { const u32x4 w = pack8f(o0, o1); *(u32x4*)(xb + off + bj * HALF) = w;
                        const float r0 = __builtin_bit_cast(float, w.x << 16), r1 = __builtin_bit_cast(float, w.x & 0xffff0000u), r2 = __builtin_bit_cast(float, w.y << 16), r3 = __builtin_bit_cast(float, w.y & 0xffff0000u);
                        const float r4 = __builtin_bit_cast(float, w.z << 16), r5 = __builtin_bit_cast(float, w.z & 0xffff0000u), r6 = __builtin_bit_cast(float, w.w << 16), r7 = __builtin_bit_cast(float, w.w & 0xffff0000u);
                        ss += ((r0 * r0 + r1 * r1) + (r2 * r2 + r3 * r3)) + ((r4 * r4 + r5 * r5) + (r6 * r6 + r7 * r7));
                        if constexpr (X8) { u32x2 w8; w8.x = pk4f8(r0, r1, r2, r3, F8_XS); w8.y = pk4f8(r4, r5, r6, r7, F8_XS); *(u32x2*)(x8 + off + bj * HALF) = w8; } }
                }
                if constexpr (!FINAL) { ss += __shfl_xor(ss, 16); ss += __shfl_xor(ss, 32);
                    if (fq == 0) __hip_atomic_fetch_add(rowss_next + row, (unsigned long long)(ss * 16777216.0f + 0.5f), __ATOMIC_RELAXED, __HIP_MEMORY_SCOPE_AGENT); }
            }
            asm volatile("" ::: "memory");
        }
    }
};
template <class Epi, class Sched, bool ALIGN_EPI = false, bool SP2 = false, bool F8 = false>
__device__ __forceinline__ void gemm_phase(PG8_LAS unsigned char* lds, const Gemm g, const Sched& S, const Epi& E) {
    int tid_ = mk_tid(); asm volatile("" : "+v"(tid_));
    const int tid = tid_, wid = __builtin_amdgcn_readfirstlane(tid >> 6), lane = tid & 63, wr = wid >> 2, wc = wid & 3, fr = lane & 15, fq = lane >> 4;
    const int K = g.K, nt = K / BK;
    unsigned voffA[2], voffB[2];
#pragma unroll
    for (int i = 0; i < 2; ++i) { int R, C; stage_rc(tid * 16 + i * 8192, R, C); const int Rb = Epi::PERM ? ((R & ~31) + perm32(R & 31)) : R;
        voffA[i] = (unsigned)(R * K + C) * 2u; voffB[i] = (unsigned)(Rb * K + C) * 2u; }
    const size_t kstep = (size_t)(BK * 2);
    const size_t hstep = (size_t)HALF * K * 2;
    const size_t tstep = 2 * hstep;
    const unsigned ldsw = (unsigned)wid * 1024u;
    const int aoff = lds_byte(wr * 64 + fr, fq * 8), boff = lds_byte(wc * 32 + fr, fq * 8);
#define PG8_SA(b, h) (((b) * 2 + (h)) * HTB)
#define PG8_SB(b, h) ((4 + (b) * 2 + (h)) * HTB)
#define PG8_STAGE(bufoff, gbase, voff) do { const char* gb_ = (const char*)(gbase); if constexpr (F8) asm volatile("" : "+s"(gb_));     \
        _Pragma("unroll") for (int _i = 0; _i < 2; ++_i) \
        __builtin_amdgcn_global_load_lds((const unsigned*)(gb_ + (voff)[_i]), (PG8_LAS unsigned*)(lds + (bufoff) + ldsw + _i * 8192), 16, 0, 0); } while (0)
#define PG8_LDA(dst, b, h) do { _Pragma("unroll") for (int m = 0; m < 4; ++m) _Pragma("unroll") for (int k = 0; k < 2; ++k) dst[m][k] = *(const PG8_LAS bf16x8*)(lds + PG8_SA(b, h) + aoff + m * 2048 + k * 1024); } while (0)
#define PG8_LDB(dst, b, h) do { _Pragma("unroll") for (int n = 0; n < 2; ++n) _Pragma("unroll") for (int k = 0; k < 2; ++k) dst[n][k] = *(const PG8_LAS bf16x8*)(lds + PG8_SB(b, h) + boff + n * 2048 + k * 1024); } while (0)
#define PG8_MMA(ai, bj, At, Bt) do { __builtin_amdgcn_s_setprio(1); _Pragma("unroll") for (int m = 0; m < 4; ++m) _Pragma("unroll") for (int n = 0; n < 2; ++n) { \
        if constexpr (F8) acc[ai][bj][m][n] = mma_f8(Bt[n][0], Bt[n][1], At[m][0], At[m][1], acc[ai][bj][m][n]); \
        else { _Pragma("unroll") for (int k = 0; k < 2; ++k) acc[ai][bj][m][n] = __builtin_amdgcn_mfma_f32_16x16x32_bf16(Bt[n][k], At[m][k], acc[ai][bj][m][n], 0, 0, 0); } } __builtin_amdgcn_s_setprio(0); } while (0)
#define PG8_WAIT_V(n) asm volatile("s_waitcnt vmcnt(" #n ")" ::: "memory")
#define PG8_WAIT_L(n) asm volatile("s_waitcnt lgkmcnt(" #n ")" ::: "memory")
#define PG8_BAR __builtin_amdgcn_s_barrier()
#define PG8_SCHED __builtin_amdgcn_sched_barrier(0)
    Unit cur, nxt; int ui = 0;
    if (!S.next(0, cur)) return;
    f32x4 acc[2][2][4][2];
#pragma unroll
    for (int a = 0; a < 2; ++a)
#pragma unroll
        for (int b = 0; b < 2; ++b)
#pragma unroll
            for (int m = 0; m < 4; ++m)
#pragma unroll
                for (int n = 0; n < 2; ++n) acc[a][b][m][n] = (f32x4){0.f, 0.f, 0.f, 0.f};
    bf16x8 At[4][2], B0[2][2], B1[2][2];
    const char* cA = (const char*)g.A + (size_t)cur.pm * tstep; const char* cB = (const char*)g.Bt + (size_t)cur.pn * tstep;
    S.a_ready(cur);
    if constexpr (SP2) {
        PG8_STAGE(PG8_SB(0, 0), cB, voffB); PG8_STAGE(PG8_SB(0, 1), cB + hstep, voffB); PG8_STAGE(PG8_SA(0, 0), cA, voffA); PG8_STAGE(PG8_SA(0, 1), cA + hstep, voffA);
        if (wr == 1) PG8_BAR;
        PG8_WAIT_V(2); PG8_BAR;
        PG8_STAGE(PG8_SB(1, 0), cB + kstep, voffB); PG8_STAGE(PG8_SA(1, 0), cA + kstep, voffA); PG8_STAGE(PG8_SB(1, 1), cB + hstep + kstep, voffB);
        PG8_WAIT_V(6); PG8_BAR;
    } else {
        PG8_STAGE(PG8_SB(0, 0), cB, voffB); PG8_STAGE(PG8_SA(0, 0), cA, voffA); PG8_STAGE(PG8_SB(0, 1), cB + hstep, voffB); PG8_STAGE(PG8_SA(0, 1), cA + hstep, voffA);
        if (wr == 1) PG8_BAR;
        PG8_WAIT_V(4); PG8_BAR;
        PG8_STAGE(PG8_SB(1, 0), cB + kstep, voffB); PG8_STAGE(PG8_SA(1, 0), cA + kstep, voffA); PG8_STAGE(PG8_SB(1, 1), cB + hstep + kstep, voffB);
        PG8_WAIT_V(6); PG8_BAR;
    }
    for (;;) {
        const bool has_next = S.next(ui + 1, nxt);
        const char* nA = has_next ? (const char*)g.A + (size_t)nxt.pm * tstep : cA; const char* nB = has_next ? (const char*)g.Bt + (size_t)nxt.pn * tstep : cB;
        for (int t = 0; t < nt; t += 2) {
            const bool last = (t == nt - 2);
            const char* a1 = cA + (size_t)(t + 1) * kstep;
            const char* a2 = last ? nA : cA + (size_t)(t + 2) * kstep; const char* b2 = last ? nB : cB + (size_t)(t + 2) * kstep;
            const char* a3 = a2 + kstep; const char* b3 = b2 + kstep;
            if (last && has_next) S.a_ready(nxt);
            if constexpr (SP2) {
            PG8_LDB(B0, 0, 0); PG8_LDB(B1, 0, 1); PG8_SCHED; PG8_LDA(At, 0, 0); PG8_STAGE(PG8_SA(1, 1), a1 + hstep, voffA);
            PG8_WAIT_V(8); PG8_WAIT_L(0); PG8_BAR; PG8_MMA(0, 0, At, B0); PG8_MMA(0, 1, At, B1); PG8_BAR; PG8_SCHED;
            PG8_LDA(At, 0, 1); PG8_STAGE(PG8_SB(0, 0), b2, voffB); PG8_STAGE(PG8_SB(0, 1), b2 + hstep, voffB); PG8_STAGE(PG8_SA(0, 0), a2, voffA);
            PG8_WAIT_V(8); PG8_WAIT_L(0); PG8_BAR; PG8_MMA(1, 0, At, B0); PG8_MMA(1, 1, At, B1); PG8_BAR; PG8_SCHED;
            PG8_LDB(B0, 1, 0); PG8_LDB(B1, 1, 1); PG8_SCHED; PG8_LDA(At, 1, 0); PG8_STAGE(PG8_SA(0, 1), a2 + hstep, voffA);
            PG8_WAIT_V(8); PG8_WAIT_L(0); PG8_BAR; PG8_MMA(0, 0, At, B0); PG8_MMA(0, 1, At, B1); PG8_BAR; PG8_SCHED;
            PG8_LDA(At, 1, 1); PG8_STAGE(PG8_SB(1, 0), b3, voffB); PG8_STAGE(PG8_SB(1, 1), b3 + hstep, voffB); PG8_STAGE(PG8_SA(1, 0), a3, voffA);
            PG8_WAIT_V(8); PG8_WAIT_L(0); PG8_BAR; PG8_MMA(1, 0, At, B0); PG8_MMA(1, 1, At, B1); PG8_BAR; PG8_SCHED;
            } else {
            PG8_LDB(B0, 0, 0); PG8_SCHED; PG8_LDA(At, 0, 0); PG8_STAGE(PG8_SA(1, 1), a1 + hstep, voffA);
            PG8_WAIT_L(8); PG8_BAR; PG8_WAIT_L(0); PG8_MMA(0, 0, At, B0); PG8_BAR; PG8_SCHED;
            PG8_LDB(B1, 0, 1); PG8_STAGE(PG8_SB(0, 0), b2, voffB);
            PG8_BAR; PG8_WAIT_L(0); PG8_MMA(0, 1, At, B1); PG8_BAR;
            PG8_LDA(At, 0, 1); PG8_STAGE(PG8_SA(0, 0), a2, voffA);
            PG8_BAR; PG8_WAIT_L(0); PG8_MMA(1, 0, At, B0); PG8_BAR; PG8_SCHED;
            PG8_STAGE(PG8_SB(0, 1), b2 + hstep, voffB);
            PG8_WAIT_V(6); PG8_BAR; PG8_MMA(1, 1, At, B1); PG8_BAR;
            PG8_LDB(B0, 1, 0); PG8_SCHED; PG8_LDA(At, 1, 0); PG8_STAGE(PG8_SA(0, 1), a2 + hstep, voffA);
            PG8_WAIT_L(8); PG8_BAR; PG8_WAIT_L(0); PG8_MMA(0, 0, At, B0); PG8_BAR; PG8_SCHED;
            PG8_LDB(B1, 1, 1); PG8_STAGE(PG8_SB(1, 0), b3, voffB);
            PG8_BAR; PG8_WAIT_L(0); PG8_MMA(0, 1, At, B1); PG8_BAR;
            PG8_LDA(At, 1, 1); PG8_STAGE(PG8_SA(1, 0), a3, voffA);
            PG8_BAR; PG8_WAIT_L(0); PG8_MMA(1, 0, At, B0); PG8_BAR; PG8_SCHED;
            PG8_STAGE(PG8_SB(1, 1), b3 + hstep, voffB);
            PG8_WAIT_V(6); PG8_BAR; PG8_MMA(1, 1, At, B1); PG8_BAR;
            }
        }
        if constexpr (ALIGN_EPI) { if (wr == 0) PG8_BAR; }
        if constexpr (!Epi::AFTER_DRAIN) {
            if constexpr (F8) { int t2_; asm volatile("v_mbcnt_lo_u32_b32 %0, -1, 0\n\tv_mbcnt_hi_u32_b32 %0, -1, %0" : "=v"(t2_)); E(acc, cur, wr, wc, t2_ & 15, t2_ >> 4); }
            else E(acc, cur, wr, wc, fr, fq);
            S.done(cur); }
        if (!has_next) break;
#pragma unroll
        for (int a = 0; a < 2; ++a)
#pragma unroll
            for (int b = 0; b < 2; ++b)
#pragma unroll
                for (int m = 0; m < 4; ++m)
#pragma unroll
                    for (int n = 0; n < 2; ++n) acc[a][b][m][n] = (f32x4){0.f, 0.f, 0.f, 0.f};
        cur = nxt; cA = nA; cB = nB; ++ui;
        if constexpr (ALIGN_EPI) { if (wr == 1) PG8_BAR; }
    }
    PG8_WAIT_V(0);
    if constexpr (!ALIGN_EPI) { if (wr == 0) PG8_BAR; }
    PG8_BAR;
    if constexpr (Epi::AFTER_DRAIN) { E.fused(acc, cur, wr, wc, fr, fq, lds, wid, lane); S.done(cur); }
#undef PG8_SA
#undef PG8_SB
#undef PG8_STAGE
#undef PG8_LDA
#undef PG8_LDB
#undef PG8_MMA
#undef PG8_WAIT_V
#undef PG8_WAIT_L
#undef PG8_BAR
#undef PG8_SCHED
}
}
constexpr int NWAVES = 8;
constexpr int BATCH = 2, SEQ = 8192, D = 4096, FF = 5632, NH = 32, HD = 128, DEPTH = 4;
constexpr int M = BATCH * SEQ;
constexpr int GDN_N = 16448, GDN_NP = 16640;
constexpr size_t MiB = 1u << 20;
constexpr size_t WS_CTL = 0, CTL_ZERO_BYTES = 3 * MiB;
constexpr size_t WS_ROWSS = 1 * MiB;
constexpr size_t WS_ROPE = 4 * MiB;
constexpr size_t WS_WB0 = 16 * MiB, WS_WB1 = 160 * MiB;
constexpr size_t WS_XB = 304 * MiB;
constexpr size_t WS_SCR = 432 * MiB;
constexpr size_t WS_HID = WS_SCR;
constexpr size_t WS_SC_U = WS_SCR, WS_SC_GB = WS_SCR + 128 * MiB, WS_SC_A2 = WS_SCR + 256 * MiB;
constexpr size_t WS_MB_PROJ = WS_SCR;
constexpr size_t WS_MB_Q = WS_SCR + 384 * MiB, WS_MB_K = WS_SCR + 512 * MiB;
constexpr size_t WS_MB_O = WS_SCR + 640 * MiB;
constexpr size_t WS_MB_KMEAN = WS_SCR + 768 * MiB;
constexpr size_t WS_MB_SEL = WS_SCR + 770 * MiB;
constexpr size_t WS_MB_LIST = WS_SCR + 772 * MiB;
constexpr size_t WS_MB_CNT = WS_SCR + 836 * MiB;
constexpr size_t WS_MB_LSE = WS_SCR + 838 * MiB;
constexpr size_t WS_MB_OPART = WS_SCR + 848 * MiB;
constexpr size_t WS_GD_PROJ = WS_SCR;
constexpr size_t WS_GD_AB = WS_SCR + 512 * MiB;
constexpr size_t WS_GD_TAB = WS_SCR + 516 * MiB;
constexpr size_t WS_GD_QN = WS_SCR + 524 * MiB, WS_GD_KN = WS_GD_QN + 128 * MiB, WS_GD_KWT = WS_GD_KN + 128 * MiB, WS_GD_VUT = WS_GD_KWT + 128 * MiB,
                 WS_GD_KDT = WS_GD_VUT + 128 * MiB, WS_GD_QD = WS_GD_KDT + 128 * MiB, WS_GD_WF = WS_GD_QD + 128 * MiB, WS_GD_QKM = WS_GD_WF + 128 * MiB,
                 WS_GD_U = WS_GD_QKM + 64 * MiB, WS_GD_O = WS_GD_U + 256 * MiB, WS_GD_OG = WS_GD_O + 256 * MiB, WS_X8 = WS_GD_OG + 128 * MiB  , WS_END = WS_X8 + 64 * MiB;
static_assert(WS_END <= (size_t)3400 * MiB, "d_ws map must stay below the guaranteed workspace size");
constexpr int CW_TMO = 0, CW_CODE = 1, CW_QHEAD = 1024, CW_PROG = 2048  , CW_BAR = 4096;
constexpr int RING_OFF = 0, RING_BYTES = 155648;
constexpr int LDSCTL_OFF = RING_BYTES, MISC_OFF = LDSCTL_OFF + 320;
constexpr int LDS_BYTES = 163840;
static_assert(MISC_OFF + 4 * 96 <= LDS_BYTES && MISC_OFF == MK_MISC_ABS, "LDS map");

#define GAS __attribute__((address_space(1)))
#define LAS __attribute__((address_space(3)))
typedef unsigned short bf16;
typedef unsigned v4u __attribute__((ext_vector_type(4)));
typedef unsigned v2u __attribute__((ext_vector_type(2)));
typedef float f32x4 __attribute__((ext_vector_type(4)));
typedef float f32x16 __attribute__((ext_vector_type(16)));
typedef float f32x2v __attribute__((ext_vector_type(2)));
typedef short bf16x8 __attribute__((ext_vector_type(8)));
typedef GAS unsigned gu32;
typedef GAS unsigned long long gu64;
#define RLX_AGENT __ATOMIC_RELAXED, __HIP_MEMORY_SCOPE_AGENT
#define LDS_WAIT() asm volatile("s_waitcnt lgkmcnt(0)" ::: "memory")
#define VM_WAIT() asm volatile("s_waitcnt vmcnt(0)" ::: "memory")
using pg8::pkbf;
__device__ __forceinline__ float bf2f(unsigned short b) { return __builtin_bit_cast(float, (unsigned)b << 16); }
__device__ __forceinline__ float bflo(unsigned w) { return __builtin_bit_cast(float, w << 16); }
__device__ __forceinline__ float bfhi(unsigned w) { return __builtin_bit_cast(float, w & 0xffff0000u); }
#define DPP_ADD(x, ctrl) ((x) + __builtin_bit_cast(float, __builtin_amdgcn_update_dpp(0, __builtin_bit_cast(int, (x)), (ctrl), 0xf, 0xf, true)))
__device__ __forceinline__ float wave_sum_dpp(float v) {
    v = DPP_ADD(v, 0xB1);
    v = DPP_ADD(v, 0x4E);
    v = DPP_ADD(v, 0x141);
    v = DPP_ADD(v, 0x140);
    const int b = __builtin_bit_cast(int, v);
    return (__builtin_bit_cast(float, __builtin_amdgcn_readlane(b, 0)) + __builtin_bit_cast(float, __builtin_amdgcn_readlane(b, 16))) +
           (__builtin_bit_cast(float, __builtin_amdgcn_readlane(b, 32)) + __builtin_bit_cast(float, __builtin_amdgcn_readlane(b, 48)));
}
__device__ __forceinline__ float row16_sum_dpp(float v) {
    v = DPP_ADD(v, 0xB1); v = DPP_ADD(v, 0x4E); v = DPP_ADD(v, 0x141); v = DPP_ADD(v, 0x140); return v;
}
__device__ __forceinline__ float wave_sum(float v) {
#pragma unroll
    for (int o = 1; o < 64; o <<= 1) v += __shfl_xor(v, o);
    return v;
}
#define XB_TMO      128
#define XB_XCNT(j)  (256  + 64 * (j))
#define XB_XSUB(j)  (1280 + 64 * (j))
#define XB_XGEN(j)  (2304 + 64 * (j))
#define XB_TOP      3328
#define XB_TOPGEN   3392
#define XCD_BAR_WORDS 3456
#define XB_SPIN_CAP (1u << 27)

__device__ __forceinline__ unsigned xb_ld(unsigned* p)              { return __hip_atomic_load(p, __ATOMIC_RELAXED, __HIP_MEMORY_SCOPE_AGENT); }
__device__ __forceinline__ unsigned xb_add(unsigned* p, unsigned v) { return __hip_atomic_fetch_add(p, v, __ATOMIC_RELAXED, __HIP_MEMORY_SCOPE_AGENT); }
__device__ __forceinline__ unsigned xb_xcc_id() { return (unsigned)__builtin_amdgcn_s_getreg((3 << 11) | 20) & 0xFu; }
#define XB_SPIN(cond, bar) do { unsigned _sp = 0; while (cond) { __builtin_amdgcn_s_sleep(1); \
    if ((++_sp & 255u) == 0u) { if (xb_ld(&(bar)[XB_TMO])) break; if (_sp > XB_SPIN_CAP) { atomicAdd(&(bar)[XB_TMO], 1u); break; } } } } while (0)

struct XcdBarrier {
    unsigned* bar; unsigned x;
    volatile LAS unsigned* st;
};

__device__ __forceinline__ XcdBarrier xcd_barrier_post(unsigned* bar, volatile LAS unsigned* st) {
    XcdBarrier b; b.bar = bar; b.x = xb_xcc_id(); b.st = st;
    if (mk_tid() == 0) (void)xb_add(&bar[XB_XCNT(b.x)], 1u);
    return b;
}
__device__ __forceinline__ void xcd_barrier_complete(unsigned* bar, unsigned x, unsigned& nloc, unsigned& nx, unsigned G) {
    unsigned sum, cnt, mine, sp = 0u;
    for (;;) {
        sum = 0u; cnt = 0u; mine = 0u;
#pragma unroll
        for (unsigned j = 0; j < 16; ++j) { const unsigned c = xb_ld(&bar[XB_XCNT(j)]); sum += c; cnt += (c > 0u) ? 1u : 0u; mine = (j == x) ? c : mine; }
        if (sum == G) break;
        __builtin_amdgcn_s_sleep(1);
        if ((++sp & 255u) == 0u) { if (xb_ld(&bar[XB_TMO])) break; if (sp > XB_SPIN_CAP) { atomicAdd(&bar[XB_TMO], 1u); break; } }
    }
    nloc = mine > 0u ? mine : 1u; nx = cnt > 0u ? cnt : 1u;
}

__device__ __attribute__((noinline)) void xcd_barrier_fn(unsigned* bar_, unsigned x_, volatile LAS unsigned* st_) {
    XcdBarrier b; b.bar = bar_; b.x = x_; b.st = st_;
    asm volatile("s_waitcnt vmcnt(0)" ::: "memory");
    __syncthreads();
    if (mk_tid() == 0) {
        unsigned* bar = b.bar;
        __builtin_amdgcn_s_waitcnt(0);
        unsigned nloc = b.st[0], nx = b.st[1];
        if (nloc == 0u) { xcd_barrier_complete(bar, b.x, nloc, nx, b.st[9]); b.st[0] = nloc; b.st[1] = nx; }
        const unsigned old = xb_add(&bar[XB_XSUB(b.x)], 1u);
        const unsigned gen = old / nloc;
        if (old + 1u == (gen + 1u) * nloc) {
            __builtin_amdgcn_fence(__ATOMIC_RELEASE, "agent");
            asm volatile("s_waitcnt vmcnt(0)" ::: "memory");
            const unsigned og = xb_add(&bar[XB_TOP], 1u);
            const unsigned tg = og / nx;
            if (og + 1u == (tg + 1u) * nx) xb_add(&bar[XB_TOPGEN], 1u);
            else XB_SPIN(xb_ld(&bar[XB_TOPGEN]) == tg, bar);
            __builtin_amdgcn_fence(__ATOMIC_ACQUIRE, "agent");
            xb_add(&bar[XB_XGEN(b.x)], 1u);
            asm volatile("s_waitcnt vmcnt(0)" ::: "memory");
        } else {
            XB_SPIN(xb_ld(&bar[XB_XGEN(b.x)]) == gen, bar);
            __builtin_amdgcn_fence(__ATOMIC_ACQUIRE, "agent");
            asm volatile("s_waitcnt vmcnt(0)" ::: "memory");
        }
    }
    __syncthreads();
}

__device__ __forceinline__ void xcd_barrier(const XcdBarrier& b) { xcd_barrier_fn(b.bar, b.x, b.st); }
struct Frame {
    LAS unsigned char* lds;
    volatile LAS unsigned* MISC;
    gu32* ctl;
    int tid, lane, wave;
    int vcu, G, gw, NGW, bx;
    unsigned char* ws;
};
struct Args { const float* in[22]; float* out; unsigned char* ws; int ph_lo, ph_hi; };
#define AS4 __attribute__((address_space(4)))
typedef const char AS4* kargp;
template <class T> __device__ __forceinline__ T karg(kargp kp, int byteoff) { typedef T AS4 TA; return *(const TA*)(kp + byteoff); }
#define ARG_IN(kp, i) karg<const float*>(kp, 8 * (i))
#define ARG_OUT(kp) karg<float*>(kp, 176)
#define ARG_WS(kp) karg<unsigned char*>(kp, 184)
static_assert(sizeof(Args) == 200, "Args layout");

template <int MODE, int N> __device__ __forceinline__ int cvt_src_col(int nd) {
    if (MODE == 0) return nd < N ? nd : -1;
    const int t = nd >> 8, r = nd & 255;
    if (MODE == 1) return r < 128 ? 128 * t + r : FF + 128 * t + (r - 128);
    if (t < 32) return r < 128 ? D + 128 * t + r : 2 * D + 128 * t + (r - 128);
    return (t - 32) * 256 + r;
}
template <int K, int N, int ND, int MODE, bool Q8 = false, bool KP = false> __device__ __forceinline__ void cvt_weights(const Frame& F, const float* W, const float* gain, bf16* dst) {
    constexpr int nbn = ND / 64, nwitems = (K / 512) * nbn;
    static_assert(K % 512 == 0, "8 k blocks per workgroup item");
    for (int wit = F.vcu; wit < nwitems; wit += F.G) {
        const int kg = wit / nbn, nb = wit - kg * nbn, kb = kg * 8 + F.wave, k0 = kb * 64, nd = nb * 64 + F.lane;
        const int c = cvt_src_col<MODE, N>(nd);
        float v[64];
        const float* p = W + (size_t)(KP ? ((k0 & ~127) + ((k0 & 64) >> 2)) : k0) * N + (c >= 0 ? c : 0);
#pragma unroll
        for (int q = 0; q < 8; ++q) {
            const float* pq = p + (size_t)q * (KP ? 2 : 8) * N; asm volatile("" : "+v"(pq));
#pragma unroll
            for (int i = 0; i < 8; ++i) v[8 * q + i] = __builtin_nontemporal_load(pq + (size_t)(KP ? ((i & 3) * 32 + (i >> 2)) : i) * N); }
        if (MODE == 0 && ND != N) { if (c < 0) {
#pragma unroll
            for (int i = 0; i < 64; ++i) v[i] = 0.f; } }
        if (gain) { const int gvb = __builtin_bit_cast(int, gain[k0 + F.lane]);
#pragma unroll
            for (int i = 0; i < 64; ++i) v[i] *= __builtin_bit_cast(float, __builtin_amdgcn_readlane(gvb, i)); }
        if constexpr (Q8) {
            GAS v4u* o8 = (GAS v4u*)((unsigned char*)dst + (size_t)nd * K + k0);
#pragma unroll
            for (int q = 0; q < 4; ++q) { v4u w; w.x = pg8::pk4f8(v[16 * q], v[16 * q + 1], v[16 * q + 2], v[16 * q + 3], pg8::F8_WS); w.y = pg8::pk4f8(v[16 * q + 4], v[16 * q + 5], v[16 * q + 6], v[16 * q + 7], pg8::F8_WS);
                w.z = pg8::pk4f8(v[16 * q + 8], v[16 * q + 9], v[16 * q + 10], v[16 * q + 11], pg8::F8_WS); w.w = pg8::pk4f8(v[16 * q + 12], v[16 * q + 13], v[16 * q + 14], v[16 * q + 15], pg8::F8_WS); o8[q] = w; }
            continue; }
        GAS v4u* o = (GAS v4u*)(dst + (size_t)nd * K + k0);
#pragma unroll
        for (int q = 0; q < 8; ++q) { v4u w; w.x = pkbf(v[8 * q], v[8 * q + 1]); w.y = pkbf(v[8 * q + 2], v[8 * q + 3]); w.z = pkbf(v[8 * q + 4], v[8 * q + 5]); w.w = pkbf(v[8 * q + 6], v[8 * q + 7]); o[q] = w; }
    }
}
#define CVT_FFN_IN(kp, widx, gidx, L, dst, Q8)  cvt_weights<D, 2 * FF, 2 * FF, 1, Q8>(F, ARG_IN(kp, widx) + (size_t)(L) * D * 2 * FF, ARG_IN(kp, gidx) + (L) * D, dst)
#define CVT_FFN_OUT(kp, widx, L, dst, Q8)   cvt_weights<FF, D, D, 0, Q8>(F, ARG_IN(kp, widx) + (size_t)(L) * FF * D, nullptr, dst)
#define CVT_MIX_IN(kp, kind, L, jj, dst) do { const float* g_ = ARG_IN(kp, 3) + (L) * D; \
        if ((kind) == 0) cvt_weights<D, GDN_N, GDN_NP, 0>(F, ARG_IN(kp, 9) + (size_t)(jj) * D * GDN_N, g_, dst); \
        else if ((kind) == 1) cvt_weights<D, 3 * D, 3 * D, 2>(F, ARG_IN(kp, 15), g_, dst); \
        else cvt_weights<D, 3 * D, 3 * D, 0>(F, ARG_IN(kp, 18), g_, dst); } while (0)
#define CVT_MIX_OUT(kp, widx, jj, dst, KP)  cvt_weights<D, D, D, 0, false, KP>(F, ARG_IN(kp, widx) + (size_t)(jj) * D * D, nullptr, dst)
__device__ __forceinline__ void p0_rows(const Frame& F, const float* x, bf16* xb, unsigned long long* rowss) {
    for (int row = F.gw; row < M; row += F.NGW) {
        const GAS f32x4* xr = (const GAS f32x4*)(x + (size_t)row * D) + F.lane;
        GAS v2u* o8 = (GAS v2u*)(xb + (size_t)row * D) + F.lane;
        f32x4 v[16]; float s = 0.f;
#pragma unroll
        for (int j = 0; j < 16; ++j) { v[j] = __builtin_nontemporal_load(xr + 64 * j); s += (v[j].x * v[j].x + v[j].y * v[j].y) + (v[j].z * v[j].z + v[j].w * v[j].w); }
#pragma unroll
        for (int j = 0; j < 16; ++j) { v2u w; w.x = pkbf(v[j].x, v[j].y); w.y = pkbf(v[j].z, v[j].w); o8[64 * j] = w; }
        s = wave_sum(s);
        if (F.lane == 0) rowss[row] = (unsigned long long)(s * 16777216.0f + 0.5f);
    }
}
__device__ __forceinline__ void sc_conv(const Frame& F, const bf16* U, const bf16* GB, const float* cw, bf16* A2) {
    for (int unit = F.gw; unit < (M / 64) * 8; unit += F.NGW) {
        const int rc = unit >> 3, cs = unit & 7, r0 = rc * 64, c0 = cs * 512 + F.lane * 8;
        float w0[8], w1[8], w2[8];
#pragma unroll
        for (int j = 0; j < 8; ++j) { w0[j] = cw[c0 + j]; w1[j] = cw[D + c0 + j]; w2[j] = cw[2 * D + c0 + j]; }
        v4u p2 = {0u, 0u, 0u, 0u}, p1 = {0u, 0u, 0u, 0u};
        if ((r0 % SEQ) != 0) { p2 = *(const GAS v4u*)(U + (size_t)(r0 - 2) * D + c0); p1 = *(const GAS v4u*)(U + (size_t)(r0 - 1) * D + c0); }
#pragma unroll 4
        for (int r = 0; r < 64; ++r) {
            const size_t off = (size_t)(r0 + r) * D + c0;
            const v4u cu = __builtin_nontemporal_load((const GAS v4u*)(U + off)), g = __builtin_nontemporal_load((const GAS v4u*)(GB + off));
            v4u o;
#pragma unroll
            for (int q = 0; q < 4; ++q) {
                const float lo = bflo(g[q]) * (w0[2 * q] * bflo(p2[q]) + w1[2 * q] * bflo(p1[q]) + w2[2 * q] * bflo(cu[q]));
                const float hi = bfhi(g[q]) * (w0[2 * q + 1] * bfhi(p2[q]) + w1[2 * q + 1] * bfhi(p1[q]) + w2[2 * q + 1] * bfhi(cu[q]));
                o[q] = pkbf(lo, hi); }
            *(GAS v4u*)(A2 + off) = o;
            p2 = p1; p1 = cu;
        }
    }
}
constexpr int MB_BLK = 256, MB_NB = SEQ / MB_BLK, MB_TOPK = 3;
__device__ __forceinline__ void rope_table(const Frame& F, const int* pos, float* tab) {
    for (int i = F.gw * 64 + F.lane; i < M * 64; i += F.NGW * 64) {
        const int row = i >> 6, fi = i & 63;
        const double inv = exp2(-(double)fi * (13.287712379549449 / 64.0));
        const double ang = (double)pos[row] * inv; double s, c; sincos(ang, &s, &c);
        tab[i] = (float)c; tab[(size_t)M * 64 + i] = (float)s;
    }
}
__device__ __forceinline__ void moba_prep(const Frame& F, const bf16* PROJ, const float* qg, const float* kg, const float* rope, bf16* Qh, bf16* Kh, float* kmean) {
    LAS float* red = (LAS float*)(F.lds + RING_OFF);
    const int l5 = F.lane & 31, tp = F.lane >> 5;
    const float gq0 = qg[2 * l5], gq1 = qg[2 * l5 + 1], gq2 = qg[64 + 2 * l5], gq3 = qg[65 + 2 * l5];
    const float gk0 = kg[2 * l5], gk1 = kg[2 * l5 + 1], gk2 = kg[64 + 2 * l5], gk3 = kg[65 + 2 * l5];
    for (int unit = F.vcu; unit < BATCH * NH * MB_NB; unit += F.G) {
        const int blk = unit % MB_NB, h = (unit / MB_NB) % NH, b = unit / (MB_NB * NH);
        float ks0 = 0.f, ks1 = 0.f, ks2 = 0.f, ks3 = 0.f;
#pragma unroll 1
        for (int ib = 0; ib < 16; ib += 8) {
            unsigned lqa[8], lqb[8], lka[8], lkb[8]; float lc0[8], lc1[8], ls0[8], ls1[8];
#pragma unroll
            for (int t = 0; t < 8; ++t) {
                const int s = blk * MB_BLK + F.wave * 32 + (ib + t) * 2 + tp; const size_t row = (size_t)b * SEQ + s;
                const bf16* pq = PROJ + row * (3 * D) + h * HD; const bf16* pk = pq + D;
                lqa[t] = __builtin_nontemporal_load((const GAS unsigned*)(pq + 2 * l5)); lqb[t] = __builtin_nontemporal_load((const GAS unsigned*)(pq + 64 + 2 * l5));
                lka[t] = __builtin_nontemporal_load((const GAS unsigned*)(pk + 2 * l5)); lkb[t] = __builtin_nontemporal_load((const GAS unsigned*)(pk + 64 + 2 * l5));
                lc0[t] = rope[row * 64 + 2 * l5]; lc1[t] = rope[row * 64 + 2 * l5 + 1]; ls0[t] = rope[(size_t)M * 64 + row * 64 + 2 * l5]; ls1[t] = rope[(size_t)M * 64 + row * 64 + 2 * l5 + 1];
            }
#pragma unroll
            for (int t = 0; t < 8; ++t) {
                const int s = blk * MB_BLK + F.wave * 32 + (ib + t) * 2 + tp;
                const unsigned qa = lqa[t], qb = lqb[t], ka = lka[t], kb = lkb[t];
                const float c0 = lc0[t], c1 = lc1[t], s0 = ls0[t], s1 = ls1[t];
                float q0 = bflo(qa), q1 = bfhi(qa), q2 = bflo(qb), q3 = bfhi(qb), k0 = bflo(ka), k1 = bfhi(ka), k2 = bflo(kb), k3 = bfhi(kb);
                float sq = (q0 * q0 + q1 * q1) + (q2 * q2 + q3 * q3), sk = (k0 * k0 + k1 * k1) + (k2 * k2 + k3 * k3);
                sq = row16_sum_dpp(sq); sk = row16_sum_dpp(sk); sq += __shfl_xor(sq, 16); sk += __shfl_xor(sk, 16);
                const float rq = 1.0f / sqrtf(sq * (1.0f / 128.0f) + 1e-6f), rk = 1.0f / sqrtf(sk * (1.0f / 128.0f) + 1e-6f);
                q0 *= rq * gq0; q1 *= rq * gq1; q2 *= rq * gq2; q3 *= rq * gq3; k0 *= rk * gk0; k1 *= rk * gk1; k2 *= rk * gk2; k3 *= rk * gk3;
                const float qo0 = q0 * c0 - q2 * s0, qo1 = q1 * c1 - q3 * s1, qo2 = q2 * c0 + q0 * s0, qo3 = q3 * c1 + q1 * s1;
                const float ko0 = k0 * c0 - k2 * s0, ko1 = k1 * c1 - k3 * s1, ko2 = k2 * c0 + k0 * s0, ko3 = k3 * c1 + k1 * s1;
                const size_t ho = ((size_t)(b * NH + h) * SEQ + s) * HD;
                *(GAS unsigned*)(Qh + ho + 2 * l5) = pkbf(qo0, qo1); *(GAS unsigned*)(Qh + ho + 64 + 2 * l5) = pkbf(qo2, qo3);
                *(GAS unsigned*)(Kh + ho + 2 * l5) = pkbf(ko0, ko1); *(GAS unsigned*)(Kh + ho + 64 + 2 * l5) = pkbf(ko2, ko3);
                ks0 += ko0; ks1 += ko1; ks2 += ko2; ks3 += ko3;
            }
        }
        ks0 += __shfl_xor(ks0, 32); ks1 += __shfl_xor(ks1, 32); ks2 += __shfl_xor(ks2, 32); ks3 += __shfl_xor(ks3, 32);
        if (tp == 0) { red[F.wave * 128 + 2 * l5] = ks0; red[F.wave * 128 + 2 * l5 + 1] = ks1; red[F.wave * 128 + 64 + 2 * l5] = ks2; red[F.wave * 128 + 65 + 2 * l5] = ks3; }
        __syncthreads();
        if (F.tid < 128) { float a = 0.f;
#pragma unroll
            for (int w = 0; w < 8; ++w) a += red[w * 128 + F.tid];
            kmean[((size_t)(b * NH + h) * MB_NB + blk) * HD + F.tid] = a * (1.0f / 256.0f); }
        __syncthreads();
    }
}
__device__ __forceinline__ void moba_select(const Frame& F, const bf16* Qh, const float* kmean, unsigned* sel, float* LSE) {
    LAS float* km = (LAS float*)(F.lds + RING_OFF);
    for (int unit = F.vcu; unit < BATCH * NH * (SEQ / 512); unit += F.G) {
        const int part = unit % (SEQ / 512), bh = unit / (SEQ / 512);
        __syncthreads();
        for (int i = F.tid; i < MB_NB * HD; i += NWAVES * 64) km[i] = kmean[(size_t)bh * MB_NB * HD + i];
        __syncthreads();
        const int s = part * 512 + F.wave * 64 + F.lane, qblk = (part * 512 + F.wave * 64) / MB_BLK;
        const GAS v4u* qp = (const GAS v4u*)(Qh + ((size_t)bh * SEQ + s) * HD);
        v4u qv[16];
#pragma unroll
        for (int i = 0; i < 16; ++i) qv[i] = qp[i];
        float v0 = -INFINITY, v1 = -INFINITY, v2 = -INFINITY; int i0 = -1, i1 = -1, i2 = -1;
        for (int n = 0; n < qblk; ++n) {
            const LAS f32x4* kr = (const LAS f32x4*)(km + n * HD);
            float a0 = 0.f, a1 = 0.f;
#pragma unroll
            for (int i = 0; i < 16; ++i) { const f32x4 ka = kr[2 * i], kb = kr[2 * i + 1];
                a0 += bflo(qv[i].x) * ka.x + bfhi(qv[i].x) * ka.y; a1 += bflo(qv[i].y) * ka.z + bfhi(qv[i].y) * ka.w;
                a0 += bflo(qv[i].z) * kb.x + bfhi(qv[i].z) * kb.y; a1 += bflo(qv[i].w) * kb.z + bfhi(qv[i].w) * kb.w; }
            const float x = a0 + a1;
            if (x > v0) { v2 = v1; i2 = i1; v1 = v0; i1 = i0; v0 = x; i0 = n; }
            else if (x > v1) { v2 = v1; i2 = i1; v1 = x; i1 = n; }
            else if (x > v2) { v2 = x; i2 = n; }
        }
        unsigned mask = 0u;
        if (i0 >= 0) mask |= 1u << i0; if (i1 >= 0) mask |= 1u << i1; if (i2 >= 0) mask |= 1u << i2;
        sel[(size_t)bh * SEQ + s] = mask;
        { const float ninf = -INFINITY; float* lp = LSE + ((size_t)bh * SEQ + s) * 4; lp[0] = ninf; lp[1] = ninf; lp[2] = ninf; }
    }
}
__device__ __forceinline__ void moba_attn_naive(const Frame& F, const bf16* Qh, const bf16* Kh, const bf16* PROJ, const unsigned* sel, bf16* O) {
    const float scale = 0.08838834764831845f;
    for (int qi = F.gw; qi < BATCH * NH * SEQ; qi += F.NGW) {
        const int s = qi % SEQ, bh = qi / SEQ, b = bh / NH, h = bh % NH, qblk = s / MB_BLK;
        const GAS v4u* qp = (const GAS v4u*)(Qh + ((size_t)bh * SEQ + s) * HD);
        v4u qv[16];
#pragma unroll
        for (int i = 0; i < 16; ++i) qv[i] = qp[i];
        const unsigned mask = sel[(size_t)bh * SEQ + s] | (1u << qblk);
        float m = -1e30f, l = 0.f, o0 = 0.f, o1 = 0.f;
        for (int j = 0; j <= qblk; ++j) {
            if (!((mask >> j) & 1u)) continue;
            for (int t = 0; t < 4; ++t) {
                const int key0 = j * MB_BLK + t * 64; if (key0 > s) break;
                const int key = key0 + F.lane;
                const GAS v4u* kp = (const GAS v4u*)(Kh + ((size_t)bh * SEQ + key) * HD);
                float a0 = 0.f, a1 = 0.f;
#pragma unroll
                for (int i = 0; i < 16; ++i) { const v4u kv = kp[i];
                    a0 += bflo(qv[i].x) * bflo(kv.x) + bfhi(qv[i].x) * bfhi(kv.x); a1 += bflo(qv[i].y) * bflo(kv.y) + bfhi(qv[i].y) * bfhi(kv.y);
                    a0 += bflo(qv[i].z) * bflo(kv.z) + bfhi(qv[i].z) * bfhi(kv.z); a1 += bflo(qv[i].w) * bflo(kv.w) + bfhi(qv[i].w) * bfhi(kv.w); }
                float sc = (a0 + a1) * scale; if (key > s) sc = -INFINITY;
                float tm = sc;
#pragma unroll
                for (int o = 1; o < 64; o <<= 1) tm = fmaxf(tm, __shfl_xor(tm, o));
                const float mn = fmaxf(m, tm), alpha = __expf(m - mn), p = __expf(sc - mn);
                const float ps = wave_sum(p);
                l = l * alpha + ps; o0 *= alpha; o1 *= alpha; m = mn;
                const bf16* vp = PROJ + ((size_t)b * SEQ + key0) * (3 * D) + 2 * D + h * HD + 2 * F.lane;
#pragma unroll 8
                for (int kk = 0; kk < 64; ++kk) { const float pk = __shfl(p, kk); const unsigned vv = *(const GAS unsigned*)(vp + (size_t)kk * (3 * D)); o0 += pk * bflo(vv); o1 += pk * bfhi(vv); }
            }
        }
        const float il = 1.0f / l;
        *(GAS unsigned*)(O + ((size_t)b * SEQ + s) * D + h * HD + 2 * F.lane) = pkbf(o0 * il, o1 * il);
    }
}
#include <hip/hip_bf16.h>
namespace mattn {
constexpr int D = 128, LDV = 3 * 4096;
constexpr float THR = 8.f;
constexpr bool WSKIP = false;
constexpr float SCALE = 0.08838834764831845f;
constexpr int NW = 8, QBLK = 32, KVBLK = 64, QB = NW * QBLK;
constexpr int SHM_V = KVBLK * D * 2, SHM_K = KVBLK * D * 2;
constexpr int LDS_TAB = 2 * SHM_V + 2 * SHM_K + NW * 64 * 4;
constexpr int LDS_BYTES = LDS_TAB + NW * 32 * 4 + 64;
using bf16 = __hip_bfloat16;
typedef short bf16x8 __attribute__((ext_vector_type(8)));
typedef short s16x4 __attribute__((ext_vector_type(4)));
typedef float f32x16 __attribute__((ext_vector_type(16)));
typedef float f32x4 __attribute__((ext_vector_type(4)));
typedef unsigned u32x4 __attribute__((ext_vector_type(4)));
template <class A, class Bt> struct same_t { static constexpr bool v = false; };
template <class A> struct same_t<A, A> { static constexpr bool v = true; };

#define KSWZ(row, colB) ((row) * 256 + ((colB) ^ (((row) & 7) << 4)))
#define SBAR() __builtin_amdgcn_sched_barrier(0)
__device__ __forceinline__ int v_st(int k, int c) { const int kk = (k & ~0xC) | ((k & 4) << 1) | ((k & 8) >> 1); return ((kk >> 3) * 4 + (c >> 5)) * 512 + ((kk & 7) * 32 + (c & 31)) * 2; }
__device__ __forceinline__ int v_rd_base(int lane) { return ((lane & 3) << 3) | (((lane >> 2) & 3) << 6) | (((lane >> 4) & 1) << 5) | (((lane >> 5) & 1) << 8); }
constexpr int v_rd_off(int d0, int ks, int half) { return d0 * 512 + ks * 4096 + half * 2048; }
__device__ __forceinline__ int crow(int r, int hi) { return (r & 3) + 8 * (r >> 2) + 4 * hi; }
__device__ __forceinline__ unsigned cvtpk(float lo, float hi) {
    unsigned r; asm volatile("v_cvt_pk_bf16_f32 %0, %1, %2" : "=v"(r) : "v"(lo), "v"(hi)); return r;
}
__device__ __forceinline__ bf16x8 pack8(f32x4 a, f32x4 b) {
    u32x4 w = {cvtpk(a[0], a[1]), cvtpk(a[2], a[3]), cvtpk(b[0], b[1]), cvtpk(b[2], b[3])};
    return *reinterpret_cast<bf16x8*>(&w);
}
template <class T> __device__ __forceinline__ bf16x8 load8(const T* p) {
    if constexpr (same_t<T, float>::v) { return pack8(*(const f32x4*)p, *(const f32x4*)(p + 4)); }
    else { return *reinterpret_cast<const bf16x8*>(p); }
}
__device__ __forceinline__ void mask_tile(f32x16& p0, f32x16& p1, int dq, unsigned W) {
    const float NEG = -__builtin_inff();
#pragma unroll
    for (int r = 0; r < 16; ++r) {
        const int c = (r & 3) + 8 * (r >> 2);
        if ((unsigned)(dq - c) >= W) p0[r] = NEG;
        if ((unsigned)(dq - c - 32) >= W) p1[r] = NEG;
    }
}
__device__ __forceinline__ void partialSM(f32x16& p0, f32x16& p1, float& m_reg, float& mn, float& alpha) {
    float pmax = p0[0]; for (int r = 1; r < 16; ++r) pmax = fmaxf(pmax, p0[r]); for (int r = 0; r < 16; ++r) pmax = fmaxf(pmax, p1[r]);
    { auto rr = __builtin_amdgcn_permlane32_swap(__float_as_uint(pmax), __float_as_uint(pmax), false, false);
      pmax = fmaxf(__uint_as_float(rr[0]), __uint_as_float(rr[1])); }
    constexpr float C2 = 1.4426950408889634f * SCALE;
    if (__builtin_expect(__all((pmax - m_reg) * SCALE <= THR), 1)) { mn = m_reg; alpha = 1.f; }
    else { mn = fmaxf(m_reg, pmax); alpha = __builtin_amdgcn_exp2f((m_reg - mn) * C2); m_reg = mn; }
    const float mnL = -mn * C2;
    for (int r = 0; r < 16; ++r) p0[r] = fmaf(p0[r], C2, mnL); for (int r = 0; r < 16; ++r) p1[r] = fmaf(p1[r], C2, mnL);
    for (int r = 0; r < 16; ++r) p0[r] = __builtin_amdgcn_exp2f(p0[r]);
}
__device__ __forceinline__ void finishSM(f32x16& p0, f32x16& p1, float alpha, float& l_reg, bf16x8& pa0, bf16x8& pa1, bf16x8& pa2, bf16x8& pa3) {
    for (int r = 0; r < 16; ++r) p1[r] = __builtin_amdgcn_exp2f(p1[r]);
    float ps = 0; for (int r = 0; r < 16; ++r) ps += p0[r]; for (int r = 0; r < 16; ++r) ps += p1[r];
    { auto rr = __builtin_amdgcn_permlane32_swap(__float_as_uint(ps), __float_as_uint(ps), false, false);
      ps = __uint_as_float(rr[0]) + __uint_as_float(rr[1]); }
    l_reg = l_reg * alpha + ps;
#define PK4(P, B_, OUT) do { unsigned a0 = cvtpk(P[B_+0], P[B_+1]), a1 = cvtpk(P[B_+2], P[B_+3]);                          \
        unsigned b0 = cvtpk(P[B_+4], P[B_+5]), b1 = cvtpk(P[B_+6], P[B_+7]);                                             \
        auto r0 = __builtin_amdgcn_permlane32_swap(a0, b0, false, false); auto r1 = __builtin_amdgcn_permlane32_swap(a1, b1, false, false); \
        u32x4 w = {r0[0], r1[0], r0[1], r1[1]}; OUT = *reinterpret_cast<bf16x8*>(&w); } while (0)
    PK4(p0, 0, pa0); PK4(p0, 8, pa1); PK4(p1, 0, pa2); PK4(p1, 8, pa3);
#undef PK4
}
template <int KB, bool SK>
__device__ __forceinline__ void qkt(f32x16& p0, f32x16& p1, const char* K_lds, int r32, int hi, const bf16x8* qr, bool act) {
    if (SK && !act) { const float NEG = -__builtin_inff();
#pragma unroll
        for (int r = 0; r < 16; ++r) { p0[r] = NEG; p1[r] = NEG; } return; }
    p0 = f32x16{}; p1 = f32x16{};
    const char* kb[4];
#pragma unroll
    for (int dd = 0; dd < 4; ++dd) kb[dd] = K_lds + KB * SHM_K + KSWZ(r32, (dd * 16 + hi * 8) * 2);
#pragma unroll
    for (int d0 = 0; d0 < 8; ++d0) { const char* a = kb[d0 & 3] + (d0 >> 2) * 128;
        bf16x8 b0 = *reinterpret_cast<const bf16x8*>(a);
        bf16x8 b1 = *reinterpret_cast<const bf16x8*>(a + 32 * 256);
        p0 = __builtin_amdgcn_mfma_f32_32x32x16_bf16(b0, qr[d0], p0, 0, 0, 0);
        p1 = __builtin_amdgcn_mfma_f32_32x32x16_bf16(b1, qr[d0], p1, 0, 0, 0); }
}
template <int VB, bool SK>
__device__ __forceinline__ void pv_tile(f32x16* o, int vb0, bf16x8 pa0, bf16x8 pa1, bf16x8 pa2, bf16x8 pa3, bool act) {
    if (SK && !act) return;
#define TRRD(dst, off) asm volatile("ds_read_b64_tr_b16 %0, %1 offset:%2" : "=&v"(dst) : "v"(vb0), "i"(off) : "memory")
#define PV_D0(d0) do { s16x4 l0, l1, l2, l3, h0, h1, h2, h3; constexpr int b_ = VB * SHM_V + v_rd_off(d0, 0, 0);     \
        TRRD(l0, b_); TRRD(h0, b_ + 2048); TRRD(l1, b_ + 4096); TRRD(h1, b_ + 6144); TRRD(l2, b_ + 8192); TRRD(h2, b_ + 10240); TRRD(l3, b_ + 12288); TRRD(h3, b_ + 14336); \
        asm volatile("s_waitcnt lgkmcnt(0)" ::: "memory"); SBAR();                 \
        o[d0] = __builtin_amdgcn_mfma_f32_32x32x16_bf16(pa0, (bf16x8){l0[0], l0[1], l0[2], l0[3], h0[0], h0[1], h0[2], h0[3]}, o[d0], 0, 0, 0);   \
        o[d0] = __builtin_amdgcn_mfma_f32_32x32x16_bf16(pa1, (bf16x8){l1[0], l1[1], l1[2], l1[3], h1[0], h1[1], h1[2], h1[3]}, o[d0], 0, 0, 0);   \
        o[d0] = __builtin_amdgcn_mfma_f32_32x32x16_bf16(pa2, (bf16x8){l2[0], l2[1], l2[2], l2[3], h2[0], h2[1], h2[2], h2[3]}, o[d0], 0, 0, 0);   \
        o[d0] = __builtin_amdgcn_mfma_f32_32x32x16_bf16(pa3, (bf16x8){l3[0], l3[1], l3[2], l3[3], h3[0], h3[1], h3[2], h3[3]}, o[d0], 0, 0, 0); } while (0)
    PV_D0(0); PV_D0(1); PV_D0(2); PV_D0(3);
#undef PV_D0
#undef TRRD
}

template <class TIn, class TOut> struct BlockRef { const TIn* Q; const TIn* K; const TIn* V; TOut* O; float* LSE; const unsigned* ROWS; int NR, ROW0, P0; };
template <class R> __device__ __forceinline__ unsigned blk_entry(const R& b, int idx) { return b.ROWS ? (idx < b.NR ? b.ROWS[idx] : 0xffffffffu) : ((unsigned)(b.ROW0 + idx) | (3u << 16)); }
template <class TIn> struct Seam {
    bf16x8 qr[8];
    unsigned ecur;
    bf16x8 st_v0, st_v1, st_k0, st_k1; f32x4 sf0, sf1, sf2, sf3;
    f32x4 tq[16];
};
__device__ __forceinline__ int swa_jlo(int P0, int W) { const int lowk = P0 - W + 1; return lowk > 0 ? lowk / KVBLK : 0; }
#define ROW(p, k0, rr) ((p) + (size_t)((k0) + (rr)) * D + sc)
#define ROWV(p, k0, rr) ((p) + (size_t)((k0) + (rr)) * LDV + sc)
#define VMW() asm volatile("s_waitcnt vmcnt(0)" ::: "memory")
#define VMWN(n) asm volatile("s_waitcnt vmcnt(%0)" :: "i"(n) : "memory")
#define SLOAD_H(Kp, Vp, k0) do { S.st_v0 = load8<TIn>(ROWV(Vp, k0, sr)); S.st_v1 = load8<TIn>(ROWV(Vp, k0, 32 + sr));              \
                         S.st_k0 = load8<TIn>(ROW(Kp, k0, sr)); S.st_k1 = load8<TIn>(ROW(Kp, k0, 32 + sr)); } while (0)
#define SWRITE_HK(bf) do { *(bf16x8*)(K_lds + (bf) * SHM_K + kws) = S.st_k0; *(bf16x8*)(K_lds + (bf) * SHM_K + kws + 32 * 256) = S.st_k1; } while (0)
#define SWRITE_HV(bf) do { *(bf16x8*)(V_lds + (bf) * SHM_V + vst0) = S.st_v0; *(bf16x8*)(V_lds + (bf) * SHM_V + vst1) = S.st_v1; } while (0)
#define SWRITE_H(bf) do { SWRITE_HV(bf); SWRITE_HK(bf); } while (0)
#define SLOAD_F(p, k0) do { S.sf0 = *(const f32x4*)ROW(p, k0, sr); S.sf1 = *(const f32x4*)(ROW(p, k0, sr) + 4);                \
                            S.sf2 = *(const f32x4*)ROW(p, k0, 32 + sr); S.sf3 = *(const f32x4*)(ROW(p, k0, 32 + sr) + 4); } while (0)
#define SWRITE_KF(bf) do { *(bf16x8*)(K_lds + (bf) * SHM_K + kws) = pack8(S.sf0, S.sf1); *(bf16x8*)(K_lds + (bf) * SHM_K + kws + 32 * 256) = pack8(S.sf2, S.sf3); } while (0)
#define SWRITE_VF(bf) do { *(bf16x8*)(V_lds + (bf) * SHM_V + vst0) = pack8(S.sf0, S.sf1); *(bf16x8*)(V_lds + (bf) * SHM_V + vst1) = pack8(S.sf2, S.sf3); } while (0)
template <class TIn, class TOut>
__device__ __forceinline__ void causal_swa_prime(const BlockRef<TIn, TOut>& cur, int W, char* lds, Seam<TIn>& S) {
    constexpr bool F32 = same_t<TIn, float>::v;
    const int tid = mk_tid(), wid = __builtin_amdgcn_readfirstlane(tid >> 6), lane = tid & 63, r32 = lane & 31, hi = lane >> 5;
    const int sr = tid >> 4, sc = (tid & 15) * 8, kws = KSWZ(sr, sc * 2); char* K_lds = lds + 2 * SHM_V;
    const int kb0 = swa_jlo(cur.P0, W) * KVBLK;
    S.ecur = blk_entry(cur, wid * QBLK + r32);
    { const unsigned qrow = S.ecur == 0xffffffffu ? 0u : (S.ecur & 0xffffu);
      for (int d0 = 0; d0 < 8; ++d0) S.qr[d0] = load8<TIn>(cur.Q + (size_t)qrow * D + d0 * 16 + hi * 8); }
    if constexpr (F32) { SLOAD_F((const float*)cur.K, kb0); VMW(); SWRITE_KF(0); SBAR(); SLOAD_F((const float*)cur.V, kb0); }
    else { SLOAD_H(cur.K, cur.V, kb0); VMW(); SWRITE_HK(0); }
    __syncthreads();
}
template <class TIn, class TOut>
__device__ __forceinline__ void causal_swa_block(const BlockRef<TIn, TOut>& cur, const BlockRef<TIn, TOut>& nxt, int skv, int W, char* lds, Seam<TIn>& S) {
    constexpr bool F32 = same_t<TIn, float>::v;
    const int tid = mk_tid(), wid = __builtin_amdgcn_readfirstlane(tid >> 6), lane = tid & 63, r32 = lane & 31, hi = lane >> 5;
    const int j_lo = swa_jlo(cur.P0, W);
    int j_hi = (cur.P0 + QB - 1) / KVBLK + 1; if (j_hi > skv / KVBLK) j_hi = skv / KVBLK;
    const int NT = j_hi - j_lo;
    const int kbn = swa_jlo(nxt.P0, W) * KVBLK;
    const int qlo = cur.P0 + wid * QBLK, qm = qlo + r32 - 4 * hi;
    char* V_lds = lds; char* K_lds = lds + 2 * SHM_V;
    float* ws = (float*)(lds + 2 * SHM_V + 2 * SHM_K) + wid * 64; float* li_l = ws, * al_l = ws + 32;
    const unsigned enxt = blk_entry(nxt, wid * QBLK + r32);
    float m_reg = -1e30f, l_reg = 0; f32x16 o[4] = {};
    const int sr = tid >> 4, sc = (tid & 15) * 8, vst0 = v_st(sr, sc), vst1 = v_st(32 + sr, sc), kws = KSWZ(sr, sc * 2);
    const int vb0 = (int)(uintptr_t)V_lds + v_rd_base(lane);
    const TIn* Kh = cur.K; const TIn* Vh = cur.V;
#define RESC(a) do { if (__any((a) < 1.f)) { if (hi == 0) al_l[r32] = (a); asm volatile("s_waitcnt lgkmcnt(0)" ::: "memory");              \
                     for (int d_ = 0; d_ < 4; ++d_) for (int r = 0; r < 16; ++r) o[d_][r] *= al_l[crow(r, hi)]; } } while (0)
#define KBASE(t) ((j_lo + (t)) * KVBLK)
#define ACT(t) (KBASE(t) <= qlo + QBLK - 1 && KBASE(t) + KVBLK - 1 >= qlo - W + 1)
#define MASKT(P0_, P1_, t) do { const int kb_ = KBASE(t); if ((!SK || ACT(t)) && (kb_ + KVBLK - 1 > qlo || kb_ <= qlo + QBLK - 1 - W)) mask_tile(P0_, P1_, qm - kb_, (unsigned)W); } while (0)
    constexpr int NQL = F32 ? 16 : 8;
    constexpr bool SK = WSKIP && !F32;
#define SEAM_K0() do { VMWN(NQL); if constexpr (F32) { SWRITE_KF(0); SBAR(); SLOAD_F((const float*)nxt.V, kbn); } else { SWRITE_HK(0); } SBAR(); } while (0)
    f32x16 pA0, pA1, pB0, pB1; float mnA, mnB, alA, alB; bf16x8 pa0, pa1, pa2, pa3;
    if constexpr (F32) { VMW(); SWRITE_VF(0); SBAR(); } else { SWRITE_HV(0); SBAR(); }
    if (NT > 1) { if constexpr (F32) SLOAD_F((const float*)Kh, KBASE(1)); else SLOAD_H(Kh, Vh, KBASE(1)); }
    SBAR(); qkt<0, SK>(pA0, pA1, K_lds, r32, hi, S.qr, ACT(0));
    if constexpr (F32) { if (NT > 1) { VMW(); SWRITE_KF(1); SBAR(); SLOAD_F((const float*)Vh, KBASE(1)); } }
    MASKT(pA0, pA1, 0); partialSM(pA0, pA1, m_reg, mnA, alA);
    if (NT > 1) { VMW(); if constexpr (F32) { SWRITE_VF(1); SBAR(); if (NT > 2) SLOAD_F((const float*)Kh, KBASE(2)); } else SWRITE_H(1); }
    __syncthreads();
#define HALF_STEP(PX0, PX1, mnX, alX, PY0, PY1, alY, t, KB, VB, SB) do {                                                      \
        SBAR(); qkt<KB, SK>(PX0, PX1, K_lds, r32, hi, S.qr, ACT(t));                                             \
        finishSM(PY0, PY1, alY, l_reg, pa0, pa1, pa2, pa3); SBAR();                                                           \
        if ((t) + 1 < NT) { if constexpr (F32) { VMW(); SWRITE_KF(SB); SBAR(); SLOAD_F((const float*)Vh, KBASE((t) + 1)); }  \
                            else { SLOAD_H(Kh, Vh, KBASE((t) + 1)); } SBAR(); }                                               \
        pv_tile<VB, SK>(o, vb0, pa0, pa1, pa2, pa3, ACT((t) - 1)); MASKT(PX0, PX1, (t)); partialSM(PX0, PX1, m_reg, mnX, alX);                                        \
        __syncthreads();                                                                                                      \
        if ((t) + 1 < NT) { VMW(); if constexpr (F32) { SWRITE_VF(SB); SBAR(); if ((t) + 2 < NT) SLOAD_F((const float*)Kh, KBASE((t) + 2)); } \
                            else { SWRITE_H(SB); } }                                                                          \
        RESC(alX); __syncthreads(); } while (0)
    for (int t = 1; t + 1 < NT; t += 2) {
        HALF_STEP(pB0, pB1, mnB, alB, pA0, pA1, alA, t, 1, 0, 0);
        HALF_STEP(pA0, pA1, mnA, alA, pB0, pB1, alB, t + 1, 0, 1, 1);
    }
    {
    int tidz_ = mk_tid(); asm volatile("" : "+v"(tidz_));
    const int tid = tidz_, lane = tid & 63, r32 = lane & 31, hi = lane >> 5;
    const int sr = tid >> 4, sc = (tid & 15) * 8, vst0 = v_st(sr, sc), vst1 = v_st(32 + sr, sc), kws = KSWZ(sr, sc * 2);
    const int vb0 = (int)(uintptr_t)V_lds + v_rd_base(lane);
    (void)vst0; (void)vst1; (void)kws; (void)vb0; (void)lane;
    const bool even = (NT & 1) == 0;
    if (even) { SBAR(); qkt<1, SK>(pB0, pB1, K_lds, r32, hi, S.qr, ACT(NT - 1)); SBAR(); }
#define QROW(e) (nxt.Q + (size_t)(wid * QBLK + r32) * D + ((e) >> 1) * 16 + hi * 8 + ((e) & 1) * 4)
    if constexpr (F32) { SLOAD_F((const float*)nxt.K, kbn); SBAR();
#pragma unroll
        for (int e = 0; e < 8; ++e) S.tq[e] = *(const f32x4*)QROW(e); }
    else { SLOAD_H(nxt.K, nxt.V, kbn); SBAR();
#pragma unroll
        for (int d0 = 0; d0 < 8; ++d0) S.qr[d0] = load8<TIn>(nxt.Q + (size_t)(enxt == 0xffffffffu ? 0u : (enxt & 0xffffu)) * D + d0 * 16 + hi * 8); }
    SBAR();
    finishSM(pA0, pA1, alA, l_reg, pa0, pa1, pa2, pa3); SBAR();
    if constexpr (F32) {
#pragma unroll
        for (int e = 8; e < 16; ++e) S.tq[e] = *(const f32x4*)QROW(e); SBAR(); }
#undef QROW
    pv_tile<0, SK>(o, vb0, pa0, pa1, pa2, pa3, ACT(even ? NT - 2 : NT - 1));
    if (even) { MASKT(pB0, pB1, NT - 1); partialSM(pB0, pB1, m_reg, mnB, alB); __syncthreads(); RESC(alB);
        finishSM(pB0, pB1, alB, l_reg, pa0, pa1, pa2, pa3); SBAR(); pv_tile<1, SK>(o, vb0, pa0, pa1, pa2, pa3, ACT(NT - 1)); }
    SBAR(); SEAM_K0();
    unsigned* tabE = (unsigned*)(lds + LDS_TAB) + wid * 32;
    if (hi == 0) { li_l[r32] = l_reg; tabE[r32] = S.ecur;
        if (S.ecur != 0xffffffffu) cur.LSE[(size_t)(S.ecur & 0xffffu) * 4 + ((S.ecur >> 16) & 3u)] = m_reg * SCALE + __logf(l_reg); }
    asm volatile("s_waitcnt lgkmcnt(0)" ::: "memory");
    float rli[16];
#pragma unroll
    for (int r = 0; r < 16; ++r) rli[r] = __builtin_amdgcn_rcpf(li_l[crow(r, hi)]);
#pragma unroll
    for (int r = 0; r < 16; ++r) { const unsigned e = tabE[crow(r, hi)]; const bool ok = e != 0xffffffffu;
        TOut* orow_p = cur.O + ((size_t)(e & 0xffffu) * 4 + ((e >> 16) & 3u)) * D;
#pragma unroll
        for (int d0 = 0; d0 < 4; ++d0) { const float v = o[d0][r] * rli[r];
            const float vn = __shfl_xor(v, 1);
            if (ok && (r32 & 1) == 0) *(unsigned*)(orow_p + d0 * 32 + r32) = cvtpk(v, vn); } }
    S.ecur = enxt;
    if constexpr (F32) {
#pragma unroll
        for (int d0 = 0; d0 < 8; ++d0) S.qr[d0] = pack8(S.tq[2 * d0], S.tq[2 * d0 + 1]); }
    }
    __syncthreads();
#undef RESC
#undef KBASE
#undef ACT
#undef MASKT
#undef SEAM_K0
#undef HALF_STEP
}
#undef ROW
#undef ROWV
#undef VMW
#undef VMWN
#undef SLOAD_H
#undef SWRITE_HK
#undef SWRITE_HV
#undef SWRITE_H
#undef SLOAD_F
#undef SWRITE_KF
#undef SWRITE_VF
}

__device__ __forceinline__ void moba_lists(const Frame& F, const unsigned* SEL, unsigned* LIST, unsigned* CNT, unsigned* qhead) {
    if (F.gw == 0 && F.lane == 0) *qhead = 0u;
    for (int p = F.gw; p < BATCH * NH * MB_NB; p += F.NGW) {
        const int j = p % MB_NB, bh = p / MB_NB;
        unsigned cnt = 0u;
        for (int qb = j + 1; qb < MB_NB; ++qb)
#pragma unroll
            for (int g = 0; g < 4; ++g) {
                const int s = qb * MB_BLK + g * 64 + F.lane;
                const unsigned m = SEL[(size_t)bh * SEQ + s];
                const bool sel = ((m >> j) & 1u) != 0u;
                const unsigned long long bal = __ballot(sel);
                const unsigned pos = cnt + (unsigned)__popcll(bal & ((1ull << F.lane) - 1ull));
                if (sel) LIST[((size_t)bh * MB_NB + j) * SEQ + pos] = (unsigned)s | ((unsigned)__popc(m & ((1u << j) - 1u)) << 16);
                cnt += (unsigned)__popcll(bal);
            }
        if (F.lane == 0) CNT[bh * MB_NB + j] = cnt;
    }
}
namespace mattn {
constexpr int W_LDS_V = 0, W_LDS_K = 4 * SHM_V, W_LDS_WS = 4 * SHM_V + 4 * SHM_K, W_LDS_TAB = W_LDS_WS + NW * 64 * 4, W_LDS_Q = W_LDS_TAB + NW * 32 * 4, W_LDS_BYTES = W_LDS_Q + 64;
template <int T> __device__ __forceinline__ void wave_tile(f32x16 (&o)[4], float& m_reg, float& l_reg, const bf16x8 (&qr)[8], const char* K_lds, int vb0, float* al_l, int r32, int hi, bool causal, int dq0) {
    f32x16 p0, p1; float mn, alpha; bf16x8 pa0, pa1, pa2, pa3;
    qkt<T, false>(p0, p1, K_lds, r32, hi, qr, true);
    if (causal) mask_tile(p0, p1, dq0 - T * KVBLK, 1u << 30);
    partialSM(p0, p1, m_reg, mn, alpha);
    if (__any(alpha < 1.f)) { if (hi == 0) al_l[r32] = alpha; asm volatile("s_waitcnt lgkmcnt(0)" ::: "memory");
#pragma unroll
        for (int d_ = 0; d_ < 4; ++d_)
#pragma unroll
            for (int r = 0; r < 16; ++r) o[d_][r] *= al_l[crow(r, hi)]; }
    finishSM(p0, p1, alpha, l_reg, pa0, pa1, pa2, pa3); SBAR();
    pv_tile<T, false>(o, vb0, pa0, pa1, pa2, pa3, true);
}
}
__device__ __forceinline__ void moba_attn_sparse(const Frame& F, char* lds, const bf16* Qh, const bf16* Kh, const bf16* PROJ, const unsigned* LIST, const unsigned* CNT, bf16* OPART, float* LSE, unsigned* qhead) {
    using namespace mattn;
    using T = mattn::bf16;
    constexpr int NPAIR = (MB_NB - 1) * BATCH * NH, NITEM = NPAIR + BATCH * NH;
    volatile unsigned* qw = (volatile unsigned*)(lds + W_LDS_Q);
    char* V_lds = lds + W_LDS_V; char* K_lds = lds + W_LDS_K;
    for (;;) {
        __syncthreads();
        if (F.tid == 0) *qw = atomicAdd(qhead, 1u);
        __syncthreads();
        const int id = __builtin_amdgcn_readfirstlane((int)*qw);
        if (id >= NITEM) break;
        int bh, blk, cnt;
        if (id < NPAIR) { blk = id / (BATCH * NH); bh = id % (BATCH * NH); cnt = __builtin_amdgcn_readfirstlane((int)CNT[bh * MB_NB + blk]); }
        else { bh = id - NPAIR; blk = MB_NB - 1; cnt = 0; }
        const int b = bh / NH, h = bh % NH;
        int tidz = F.tid; asm volatile("" : "+v"(tidz));
        const int tid = tidz, wid = __builtin_amdgcn_readfirstlane(tid >> 6), lane = tid & 63, r32 = lane & 31, hi = lane >> 5;
        {
            const T* Kp = (const T*)Kh + ((size_t)bh * SEQ + (size_t)blk * MB_BLK) * HD;
            const T* Vp = (const T*)PROJ + ((size_t)b * SEQ + (size_t)blk * MB_BLK) * (3 * ::D) + 2 * ::D + h * HD;
            const int sr = tid >> 4, sc = (tid & 15) * 8, vst0 = v_st(sr, sc), vst1 = v_st(32 + sr, sc), kws = KSWZ(sr, sc * 2);
            bf16x8 k0[4], k1[4], v0[4], v1[4];
#pragma unroll
            for (int t = 0; t < 4; ++t) { k0[t] = load8<T>(Kp + (size_t)(64 * t + sr) * HD + sc); k1[t] = load8<T>(Kp + (size_t)(64 * t + 32 + sr) * HD + sc);
                v0[t] = load8<T>(Vp + (size_t)(64 * t + sr) * LDV + sc); v1[t] = load8<T>(Vp + (size_t)(64 * t + 32 + sr) * LDV + sc); }
#pragma unroll
            for (int t = 0; t < 4; ++t) { *(bf16x8*)(K_lds + t * SHM_K + kws) = k0[t]; *(bf16x8*)(K_lds + t * SHM_K + kws + 32 * 256) = k1[t];
                *(bf16x8*)(V_lds + t * SHM_V + vst0) = v0[t]; *(bf16x8*)(V_lds + t * SHM_V + vst1) = v1[t]; }
        }
        __syncthreads();
        const int ng_g = (cnt + 31) >> 5, ngroups = ng_g + MB_BLK / 32;
        const unsigned* rows = LIST + ((size_t)bh * MB_NB + blk) * SEQ;
        const T* Qb = (const T*)Qh + (size_t)bh * SEQ * HD; T* Ob = (T*)OPART + (size_t)bh * SEQ * 4 * HD; float* Lb = LSE + (size_t)bh * SEQ * 4;
        float* al_l = (float*)(lds + W_LDS_WS) + wid * 64 + 32; float* li_l = (float*)(lds + W_LDS_WS) + wid * 64; unsigned* tabE = (unsigned*)(lds + W_LDS_TAB) + wid * 32;
        const int vb0 = (int)(uintptr_t)V_lds + v_rd_base(lane);
        for (int g = wid; g < ngroups; g += NW) {
            const bool own = g >= ng_g;
            const int idx = (own ? g - ng_g : g) * 32 + r32;
            const unsigned e = own ? ((unsigned)(blk * MB_BLK + idx) | (3u << 16)) : (idx < cnt ? rows[idx] : 0xffffffffu);
            const unsigned qrow = e == 0xffffffffu ? 0u : (e & 0xffffu);
            bf16x8 qr[8];
#pragma unroll
            for (int d0 = 0; d0 < 8; ++d0) qr[d0] = load8<T>(Qb + (size_t)qrow * HD + d0 * 16 + hi * 8);
            float m_reg = -1e30f, l_reg = 0.f; f32x16 o[4] = {};
            const int dq0 = idx - 4 * hi;
            wave_tile<0>(o, m_reg, l_reg, qr, K_lds, vb0, al_l, r32, hi, own, dq0);
            wave_tile<1>(o, m_reg, l_reg, qr, K_lds, vb0, al_l, r32, hi, own, dq0);
            wave_tile<2>(o, m_reg, l_reg, qr, K_lds, vb0, al_l, r32, hi, own, dq0);
            wave_tile<3>(o, m_reg, l_reg, qr, K_lds, vb0, al_l, r32, hi, own, dq0);
            if (hi == 0) { li_l[r32] = l_reg; tabE[r32] = e;
                if (e != 0xffffffffu) Lb[(size_t)(e & 0xffffu) * 4 + ((e >> 16) & 3u)] = m_reg * SCALE + __logf(l_reg); }
            asm volatile("s_waitcnt lgkmcnt(0)" ::: "memory");
#pragma unroll
            for (int r = 0; r < 16; ++r) { const unsigned er = tabE[crow(r, hi)]; const bool ok = er != 0xffffffffu; const float rl = __builtin_amdgcn_rcpf(li_l[crow(r, hi)]);
                T* orow_p = Ob + ((size_t)(er & 0xffffu) * 4 + ((er >> 16) & 3u)) * HD;
                if (ok) { uint2 w; w.x = cvtpk(o[0][r] * rl, o[1][r] * rl); w.y = cvtpk(o[2][r] * rl, o[3][r] * rl); *(uint2*)(orow_p + 4 * r32) = w; } }
            asm volatile("s_waitcnt lgkmcnt(0)" ::: "memory");
        }
    }
}
__device__ __forceinline__ void moba_combine(const Frame& F, const bf16* OPART, const float* LSE, bf16* AO) {
    constexpr int RB = 8;
    for (int r0 = F.gw * RB; r0 < BATCH * NH * SEQ; r0 += F.NGW * RB) {
        f32x4 l[RB]; unsigned v[RB][4];
#pragma unroll
        for (int u = 0; u < RB; ++u) { const size_t q = (size_t)(r0 + u); l[u] = *(const GAS f32x4*)(LSE + q * 4);
#pragma unroll
            for (int k = 0; k < 4; ++k) v[u][k] = __builtin_nontemporal_load((const GAS unsigned*)(OPART + (q * 4 + k) * HD + 2 * F.lane)); }
#pragma unroll
        for (int u = 0; u < RB; ++u) {
            const int q = r0 + u, s = q % SEQ, bh = q / SEQ, b = bh / NH, h = bh % NH;
            const float mx = fmaxf(fmaxf(l[u][0], l[u][1]), fmaxf(l[u][2], l[u][3]));
            float o0 = 0.f, o1 = 0.f, den = 0.f;
#pragma unroll
            for (int k = 0; k < 4; ++k) { const float w = __expf(l[u][k] - mx); const bool on = w > 0.f;
                o0 += on ? w * bflo(v[u][k]) : 0.f; o1 += on ? w * bfhi(v[u][k]) : 0.f; den += w; }
            const float id = 1.0f / den;
            *(GAS unsigned*)(AO + ((size_t)b * SEQ + s) * D + h * HD + 2 * F.lane) = pkbf(o0 * id, o1 * id);
        }
    }
}
constexpr int GD_C = 64, GD_NCH = SEQ / GD_C;
__device__ __forceinline__ float silu_acc(float x) { return x * __builtin_amdgcn_rcpf(1.0f + __expf(-x)); }
__device__ __forceinline__ void gdn_prep(const Frame& F, const bf16* PROJ, const float* AB, const float* cw, const float* a_log, const float* dt_bias,
                                         bf16* QN, bf16* KN, bf16* VN, float* TG, float* TGC, float* TB) {
    for (int unit = F.gw; unit < BATCH * NH * GD_NCH; unit += F.NGW) {
        const int n = unit % GD_NCH, h = (unit / GD_NCH) % NH, b = unit / (GD_NCH * NH);
        const size_t r0 = (size_t)b * SEQ + (size_t)n * GD_C;
        {
            const float a = AB[(r0 + F.lane) * 64 + h], bt = AB[(r0 + F.lane) * 64 + 32 + h];
            const float beta = 1.0f / (1.0f + expf(-bt));
            const float xs = a + dt_bias[h];
            const float sp = xs > 20.f ? xs : log1pf(expf(xs));
            const float g = -expf(a_log[h]) * sp;
            float gc = g;
#pragma unroll
            for (int o = 1; o < 64; o <<= 1) { const float t = __shfl_up(gc, o); if (F.lane >= o) gc += t; }
            TG[(size_t)unit * 64 + F.lane] = g; TGC[(size_t)unit * 64 + F.lane] = gc; TB[(size_t)unit * 64 + F.lane] = beta;
        }
        const int cq = h * HD + 2 * F.lane, ck = D + cq, cv = 2 * D + cq;
        float wq[4][2], wk[4][2], wv[4][2];
#pragma unroll
        for (int t = 0; t < 4; ++t) { wq[t][0] = cw[(size_t)t * 3 * D + cq]; wq[t][1] = cw[(size_t)t * 3 * D + cq + 1]; wk[t][0] = cw[(size_t)t * 3 * D + ck]; wk[t][1] = cw[(size_t)t * 3 * D + ck + 1];
            wv[t][0] = cw[(size_t)t * 3 * D + cv]; wv[t][1] = cw[(size_t)t * 3 * D + cv + 1]; }
        unsigned xq[3] = {0u, 0u, 0u}, xk[3] = {0u, 0u, 0u}, xv[3] = {0u, 0u, 0u};
        if (n > 0) {
#pragma unroll
            for (int t = 0; t < 3; ++t) { const bf16* pr = PROJ + (r0 - 3 + t) * 16384; xq[t] = *(const GAS unsigned*)(pr + cq); xk[t] = *(const GAS unsigned*)(pr + ck); xv[t] = *(const GAS unsigned*)(pr + cv); } }
        const size_t ob = (size_t)unit * GD_C * HD + 2 * F.lane;
#pragma unroll 2
        for (int j = 0; j < GD_C; ++j) {
            const bf16* pr = PROJ + (r0 + j) * 16384;
            const unsigned nq = *(const GAS unsigned*)(pr + cq), nk = *(const GAS unsigned*)(pr + ck), nv = *(const GAS unsigned*)(pr + cv);
            const float q0 = silu_acc(wq[0][0] * bflo(xq[0]) + wq[1][0] * bflo(xq[1]) + wq[2][0] * bflo(xq[2]) + wq[3][0] * bflo(nq));
            const float q1 = silu_acc(wq[0][1] * bfhi(xq[0]) + wq[1][1] * bfhi(xq[1]) + wq[2][1] * bfhi(xq[2]) + wq[3][1] * bfhi(nq));
            const float k0 = silu_acc(wk[0][0] * bflo(xk[0]) + wk[1][0] * bflo(xk[1]) + wk[2][0] * bflo(xk[2]) + wk[3][0] * bflo(nk));
            const float k1 = silu_acc(wk[0][1] * bfhi(xk[0]) + wk[1][1] * bfhi(xk[1]) + wk[2][1] * bfhi(xk[2]) + wk[3][1] * bfhi(nk));
            const float v0 = silu_acc(wv[0][0] * bflo(xv[0]) + wv[1][0] * bflo(xv[1]) + wv[2][0] * bflo(xv[2]) + wv[3][0] * bflo(nv));
            const float v1 = silu_acc(wv[0][1] * bfhi(xv[0]) + wv[1][1] * bfhi(xv[1]) + wv[2][1] * bfhi(xv[2]) + wv[3][1] * bfhi(nv));
            xq[0] = xq[1]; xq[1] = xq[2]; xq[2] = nq; xk[0] = xk[1]; xk[1] = xk[2]; xk[2] = nk; xv[0] = xv[1]; xv[1] = xv[2]; xv[2] = nv;
            const float sq = wave_sum(q0 * q0 + q1 * q1), sk = wave_sum(k0 * k0 + k1 * k1);
            const float rq = 0.08838834764831845f / sqrtf(sq + 1e-6f), rk = 1.0f / sqrtf(sk + 1e-6f);
            *(GAS unsigned*)(QN + ob + (size_t)j * HD) = pkbf(q0 * rq, q1 * rq);
            *(GAS unsigned*)(KN + ob + (size_t)j * HD) = pkbf(k0 * rk, k1 * rk);
            *(GAS unsigned*)(VN + ob + (size_t)j * HD) = pkbf(v0, v1);
        }
    }
}
__device__ __forceinline__ void gdn_scan_naive(const Frame& F, const bf16* QN, const bf16* KN, const bf16* VN, const float* TG, const float* TB, float* O) {
    LAS float* sk = (LAS float*)(F.lds + RING_OFF);
    LAS float* sq = sk + 128;
    LAS float* red = sq + 128;
    LAS float* red2 = red + 512;
    const int c = F.tid & 127, qd = F.tid >> 7;
    for (int bh = F.vcu; bh < BATCH * NH; bh += F.G) {
        const int b = bh / NH, h = bh % NH;
        float S[32];
#pragma unroll
        for (int i = 0; i < 32; ++i) S[i] = 0.f;
        for (int t = 0; t < SEQ; ++t) {
            const size_t ci = (size_t)bh * GD_NCH + (t >> 6); const int j = t & 63;
            const size_t ro = (ci * GD_C + j) * HD;
            __syncthreads();
            if (F.tid < 128) sk[F.tid] = bf2f(KN[ro + F.tid]); else if (F.tid < 256) sq[F.tid - 128] = bf2f(QN[ro + F.tid - 128]);
            const float g = TG[ci * 64 + j], beta = TB[ci * 64 + j], v = bf2f(VN[ro + c]);
            const float eg = expf(g);
            __syncthreads();
            float part = 0.f;
#pragma unroll
            for (int i = 0; i < 32; ++i) { S[i] *= eg; part += sk[qd * 32 + i] * S[i]; }
            red[qd * 128 + c] = part;
            __syncthreads();
            const float ks = (red[c] + red[128 + c]) + (red[256 + c] + red[384 + c]);
            const float vn = beta * (v - ks);
            float po = 0.f;
#pragma unroll
            for (int i = 0; i < 32; ++i) { S[i] += sk[qd * 32 + i] * vn; po += sq[qd * 32 + i] * S[i]; }
            red2[qd * 128 + c] = po;
            __syncthreads();
            if (qd == 0) O[((size_t)b * SEQ + t) * D + h * HD + c] = (red2[c] + red2[128 + c]) + (red2[256 + c] + red2[384 + c]);
        }
    }
}
__device__ __forceinline__ void gdn_outnorm(const Frame& F, const bf16* O, const bf16* PROJ, const float* onorm, bf16* OG) {
    const float g0 = onorm[2 * F.lane], g1 = onorm[2 * F.lane + 1];
    for (int row = F.gw; row < M; row += F.NGW) {
#pragma unroll 4
        for (int h = 0; h < NH; ++h) {
            const unsigned ow = *(const GAS unsigned*)(O + (size_t)row * D + h * HD + 2 * F.lane); f32x2v o; o.x = bflo(ow); o.y = bfhi(ow);
            const unsigned z = *(const GAS unsigned*)(PROJ + (size_t)row * 16384 + 3 * D + h * HD + 2 * F.lane);
            const float ss = wave_sum(o.x * o.x + o.y * o.y);
            const float rs = __builtin_amdgcn_rsqf(ss * (1.0f / 128.0f) + 1e-6f);
            *(GAS unsigned*)(OG + (size_t)row * D + h * HD + 2 * F.lane) = pkbf(o.x * rs * g0 * silu_acc(bflo(z)), o.y * rs * g1 * silu_acc(bfhi(z)));
        }
    }
}
#define MFMA32(a, b, c) __builtin_amdgcn_mfma_f32_32x32x16_bf16((a), (b), (c), 0, 0, 0)
constexpr int GD_WSLOT = 17408;
__device__ __forceinline__ bf16x8 pack_regs(const f32x16& x, int s) {
    v4u w; w.x = pkbf(x[8 * s + 0], x[8 * s + 1]); w.y = pkbf(x[8 * s + 2], x[8 * s + 3]); w.z = pkbf(x[8 * s + 4], x[8 * s + 5]); w.w = pkbf(x[8 * s + 6], x[8 * s + 7]);
    return __builtin_bit_cast(bf16x8, w);
}
__device__ __forceinline__ int sorder_pos(int i, int d) { const int ti = i >> 5, r = i & 31, td = d >> 5, dd = d & 31, s = dd >> 4, e = dd & 15, hh = (e >> 2) & 1, jj = ((e >> 3) << 2) | (e & 3);
    return ((((ti * 4 + td) * 2 + s) * 64 + hh * 32 + r) << 3) + jj; }

__device__ __forceinline__ void gdn_prep2(const Frame& F, const bf16* PROJ, const float* AB, const float* cw, const float* a_log, const float* dt_bias,
                                          bf16* QN, bf16* KN, bf16* QDF, bf16* KDF, bf16* KWT, bf16* VUT, float* TGC, float* TB) {
    LAS unsigned char* slot = F.lds + RING_OFF + F.wave * GD_WSLOT;
    LAS unsigned* tile32 = (LAS unsigned*)slot;
    LAS unsigned short* tile16 = (LAS unsigned short*)slot;
    LAS float* ftab = (LAS float*)(slot + 16640);
    for (int unit = F.gw; unit < BATCH * NH * GD_NCH; unit += F.NGW) {
        int lane_ = F.lane; asm volatile("" : "+v"(lane_));
        const int lane = lane_;
        const int n = unit % GD_NCH, h = (unit / GD_NCH) % NH, b = unit / (GD_NCH * NH);
        const size_t r0 = (size_t)b * SEQ + (size_t)n * GD_C;
        float fq;
        {
            const float a = AB[(r0 + lane) * 64 + h], bt = AB[(r0 + lane) * 64 + 32 + h];
            const float beta = 1.0f / (1.0f + expf(-bt));
            const float xs = a + dt_bias[h];
            const float sp = xs > 20.f ? xs : log1pf(expf(xs));
            const float g = -expf(a_log[h]) * sp;
            float gc = g;
#pragma unroll
            for (int o = 1; o < 64; o <<= 1) { const float t = __shfl_up(gc, o); if (lane >= o) gc += t; }
            const float gl = __shfl(gc, 63);
            TGC[(size_t)unit * 64 + lane] = gc; TB[(size_t)unit * 64 + lane] = beta;
            ftab[lane] = beta * expf(gc); ftab[64 + lane] = expf(gl - gc); ftab[128 + lane] = beta; fq = expf(gc);
        }
        asm volatile("" ::: "memory");
        const int cq = h * HD + 2 * lane, ck = D + cq, cv = 2 * D + cq;
        const size_t ob = (size_t)unit * GD_C * HD;
        {
            float wq[4][2], wk[4][2];
#pragma unroll
            for (int t = 0; t < 4; ++t) { wq[t][0] = cw[(size_t)t * 3 * D + cq]; wq[t][1] = cw[(size_t)t * 3 * D + cq + 1]; wk[t][0] = cw[(size_t)t * 3 * D + ck]; wk[t][1] = cw[(size_t)t * 3 * D + ck + 1]; }
            unsigned xq[3] = {0u, 0u, 0u}, xk[3] = {0u, 0u, 0u};
            if (n > 0) {
#pragma unroll
                for (int t = 0; t < 3; ++t) { const bf16* pr = PROJ + (r0 - 3 + t) * 16384; xq[t] = *(const GAS unsigned*)(pr + cq); xk[t] = *(const GAS unsigned*)(pr + ck); } }
#pragma unroll 1
            for (int jb = 0; jb < GD_C; jb += 16) {
                unsigned rq[16], rk[16];
#pragma unroll
                for (int t = 0; t < 16; ++t) { const bf16* pr = PROJ + (r0 + jb + t) * 16384; rq[t] = __builtin_nontemporal_load((const GAS unsigned*)(pr + cq)); rk[t] = __builtin_nontemporal_load((const GAS unsigned*)(pr + ck)); }
#pragma unroll
                for (int t = 0; t < 16; ++t) {
                    const int j = jb + t; const unsigned nq = rq[t], nk = rk[t];
                    const float q0 = silu_acc(wq[0][0] * bflo(xq[0]) + wq[1][0] * bflo(xq[1]) + wq[2][0] * bflo(xq[2]) + wq[3][0] * bflo(nq));
                    const float q1 = silu_acc(wq[0][1] * bfhi(xq[0]) + wq[1][1] * bfhi(xq[1]) + wq[2][1] * bfhi(xq[2]) + wq[3][1] * bfhi(nq));
                    const float k0 = silu_acc(wk[0][0] * bflo(xk[0]) + wk[1][0] * bflo(xk[1]) + wk[2][0] * bflo(xk[2]) + wk[3][0] * bflo(nk));
                    const float k1 = silu_acc(wk[0][1] * bfhi(xk[0]) + wk[1][1] * bfhi(xk[1]) + wk[2][1] * bfhi(xk[2]) + wk[3][1] * bfhi(nk));
                    xq[0] = xq[1]; xq[1] = xq[2]; xq[2] = nq; xk[0] = xk[1]; xk[1] = xk[2]; xk[2] = nk;
                    const float sq = wave_sum_dpp(q0 * q0 + q1 * q1), sk = wave_sum_dpp(k0 * k0 + k1 * k1);
                    const float rq_ = 0.08838834764831845f * __builtin_amdgcn_rsqf(sq + 1e-6f), rk_ = __builtin_amdgcn_rsqf(sk + 1e-6f);
                    const float eq = __shfl(fq, j);
                    const unsigned kp = pkbf(k0 * rk_, k1 * rk_);
                    *(GAS unsigned*)(QN + ob + (size_t)j * HD + 2 * lane) = pkbf(q0 * rq_, q1 * rq_);
                    *(GAS unsigned*)(KN + ob + (size_t)j * HD + 2 * lane) = kp;
                    *(GAS unsigned*)(QDF + ob + sorder_pos(j, 2 * lane)) = pkbf(q0 * rq_ * eq, q1 * rq_ * eq);
                    tile32[j * 65 + lane] = kp;
                }
            }
            asm volatile("" ::: "memory");
#pragma unroll 1
            for (int dt = 0; dt < 4; ++dt) {
                const int ds = dt >> 1, tj = dt & 1;
                const int d = lane + 64 * ds, td = d >> 5, r = d & 31;
                {
                    float kv[32];
#pragma unroll
                    for (int j = 0; j < 32; ++j) kv[j] = bf2f(tile16[(32 * tj + j) * 130 + d]);
                    GAS v4u* ow = (GAS v4u*)(KWT + ob + (size_t)d * 64 + 32 * tj);
#pragma unroll
                    for (int q = 0; q < 4; ++q) { const LAS float* fw = ftab + 32 * tj + 8 * q; v4u w;
                        w.x = pkbf(kv[8 * q] * fw[0], kv[8 * q + 1] * fw[1]); w.y = pkbf(kv[8 * q + 2] * fw[2], kv[8 * q + 3] * fw[3]);
                        w.z = pkbf(kv[8 * q + 4] * fw[4], kv[8 * q + 5] * fw[5]); w.w = pkbf(kv[8 * q + 6] * fw[6], kv[8 * q + 7] * fw[7]); ow[q] = w; }
#pragma unroll
                    for (int s = 0; s < 2; ++s)
#pragma unroll
                        for (int h2 = 0; h2 < 2; ++h2) { const int j0 = 16 * s + 4 * h2; const LAS float* fd = ftab + 64 + 32 * tj + j0; v4u w;
                            w.x = pkbf(kv[j0] * fd[0], kv[j0 + 1] * fd[1]); w.y = pkbf(kv[j0 + 2] * fd[2], kv[j0 + 3] * fd[3]);
                            w.z = pkbf(kv[j0 + 8] * fd[8], kv[j0 + 9] * fd[9]); w.w = pkbf(kv[j0 + 10] * fd[10], kv[j0 + 11] * fd[11]);
                            *(GAS v4u*)(KDF + ob + (size_t)((((td * 2 + tj) * 2 + s) * 64 + h2 * 32 + r) << 3)) = w; }
                }
            }
        }
        asm volatile("" ::: "memory");
        {
            float wv[4][2];
#pragma unroll
            for (int t = 0; t < 4; ++t) { wv[t][0] = cw[(size_t)t * 3 * D + cv]; wv[t][1] = cw[(size_t)t * 3 * D + cv + 1]; }
            unsigned xv[3] = {0u, 0u, 0u};
            if (n > 0) {
#pragma unroll
                for (int t = 0; t < 3; ++t) xv[t] = *(const GAS unsigned*)(PROJ + (r0 - 3 + t) * 16384 + cv); }
#pragma unroll 1
            for (int jb = 0; jb < GD_C; jb += 32) {
                unsigned rv[32];
#pragma unroll
                for (int t = 0; t < 32; ++t) rv[t] = __builtin_nontemporal_load((const GAS unsigned*)(PROJ + (r0 + jb + t) * 16384 + cv));
#pragma unroll
                for (int t = 0; t < 32; ++t) {
                    const int j = jb + t; const unsigned nv = rv[t];
                    const float v0 = silu_acc(wv[0][0] * bflo(xv[0]) + wv[1][0] * bflo(xv[1]) + wv[2][0] * bflo(xv[2]) + wv[3][0] * bflo(nv));
                    const float v1 = silu_acc(wv[0][1] * bfhi(xv[0]) + wv[1][1] * bfhi(xv[1]) + wv[2][1] * bfhi(xv[2]) + wv[3][1] * bfhi(nv));
                    xv[0] = xv[1]; xv[1] = xv[2]; xv[2] = nv;
                    tile32[j * 65 + lane] = pkbf(v0, v1);
                }
            }
            asm volatile("" ::: "memory");
#pragma unroll 1
            for (int ds = 0; ds < 2; ++ds) {
                const int d = lane + 64 * ds;
                GAS v4u* ow = (GAS v4u*)(VUT + ob + (size_t)d * 64);
#pragma unroll 2
                for (int q = 0; q < 8; ++q) { float x[8];
#pragma unroll
                    for (int e = 0; e < 8; ++e) { const int j = 8 * q + e; x[e] = bf2f(tile16[j * 130 + d]) * ftab[128 + j]; }
                    v4u w; w.x = pkbf(x[0], x[1]); w.y = pkbf(x[2], x[3]); w.z = pkbf(x[4], x[5]); w.w = pkbf(x[6], x[7]); ow[q] = w; }
            }
        }
        asm volatile("" ::: "memory");
    }
}
__device__ __forceinline__ void gdn_chunk(const Frame& F, const bf16* QN, const bf16* KN, const bf16* KWT, const bf16* VUT, const float* TGC, const float* TB,
                                          bf16* WF, float* UU, bf16* QKF) {
    LAS unsigned char* slot = F.lds + RING_OFF + F.wave * GD_WSLOT;
    LAS float* Al = (LAS float*)slot;
    LAS unsigned short* Timg = (LAS unsigned short*)slot;
    LAS float* gtab = (LAS float*)(slot + 16384);
    for (int unit = F.gw; unit < BATCH * NH * GD_NCH; unit += F.NGW) {
        int lane_ = F.lane; asm volatile("" : "+v"(lane_));
        const int lane = lane_, r = lane & 31, hh = lane >> 5;
        const size_t ob = (size_t)unit * GD_C * HD;
        gtab[lane] = TGC[(size_t)unit * 64 + lane]; gtab[64 + lane] = TB[(size_t)unit * 64 + lane];
        const float gcl0 = TGC[(size_t)unit * 64 + r], gcl1 = TGC[(size_t)unit * 64 + 32 + r];
        asm volatile("" ::: "memory");
        bf16x8 kf[2][8], qf[2][8];
#pragma unroll
        for (int t = 0; t < 2; ++t)
#pragma unroll
            for (int s = 0; s < 8; ++s) { kf[t][s] = *(const GAS bf16x8*)(KN + ob + (size_t)(32 * t + r) * HD + 16 * s + 8 * hh); qf[t][s] = *(const GAS bf16x8*)(QN + ob + (size_t)(32 * t + r) * HD + 16 * s + 8 * hh); }
#pragma unroll
        for (int q = 0; q < 3; ++q) {
            const int ti = q ? 1 : 0, tj = q == 2 ? 1 : 0;
            f32x16 x = {};
#pragma unroll
            for (int s = 0; s < 8; ++s) x = MFMA32(kf[ti][s], kf[tj][s], x);
            const float gcj = tj ? gcl1 : gcl0;
#pragma unroll
            for (int g = 0; g < 4; ++g) { const f32x4 gi = *(const LAS f32x4*)(gtab + 32 * ti + 8 * g + 4 * hh), bi = *(const LAS f32x4*)(gtab + 64 + 32 * ti + 8 * g + 4 * hh);
#pragma unroll
                for (int e = 0; e < 4; ++e) { const int i = 32 * ti + 8 * g + 4 * hh + e;
                    Al[i * 64 + 32 * tj + r] = bi[e] * x[4 * g + e] * __expf(fminf(gi[e] - gcj, 0.f)); } }
        }
#pragma unroll
        for (int q = 0; q < 3; ++q) {
            const int ti = q ? 1 : 0, tj = q == 2 ? 1 : 0;
            f32x16 y = {};
#pragma unroll
            for (int s = 0; s < 8; ++s) y = MFMA32(kf[tj][s], qf[ti][s], y);
            const float gci = ti ? gcl1 : gcl0;
#pragma unroll
            for (int g = 0; g < 4; ++g) { const f32x4 gj = *(const LAS f32x4*)(gtab + 32 * tj + 8 * g + 4 * hh);
#pragma unroll
                for (int e = 0; e < 4; ++e) { const int jl = 8 * g + 4 * hh + e;
                    const float v = y[4 * g + e] * __expf(fminf(gci - gj[e], 0.f));
                    y[4 * g + e] = (ti != tj || jl <= r) ? v : 0.f; } }
#pragma unroll
            for (int s = 0; s < 2; ++s) *(GAS bf16x8*)(QKF + (size_t)unit * 4096 + (size_t)(((q * 2 + s) * 64 + lane) << 3)) = pack_regs(y, s);
        }
        bf16x8 kwf[4][4], vuf[4][4];
#pragma unroll
        for (int td = 0; td < 4; ++td)
#pragma unroll
            for (int s = 0; s < 4; ++s) { kwf[td][s] = *(const GAS bf16x8*)(KWT + ob + (size_t)(32 * td + r) * 64 + 16 * s + 8 * hh); vuf[td][s] = *(const GAS bf16x8*)(VUT + ob + (size_t)(32 * td + r) * 64 + 16 * s + 8 * hh); }
        asm volatile("" ::: "memory");
        float t[64];
#pragma unroll
        for (int i = 0; i < 64; ++i) {
            float acc = (lane == i) ? 1.f : 0.f;
#pragma unroll
            for (int j4 = 0; j4 < (i + 3) / 4; ++j4) { const f32x4 a = *(const LAS f32x4*)(Al + i * 64 + 4 * j4);
#pragma unroll
                for (int e = 0; e < 4; ++e) if (4 * j4 + e < i) acc -= a[e] * t[4 * j4 + e]; }
            t[i] = acc;
        }
asm volatile("" ::: "memory");
#pragma unroll
        for (int i = 0; i < 64; ++i) Timg[i * 72 + lane] = (unsigned short)(pkbf(t[i], 0.f) & 0xffffu);
        asm volatile("" ::: "memory");
        bf16x8 tf[2][4];
#pragma unroll
        for (int ti = 0; ti < 2; ++ti)
#pragma unroll
            for (int s = 0; s < 4; ++s) tf[ti][s] = *(const LAS bf16x8*)(Timg + (32 * ti + r) * 72 + 16 * s + 8 * hh);
#pragma unroll
        for (int td = 0; td < 4; ++td) {
#pragma unroll
            for (int ti = 0; ti < 2; ++ti) { f32x16 w = {};
#pragma unroll
                for (int s = 0; s < 4; ++s) w = MFMA32(kwf[td][s], tf[ti][s], w);
#pragma unroll
                for (int s = 0; s < 2; ++s) *(GAS bf16x8*)(WF + ob + (size_t)((((ti * 4 + td) * 2 + s) * 64 + lane) << 3)) = pack_regs(w, s); }
        }
#pragma unroll
        for (int tdv = 0; tdv < 4; ++tdv) {
#pragma unroll
            for (int ti = 0; ti < 2; ++ti) { f32x16 u = {};
#pragma unroll
                for (int s = 0; s < 4; ++s) u = MFMA32(tf[ti][s], vuf[tdv][s], u);
                v4u* up = (v4u*)((unsigned*)UU + (size_t)unit * 4096 + (size_t)((tdv * 2 + ti) * 64 + lane) * 8);
#pragma unroll
                for (int g = 0; g < 2; ++g) { v4u w; w.x = pkbf(u[8 * g], u[8 * g + 1]); w.y = pkbf(u[8 * g + 2], u[8 * g + 3]); w.z = pkbf(u[8 * g + 4], u[8 * g + 5]); w.w = pkbf(u[8 * g + 6], u[8 * g + 7]); up[g] = w; } }
        }
        asm volatile("" ::: "memory");
    }
}
constexpr int GS_BUF = 57344, GS_WF = 0, GS_QD = 16384, GS_KD = 32768, GS_QK = 49152, GS_OB = 2 * GS_BUF, GS_OBSZ = 64 * 272;
static_assert(GS_OB + 2 * GS_OBSZ <= RING_BYTES, "scan LDS map");
#define GS_BAR_COMPUTE() asm volatile("s_waitcnt lgkmcnt(0)\n\ts_barrier" ::: "memory")
#define GS_BAR_LOADER() asm volatile("s_waitcnt vmcnt(0) lgkmcnt(0)\n\ts_barrier" ::: "memory")
__device__ __forceinline__ void gdn_scan(const Frame& F, const bf16* WF, const bf16* QDF, const bf16* KDF, const bf16* QKF, const float* UU, const float* TGC, bf16* GO, unsigned* prog) {
    if (F.bx >= BATCH * NH) return;
    const int bh = F.bx, b = bh / NH, h = bh % NH;
    LAS unsigned char* lbase = F.lds + RING_OFF;
    const size_t cb = (size_t)bh * GD_NCH;
#define GS_ISSUE(n_) do { const int lw_ = F.wave - 4; LAS unsigned char* dst_ = lbase + ((n_) & 1) * GS_BUF + lw_ * 1024; const size_t co_ = (cb + (n_)) * 8192;     \
        const unsigned lo_ = (unsigned)(lw_ * 512 + lane * 8); \
        _Pragma("unroll") for (int p_ = 0; p_ < 4; ++p_) { \
            __builtin_amdgcn_global_load_lds((const unsigned*)(WF + co_ + p_ * 2048 + lo_), (LAS unsigned*)(dst_ + GS_WF + p_ * 4096), 16, 0, 0); \
            __builtin_amdgcn_global_load_lds((const unsigned*)(QDF + co_ + p_ * 2048 + lo_), (LAS unsigned*)(dst_ + GS_QD + p_ * 4096), 16, 0, 0); \
            __builtin_amdgcn_global_load_lds((const unsigned*)(KDF + co_ + p_ * 2048 + lo_), (LAS unsigned*)(dst_ + GS_KD + p_ * 4096), 16, 0, 0); } \
        __builtin_amdgcn_global_load_lds((const unsigned*)(QKF + (cb + (n_)) * 4096 + lo_), (LAS unsigned*)(dst_ + GS_QK), 16, 0, 0); \
        if (lw_ < 2) __builtin_amdgcn_global_load_lds((const unsigned*)(QKF + (cb + (n_)) * 4096 + 2048 + lo_), (LAS unsigned*)(dst_ + GS_QK + 4096), 16, 0, 0); } while (0)
#define GS_OSTORE(n_) do { const int lw_ = F.wave - 4; const LAS unsigned char* ob_ = lbase + GS_OB + ((n_) & 1) * GS_OBSZ; \
        _Pragma("unroll") for (int q_ = 0; q_ < 4; ++q_) { const int row_ = 16 * lw_ + 4 * q_ + (lane >> 4), cg_ = lane & 15; \
            const v4u v_ = *(const LAS v4u*)(ob_ + row_ * 272 + cg_ * 16); \
            *(GAS v4u*)(GO + ((size_t)b * SEQ + (size_t)(n_) * GD_C + row_) * D + h * HD + cg_ * 8) = v_; } } while (0)
    if (F.wave >= 4) {
        const int lane = F.lane;
        GS_ISSUE(0);
        GS_BAR_LOADER();
        for (int n = 0; n < GD_NCH; ++n) {
            if (n + 1 < GD_NCH) GS_ISSUE(n + 1);
            if (n > 0) GS_OSTORE(n - 1);
            if (F.wave == 4 && lane == 0) __hip_atomic_store(prog + 16 * bh, (unsigned)(n + 1), __ATOMIC_RELAXED, __HIP_MEMORY_SCOPE_AGENT);
            GS_BAR_LOADER();
        }
        GS_OSTORE(GD_NCH - 1);
    } else {
        f32x16 S[4] = {};
        f32x16 uc[2];
        float egn;
        { const int lane = F.lane;
#pragma unroll
          for (int ti = 0; ti < 2; ++ti) { const v4u* up = (const v4u*)((const unsigned*)UU + cb * 4096 + (size_t)((F.wave * 2 + ti) * 64 + lane) * 8);
#pragma unroll
              for (int g = 0; g < 2; ++g) { const v4u x = up[g]; uc[ti][8 * g] = bflo(x.x); uc[ti][8 * g + 1] = bfhi(x.x); uc[ti][8 * g + 2] = bflo(x.y); uc[ti][8 * g + 3] = bfhi(x.y);
                  uc[ti][8 * g + 4] = bflo(x.z); uc[ti][8 * g + 5] = bfhi(x.z); uc[ti][8 * g + 6] = bflo(x.w); uc[ti][8 * g + 7] = bfhi(x.w); } }
          egn = TGC[cb * 64 + 63]; }
        GS_BAR_COMPUTE();
        for (int n = 0; n < GD_NCH; ++n) {
            int lq_ = F.lane; asm volatile("" : "+v"(lq_));
            const int lane = lq_, r = lane & 31, hh = lane >> 5;
            const LAS unsigned char* B = lbase + (n & 1) * GS_BUF;
            const float eg = __expf(egn);
            bf16x8 Sb[4][2];
#pragma unroll
            for (int td = 0; td < 4; ++td) { Sb[td][0] = pack_regs(S[td], 0); Sb[td][1] = pack_regs(S[td], 1); }
            bf16x8 Vb[2][2];
            f32x16 P[2] = {}, O[2] = {};
#define FRG(off_) (*(const LAS bf16x8*)(B + (off_) + lane * 16))
            bf16x8 fr0, fr1, fr2, fr3, fr4, fr5, fr6, fr7;
            fr0 = FRG(GS_WF + 0);
            fr1 = FRG(GS_WF + 8192);
            fr2 = FRG(GS_WF + 1024);
            fr3 = FRG(GS_WF + 9216);
            fr4 = FRG(GS_WF + 2048);
            fr5 = FRG(GS_WF + 10240);
            fr6 = FRG(GS_WF + 3072); P[0] = MFMA32(fr0, Sb[0][0], P[0]); __builtin_amdgcn_sched_barrier(0);
            fr7 = FRG(GS_WF + 11264); P[1] = MFMA32(fr1, Sb[0][0], P[1]); __builtin_amdgcn_sched_barrier(0);
            fr0 = FRG(GS_WF + 4096); P[0] = MFMA32(fr2, Sb[0][1], P[0]); __builtin_amdgcn_sched_barrier(0);
            fr1 = FRG(GS_WF + 12288); P[1] = MFMA32(fr3, Sb[0][1], P[1]); __builtin_amdgcn_sched_barrier(0);
            fr2 = FRG(GS_WF + 5120); P[0] = MFMA32(fr4, Sb[1][0], P[0]); __builtin_amdgcn_sched_barrier(0);
            fr3 = FRG(GS_WF + 13312); P[1] = MFMA32(fr5, Sb[1][0], P[1]); __builtin_amdgcn_sched_barrier(0);
            fr4 = FRG(GS_WF + 6144); P[0] = MFMA32(fr6, Sb[1][1], P[0]); __builtin_amdgcn_sched_barrier(0);
            fr5 = FRG(GS_WF + 14336); P[1] = MFMA32(fr7, Sb[1][1], P[1]); __builtin_amdgcn_sched_barrier(0);
            fr6 = FRG(GS_WF + 7168); P[0] = MFMA32(fr0, Sb[2][0], P[0]); __builtin_amdgcn_sched_barrier(0);
            fr7 = FRG(GS_WF + 15360); P[1] = MFMA32(fr1, Sb[2][0], P[1]); __builtin_amdgcn_sched_barrier(0);
            fr0 = FRG(GS_KD + 0); P[0] = MFMA32(fr2, Sb[2][1], P[0]); __builtin_amdgcn_sched_barrier(0);
            fr1 = FRG(GS_KD + 4096); P[1] = MFMA32(fr3, Sb[2][1], P[1]); __builtin_amdgcn_sched_barrier(0);
            fr2 = FRG(GS_KD + 8192); P[0] = MFMA32(fr4, Sb[3][0], P[0]); __builtin_amdgcn_sched_barrier(0);
            fr3 = FRG(GS_KD + 12288); P[1] = MFMA32(fr5, Sb[3][0], P[1]); __builtin_amdgcn_sched_barrier(0);
            fr4 = FRG(GS_KD + 1024); P[0] = MFMA32(fr6, Sb[3][1], P[0]); __builtin_amdgcn_sched_barrier(0);
            fr5 = FRG(GS_KD + 5120); P[1] = MFMA32(fr7, Sb[3][1], P[1]); __builtin_amdgcn_sched_barrier(0);
            {
#pragma unroll
                for (int ti = 0; ti < 2; ++ti) { const f32x16 vn = uc[ti] - P[ti]; Vb[ti][0] = pack_regs(vn, 0); Vb[ti][1] = pack_regs(vn, 1); }
            }
            if (n + 1 < GD_NCH) {
#pragma unroll
                for (int ti = 0; ti < 2; ++ti) { const v4u* up = (const v4u*)((const unsigned*)UU + (cb + n + 1) * 4096 + (size_t)((F.wave * 2 + ti) * 64 + lane) * 8);
#pragma unroll
                    for (int g = 0; g < 2; ++g) { const v4u x = up[g]; uc[ti][8 * g] = bflo(x.x); uc[ti][8 * g + 1] = bfhi(x.x); uc[ti][8 * g + 2] = bflo(x.y); uc[ti][8 * g + 3] = bfhi(x.y);
                        uc[ti][8 * g + 4] = bflo(x.z); uc[ti][8 * g + 5] = bfhi(x.z); uc[ti][8 * g + 6] = bflo(x.w); uc[ti][8 * g + 7] = bfhi(x.w); } }
                egn = TGC[(cb + n + 1) * 64 + 63]; }
#pragma unroll
            for (int td = 0; td < 4; ++td) S[td] = S[td] * eg;
            __builtin_amdgcn_sched_barrier(0);
            fr6 = FRG(GS_KD + 9216); S[0] = MFMA32(fr0, Vb[0][0], S[0]); __builtin_amdgcn_sched_barrier(0);
            fr7 = FRG(GS_KD + 13312); S[1] = MFMA32(fr1, Vb[0][0], S[1]); __builtin_amdgcn_sched_barrier(0);
            fr0 = FRG(GS_KD + 2048); S[2] = MFMA32(fr2, Vb[0][0], S[2]); __builtin_amdgcn_sched_barrier(0);
            fr1 = FRG(GS_KD + 6144); S[3] = MFMA32(fr3, Vb[0][0], S[3]); __builtin_amdgcn_sched_barrier(0);
            fr2 = FRG(GS_KD + 10240); S[0] = MFMA32(fr4, Vb[0][1], S[0]); __builtin_amdgcn_sched_barrier(0);
            fr3 = FRG(GS_KD + 14336); S[1] = MFMA32(fr5, Vb[0][1], S[1]); __builtin_amdgcn_sched_barrier(0);
            fr4 = FRG(GS_KD + 3072); S[2] = MFMA32(fr6, Vb[0][1], S[2]); __builtin_amdgcn_sched_barrier(0);
            fr5 = FRG(GS_KD + 7168); S[3] = MFMA32(fr7, Vb[0][1], S[3]); __builtin_amdgcn_sched_barrier(0);
            fr6 = FRG(GS_KD + 11264); S[0] = MFMA32(fr0, Vb[1][0], S[0]); __builtin_amdgcn_sched_barrier(0);
            fr7 = FRG(GS_KD + 15360); S[1] = MFMA32(fr1, Vb[1][0], S[1]); __builtin_amdgcn_sched_barrier(0);
            fr0 = FRG(GS_QD + 0); S[2] = MFMA32(fr2, Vb[1][0], S[2]); __builtin_amdgcn_sched_barrier(0);
            fr1 = FRG(GS_QD + 8192); S[3] = MFMA32(fr3, Vb[1][0], S[3]); __builtin_amdgcn_sched_barrier(0);
            fr2 = FRG(GS_QD + 1024); S[0] = MFMA32(fr4, Vb[1][1], S[0]); __builtin_amdgcn_sched_barrier(0);
            fr3 = FRG(GS_QD + 9216); S[1] = MFMA32(fr5, Vb[1][1], S[1]); __builtin_amdgcn_sched_barrier(0);
            fr4 = FRG(GS_QD + 2048); S[2] = MFMA32(fr6, Vb[1][1], S[2]); __builtin_amdgcn_sched_barrier(0);
            fr5 = FRG(GS_QD + 10240); S[3] = MFMA32(fr7, Vb[1][1], S[3]); __builtin_amdgcn_sched_barrier(0);
            fr6 = FRG(GS_QD + 3072); O[0] = MFMA32(fr0, Sb[0][0], O[0]); __builtin_amdgcn_sched_barrier(0);
            fr7 = FRG(GS_QD + 11264); O[1] = MFMA32(fr1, Sb[0][0], O[1]); __builtin_amdgcn_sched_barrier(0);
            fr0 = FRG(GS_QD + 4096); O[0] = MFMA32(fr2, Sb[0][1], O[0]); __builtin_amdgcn_sched_barrier(0);
            fr1 = FRG(GS_QD + 12288); O[1] = MFMA32(fr3, Sb[0][1], O[1]); __builtin_amdgcn_sched_barrier(0);
            fr2 = FRG(GS_QD + 5120); O[0] = MFMA32(fr4, Sb[1][0], O[0]); __builtin_amdgcn_sched_barrier(0);
            fr3 = FRG(GS_QD + 13312); O[1] = MFMA32(fr5, Sb[1][0], O[1]); __builtin_amdgcn_sched_barrier(0);
            fr4 = FRG(GS_QD + 6144); O[0] = MFMA32(fr6, Sb[1][1], O[0]); __builtin_amdgcn_sched_barrier(0);
            fr5 = FRG(GS_QD + 14336); O[1] = MFMA32(fr7, Sb[1][1], O[1]); __builtin_amdgcn_sched_barrier(0);
            fr6 = FRG(GS_QD + 7168); O[0] = MFMA32(fr0, Sb[2][0], O[0]); __builtin_amdgcn_sched_barrier(0);
            fr7 = FRG(GS_QD + 15360); O[1] = MFMA32(fr1, Sb[2][0], O[1]); __builtin_amdgcn_sched_barrier(0);
            fr0 = FRG(GS_QK + 0); O[0] = MFMA32(fr2, Sb[2][1], O[0]); __builtin_amdgcn_sched_barrier(0);
            fr1 = FRG(GS_QK + 2048); O[1] = MFMA32(fr3, Sb[2][1], O[1]); __builtin_amdgcn_sched_barrier(0);
            fr2 = FRG(GS_QK + 4096); O[0] = MFMA32(fr4, Sb[3][0], O[0]); __builtin_amdgcn_sched_barrier(0);
            fr3 = FRG(GS_QK + 1024); O[1] = MFMA32(fr5, Sb[3][0], O[1]); __builtin_amdgcn_sched_barrier(0);
            fr4 = FRG(GS_QK + 3072); O[0] = MFMA32(fr6, Sb[3][1], O[0]); __builtin_amdgcn_sched_barrier(0);
            fr5 = FRG(GS_QK + 5120); O[1] = MFMA32(fr7, Sb[3][1], O[1]); __builtin_amdgcn_sched_barrier(0);
            O[0] = MFMA32(fr0, Vb[0][0], O[0]); __builtin_amdgcn_sched_barrier(0);
            O[1] = MFMA32(fr1, Vb[0][0], O[1]); __builtin_amdgcn_sched_barrier(0);
            O[1] = MFMA32(fr2, Vb[1][0], O[1]); __builtin_amdgcn_sched_barrier(0);
            O[0] = MFMA32(fr3, Vb[0][1], O[0]); __builtin_amdgcn_sched_barrier(0);
            O[1] = MFMA32(fr4, Vb[0][1], O[1]); __builtin_amdgcn_sched_barrier(0);
            O[1] = MFMA32(fr5, Vb[1][1], O[1]); __builtin_amdgcn_sched_barrier(0);
#undef FRG
            {
                LAS unsigned short* ob = (LAS unsigned short*)(lbase + GS_OB + (n & 1) * GS_OBSZ) + (4 * hh) * 136 + 32 * F.wave + r;
#pragma unroll
                for (int ti = 0; ti < 2; ++ti)
#pragma unroll
                    for (int g = 0; g < 16; ++g) ob[(32 * ti + (g & 3) + 8 * (g >> 2)) * 136] = (unsigned short)(pkbf(O[ti][g], 0.f) & 0xffffu);
            }
            GS_BAR_COMPUTE();
        }
    }
#undef GS_ISSUE
#undef GS_OSTORE
}

__device__ __forceinline__ void gdn_scan_helper(const Frame& F, const bf16* WF, const bf16* QDF, const bf16* KDF, const bf16* QKF, const float* UU, const unsigned* prog) {
    const int k = (F.bx - BATCH * NH) >> 3;
    if (k < 0 || k >= 24) return;
    const int bh = (F.bx & 7) + 8 * (k & 7), role = k >> 3;
    const size_t cb = (size_t)bh * GD_NCH;
    unsigned dummy = 0u; int touched = 0;
    for (int it = 0; it < (1 << 20) && touched < GD_NCH; ++it) {
        const int p = __builtin_amdgcn_readfirstlane((int)__hip_atomic_load(prog + 16 * bh, __ATOMIC_RELAXED, __HIP_MEMORY_SCOPE_AGENT));
        const int target = p + 5 < GD_NCH ? p + 5 : GD_NCH;
        for (; touched < target; ++touched) {
            const size_t c = cb + touched; const char* a; int nlines;
            if (role == 0) { a = (const char*)(WF + c * 8192); nlines = 128; }
            else if (role == 1) { a = (const char*)(QDF + c * 8192); nlines = 128; }
            else { a = (const char*)(KDF + c * 8192); nlines = 128; }
            if (F.tid < nlines) { const char* q_ = a + F.tid * 128; asm volatile("global_load_dword %0, %1, off" : "+v"(dummy) : "v"(q_) : "memory"); }
            const char* a2 = role == 0 ? (const char*)(QKF + c * 4096) : (const char*)((const unsigned*)UU + c * 4096) + (role - 1) * 8192;
            const int n2 = role == 0 ? 48 : 64;
            if (F.tid >= 128 && F.tid < 128 + n2) { const char* q_ = a2 + (F.tid - 128) * 128; asm volatile("global_load_dword %0, %1, off" : "+v"(dummy) : "v"(q_) : "memory"); }
        }
        if (p >= GD_NCH) break;
        __builtin_amdgcn_s_sleep(8);
    }
    asm volatile("s_waitcnt vmcnt(0)" : "+v"(dummy) :: "memory");
}


template <class Epi, bool F8 = false> __device__ __forceinline__ void run_gemm(const Frame& F, const bf16* A, const bf16* Bt, int N, int K, const Epi& E) {
    pg8::Gemm g{A, Bt, M, N, F8 ? K / 2 : K}; pg8::StaticOrder S; S.init(M, N, F.G, F.bx);
    pg8::gemm_phase<Epi, pg8::StaticOrder, true, true, F8>(F.lds + RING_OFF, g, S, E);
}
#ifndef MK_F8_FFNS
#define MK_F8_FFNS 4
#endif
__host__ __device__ constexpr bool ffn_f8(int f) { return f >= 8 - MK_F8_FFNS; }
#ifndef MK_F8_IN
#define MK_F8_IN 4
#endif
static_assert(MK_F8_IN <= 7 && MK_F8_IN <= MK_F8_FFNS, "fp8 in-projections: never the first FFN (its rows come from P0), and only FFNs whose out-projection is fp8 too");
__host__ __device__ constexpr bool ffn_in_f8(int f) { return f < 8 && f >= 8 - MK_F8_IN; }
constexpr float F8_UNSCALE_IN = 1.0f / (pg8::F8_XS * pg8::F8_WS);
#define P_X8 WSP(unsigned char, WS_X8)
constexpr float F8_UNSCALE = 1.0f / (pg8::F8_HS * pg8::F8_WS);
__host__ __device__ constexpr int layer_base(int L) { return L == 0 ? 1 : L == 1 ? 11 : L == 2 ? 18 : 29; }
constexpr int NPH = 39;
#define WSP(T, off) ((T*)(F.ws + (off)))
#define P_XB   WSP(bf16, WS_XB)
#define P_HID  WSP(bf16, WS_HID)
#define P_RSS(v) (WSP(unsigned long long, WS_ROWSS) + (size_t)(v) * M)
#define P_WB(g) WSP(bf16, ((g) & 1) ? WS_WB1 : WS_WB0)

#define MI_(i) ((unsigned)__builtin_amdgcn_readfirstlane((int)((const volatile LAS unsigned*)((LAS unsigned char*)lds + MISC_OFF))[(i)]))
#define KP0() ((kargp)(((unsigned long long)MI_(19) << 32) | (unsigned long long)MI_(18)))
#define IN(k) ({ kargp k_ = KP0(); const int lo_ = karg<int>(k_, 192), hi_ = karg<int>(k_, 196); lo_ <= (k) && (k) < hi_; })
#define SEAM(k) do { kargp k_ = KP0(); if ((k) + 1 < karg<int>(k_, 196)) { XcdBarrier b_; b_.bar = (unsigned*)(ARG_WS(k_) + WS_CTL) + CW_BAR; b_.x = xb_xcc_id(); b_.st = (volatile LAS unsigned*)((LAS unsigned char*)lds + MISC_OFF) + 8; xcd_barrier(b_); } } while (0)
#define HWSLOT() ((int)(__builtin_amdgcn_s_getreg((5 << 11) | 4) & 63u))
#define ENTER() constexpr int L = Lrt; kargp kp_ = KP0(); do { int t_ = mk_tid(); asm volatile("" : "+v"(t_)); const int g_ = (int)MI_(17), bx_ = (int)MI_(16); \
        F.tid = t_; F.lane = t_ & 63; F.wave = __builtin_amdgcn_readfirstlane(t_ >> 6); F.G = g_; F.bx = bx_; F.vcu = (g_ % 8 == 0) ? (bx_ % 8) * (g_ / 8) + bx_ / 8 : bx_; \
        F.gw = F.vcu * NWAVES + F.wave; F.NGW = g_ * NWAVES; F.ws = ARG_WS(kp_); } while (0); \
    constexpr int g0 = 6 * L, jj = L == 3 ? 1 : 0; (void)g0; (void)jj
#define REFRESH() do { kp_ = KP0(); F.ws = ARG_WS(kp_); } while (0)

template <int Lrt> __device__ __forceinline__ void run_layer(Frame& F, unsigned char* lds) {
    constexpr int pb = layer_base(Lrt), kind = Lrt == 1 ? 1 : Lrt == 2 ? 2 : 0;
        constexpr bool f8a = ffn_f8(2 * Lrt), f8b = ffn_f8(2 * Lrt + 1), f8ia = ffn_in_f8(2 * Lrt), f8ib = ffn_in_f8(2 * Lrt + 1), f8in = ffn_in_f8(2 * Lrt + 2);
        if (IN(pb + 0)) { ENTER(); CVT_FFN_OUT(kp_, 6, L, P_WB(g0 + 1), f8a); REFRESH();
            pg8::EpiIn<0, f8a> E{P_RSS(3 * L), P_HID, nullptr, nullptr, FF, f8ia ? F8_UNSCALE_IN : 1.0f}; run_gemm<pg8::EpiIn<0, f8a>, f8ia>(F, f8ia ? (const bf16*)P_X8 : P_XB, P_WB(g0), 2 * FF, D, E); SEAM(pb + 0); }
        if (IN(pb + 1)) { ENTER(); CVT_MIX_IN(kp_, kind, L, jj, P_WB(g0 + 2)); REFRESH();
            pg8::EpiRes<false> E{nullptr, P_XB, P_RSS(3 * L + 1), f8a ? 0.5f * F8_UNSCALE : 0.5f}; run_gemm<pg8::EpiRes<false>, f8a>(F, P_HID, P_WB(g0 + 1), D, FF, E); SEAM(pb + 1); }
        constexpr int pf = kind == 0 ? pb + 8 : kind == 1 ? pb + 5 : pb + 9;
        if constexpr (kind == 0) {
            if (IN(pb + 2)) { ENTER(); CVT_MIX_OUT(kp_, 14, jj, P_WB(g0 + 3), false); REFRESH();
                pg8::EpiIn<3> E{P_RSS(3 * L + 1), WSP(bf16, WS_GD_PROJ), nullptr, WSP(float, WS_GD_AB), 16384}; run_gemm(F, P_XB, P_WB(g0 + 2), GDN_NP, D, E); SEAM(pb + 2); }
            if (IN(pb + 3)) { ENTER(); gdn_prep2(F, WSP(bf16, WS_GD_PROJ), WSP(float, WS_GD_AB), ARG_IN(kp_, 10) + (size_t)jj * 4 * 3 * D, ARG_IN(kp_, 11) + jj * NH, ARG_IN(kp_, 12) + jj * NH,
                                       WSP(bf16, WS_GD_QN), WSP(bf16, WS_GD_KN), WSP(bf16, WS_GD_QD), WSP(bf16, WS_GD_KDT), WSP(bf16, WS_GD_KWT), WSP(bf16, WS_GD_VUT),
                                       WSP(float, WS_GD_TAB), WSP(float, WS_GD_TAB) + (size_t)BATCH * NH * SEQ); SEAM(pb + 3); }
            if (IN(pb + 4)) { ENTER(); gdn_chunk(F, WSP(bf16, WS_GD_QN), WSP(bf16, WS_GD_KN), WSP(bf16, WS_GD_KWT), WSP(bf16, WS_GD_VUT), WSP(float, WS_GD_TAB), WSP(float, WS_GD_TAB) + (size_t)BATCH * NH * SEQ,
                                       WSP(bf16, WS_GD_WF), WSP(float, WS_GD_U), WSP(bf16, WS_GD_QKM)); SEAM(pb + 4); }
            if (IN(pb + 5)) { ENTER(); unsigned* prog = (unsigned*)(F.ws + WS_CTL) + CW_PROG + jj * 1024;
                if (F.bx < BATCH * NH) gdn_scan(F, WSP(bf16, WS_GD_WF), WSP(bf16, WS_GD_QD), WSP(bf16, WS_GD_KDT), WSP(bf16, WS_GD_QKM), WSP(float, WS_GD_U), WSP(float, WS_GD_TAB), WSP(bf16, WS_GD_O), prog);
                else gdn_scan_helper(F, WSP(bf16, WS_GD_WF), WSP(bf16, WS_GD_QD), WSP(bf16, WS_GD_KDT), WSP(bf16, WS_GD_QKM), WSP(float, WS_GD_U), prog);
                SEAM(pb + 5); }
            if (IN(pb + 6)) { ENTER(); gdn_outnorm(F, WSP(bf16, WS_GD_O), WSP(bf16, WS_GD_PROJ), ARG_IN(kp_, 13) + jj * HD, WSP(bf16, WS_GD_OG)); SEAM(pb + 6); }
            if (IN(pb + 7)) { ENTER(); CVT_FFN_IN(kp_, 7, 4, L, P_WB(g0 + 4), f8ib); REFRESH();
                pg8::EpiRes<false, f8ib> E{nullptr, P_XB, P_RSS(3 * L + 2), 1.0f, P_X8}; run_gemm(F, WSP(bf16, WS_GD_OG), P_WB(g0 + 3), D, D, E); SEAM(pb + 7); }
        } else if constexpr (kind == 1) {
            if (IN(pb + 2)) { ENTER(); CVT_MIX_OUT(kp_, 17, 0, P_WB(g0 + 3), false); REFRESH();
                pg8::EpiIn<2> E{P_RSS(3 * L + 1), WSP(bf16, WS_SC_U), WSP(bf16, WS_SC_GB), nullptr, D}; run_gemm(F, P_XB, P_WB(g0 + 2), 3 * D, D, E); SEAM(pb + 2); }
            if (IN(pb + 3)) { ENTER(); sc_conv(F, WSP(bf16, WS_SC_U), WSP(bf16, WS_SC_GB), ARG_IN(kp_, 16) + (size_t)jj * 3 * D, WSP(bf16, WS_SC_A2)); SEAM(pb + 3); }
            if (IN(pb + 4)) { ENTER(); CVT_FFN_IN(kp_, 7, 4, L, P_WB(g0 + 4), f8ib); REFRESH();
                pg8::EpiRes<false, f8ib> E{nullptr, P_XB, P_RSS(3 * L + 2), 1.0f, P_X8}; run_gemm(F, WSP(bf16, WS_SC_A2), P_WB(g0 + 3), D, D, E); SEAM(pb + 4); }
        } else {
            if (IN(pb + 2)) { ENTER(); CVT_MIX_OUT(kp_, 21, 0, P_WB(g0 + 3), true); REFRESH();
                pg8::EpiIn<1> E{P_RSS(3 * L + 1), WSP(bf16, WS_MB_PROJ), nullptr, nullptr, 3 * D}; run_gemm(F, P_XB, P_WB(g0 + 2), 3 * D, D, E); SEAM(pb + 2); }
            if (IN(pb + 3)) { ENTER(); moba_prep(F, WSP(bf16, WS_MB_PROJ), ARG_IN(kp_, 19) + jj * HD, ARG_IN(kp_, 20) + jj * HD, WSP(float, WS_ROPE), WSP(bf16, WS_MB_Q), WSP(bf16, WS_MB_K), WSP(float, WS_MB_KMEAN)); SEAM(pb + 3); }
            if (IN(pb + 4)) { ENTER(); moba_select(F, WSP(bf16, WS_MB_Q), WSP(float, WS_MB_KMEAN), WSP(unsigned, WS_MB_SEL), WSP(float, WS_MB_LSE)); SEAM(pb + 4); }
            if (IN(pb + 5)) { ENTER(); moba_lists(F, WSP(unsigned, WS_MB_SEL), WSP(unsigned, WS_MB_LIST), WSP(unsigned, WS_MB_CNT), (unsigned*)(F.ws + WS_CTL) + CW_QHEAD); SEAM(pb + 5); }
            if (IN(pb + 6)) { ENTER(); moba_attn_sparse(F, (char*)lds, WSP(bf16, WS_MB_Q), WSP(bf16, WS_MB_K), WSP(bf16, WS_MB_PROJ), WSP(unsigned, WS_MB_LIST), WSP(unsigned, WS_MB_CNT),
                                               WSP(bf16, WS_MB_OPART), WSP(float, WS_MB_LSE), (unsigned*)(F.ws + WS_CTL) + CW_QHEAD); SEAM(pb + 6); }
            if (IN(pb + 7)) { ENTER(); moba_combine(F, WSP(bf16, WS_MB_OPART), WSP(float, WS_MB_LSE), WSP(bf16, WS_MB_O)); SEAM(pb + 7); }
            if (IN(pb + 8)) { ENTER(); CVT_FFN_IN(kp_, 7, 4, L, P_WB(g0 + 4), f8ib); REFRESH();
                pg8::EpiRes<false, f8ib> E{nullptr, P_XB, P_RSS(3 * L + 2), 1.0f, P_X8}; run_gemm(F, WSP(bf16, WS_MB_O), P_WB(g0 + 3), D, D, E); SEAM(pb + 8); }
        }
        if (IN(pf)) { ENTER(); CVT_FFN_OUT(kp_, 8, L, P_WB(g0 + 5), f8b); REFRESH();
            pg8::EpiIn<0, f8b> E{P_RSS(3 * L + 2), P_HID, nullptr, nullptr, FF, f8ib ? F8_UNSCALE_IN : 1.0f}; run_gemm<pg8::EpiIn<0, f8b>, f8ib>(F, f8ib ? (const bf16*)P_X8 : P_XB, P_WB(g0 + 4), 2 * FF, D, E); SEAM(pf); }
        if (IN(pf + 1)) { ENTER(); if (L + 1 < DEPTH) CVT_FFN_IN(kp_, 5, 2, L + 1, P_WB(g0 + 6), f8in); REFRESH();
            pg8::EpiRes<(L == DEPTH - 1), f8in> E{ARG_OUT(kp_), P_XB, P_RSS(3 * L + 3), f8b ? 0.5f * F8_UNSCALE : 0.5f, P_X8}; run_gemm<pg8::EpiRes<(L == DEPTH - 1), f8in>, f8b>(F, P_HID, P_WB(g0 + 5), D, FF, E); SEAM(pf + 1); }

}

__global__ void __launch_bounds__(NWAVES * 64, 2) mk_fwd(Args args) {
    extern __shared__ __attribute__((aligned(16))) unsigned char lds[];
    Frame F;
    F.lds = (LAS unsigned char*)lds;
    F.MISC = (volatile LAS unsigned*)(F.lds + MISC_OFF);
    F.tid = threadIdx.x;
    if (F.tid == 0) { const unsigned long long kpv = (unsigned long long)__builtin_amdgcn_kernarg_segment_ptr(); F.MISC[16] = blockIdx.x; F.MISC[17] = gridDim.x; F.MISC[18] = (unsigned)kpv; F.MISC[19] = (unsigned)(kpv >> 32); }
    if ((F.tid & 63) == 0) F.MISC[32 + mk_hwslot()] = F.tid >> 6;
    for (int u = F.tid; u < (LDS_BYTES - LDSCTL_OFF) / 4; u += NWAVES * 64) { const int mi = u - (MISC_OFF - LDSCTL_OFF) / 4; if (mi < 16 || (mi > 19 && mi < 32) || mi >= 96) ((LAS unsigned*)(F.lds + LDSCTL_OFF))[u] = 0u; }
    __syncthreads();
    { kargp k_ = KP0(); (void)xcd_barrier_post((unsigned*)(ARG_WS(k_) + WS_CTL) + CW_BAR, (volatile LAS unsigned*)((LAS unsigned char*)lds + MISC_OFF) + 8); }
    if (IN(0)) { constexpr int Lrt = 0; ENTER(); p0_rows(F, ARG_IN(kp_, 0), P_XB, P_RSS(0)); rope_table(F, (const int*)ARG_IN(kp_, 1), WSP(float, WS_ROPE)); CVT_FFN_IN(kp_, 5, 2, 0, P_WB(0), false); REFRESH(); SEAM(0); }
    run_layer<0>(F, lds); run_layer<1>(F, lds); run_layer<2>(F, lds); run_layer<3>(F, lds);
#ifdef MK_PROBE_LIST
    if (IN(40)) { constexpr int Lrt = 0; ENTER(); pg8::EpiRes<false> E{nullptr, WSP(bf16, WS_GD_O), P_RSS(12), 0.5f}; run_gemm(F, P_HID, P_WB(1), D, FF, E); }
    if (IN(41)) { constexpr int Lrt = 0; ENTER(); pg8::EpiIn<1> E{P_RSS(0), WSP(bf16, WS_GD_O), nullptr, nullptr, D}; run_gemm(F, P_HID, P_WB(1), D, FF, E); }
#endif
}
#undef IN
#undef SEAM
#undef ENTER
#undef REFRESH

#ifndef MK_MULTI
#define MK_MULTI 0
#endif
extern "C" void kernel_launch(void* const* d_in, const int* in_sizes, int n_in, void* d_out, int out_size, void* d_ws, size_t ws_size, hipStream_t stream) {
    static int grid = 0;
    if (grid == 0) {
        if (n_in != 22 || out_size != M * D || ws_size < WS_END) { fprintf(stderr, "kernel_launch: unexpected shapes (n_in %d out %d ws %zu)\n", n_in, out_size, ws_size); grid = -1; return; }
        int dev = 0, cus = 0, per_cu = 0;
        if (hipGetDevice(&dev) != hipSuccess || hipDeviceGetAttribute(&cus, hipDeviceAttributeMultiprocessorCount, dev) != hipSuccess) { grid = -1; return; }
        if (hipFuncSetAttribute((const void*)mk_fwd, hipFuncAttributeMaxDynamicSharedMemorySize, LDS_BYTES) != hipSuccess) { fprintf(stderr, "kernel_launch: hipFuncSetAttribute failed\n"); grid = -1; return; }
        if (hipOccupancyMaxActiveBlocksPerMultiprocessor(&per_cu, (const void*)mk_fwd, NWAVES * 64, LDS_BYTES) != hipSuccess || per_cu < 1) { fprintf(stderr, "kernel_launch: occupancy query reports %d\n", per_cu); per_cu = 1; }
        (void)hipGetLastError();
        grid = cus;
    }
    if (grid < 0) return;
    if (hipMemsetAsync((char*)d_ws + WS_CTL, 0, CTL_ZERO_BYTES, stream) != hipSuccess) return;
    Args a{};
    for (int i = 0; i < 22; ++i) a.in[i] = (const float*)d_in[i];
    a.out = (float*)d_out; a.ws = (unsigned char*)d_ws;
#if MK_MULTI
    for (int p = 0; p < NPH; ++p) { a.ph_lo = p; a.ph_hi = p + 1; hipLaunchKernelGGL(mk_fwd, dim3(grid), dim3(NWAVES * 64), LDS_BYTES, stream, a); }
#else
    a.ph_lo = 0; a.ph_hi = NPH;
    hipLaunchKernelGGL(mk_fwd, dim3(grid), dim3(NWAVES * 64), LDS_BYTES, stream, a);
#ifdef MK_PROBE_LIST
    { const int plist[] = {MK_PROBE_LIST};
      for (int p : plist) { a.ph_lo = p; a.ph_hi = p + 1; (void)hipMemsetAsync((char*)d_ws + WS_CTL + 4 * CW_QHEAD, 0, 4, stream); hipLaunchKernelGGL(mk_fwd, dim3(grid), dim3(NWAVES * 64), LDS_BYTES, stream, a); } }
#endif
#endif
}
```
